# Optimizing an MI355X kernel written in HIP

```python
import math
import jax
import jax.numpy as jnp
from jax import lax
import numpy as np

D_MODEL = 1024
BATCH = 8
SEQ = 2048
DEPTH = 4

GRID_W = 64
CTX_LEN = 256
N_MIXERS = 3
CONV_W = 3
DA_HEADS = 8
DA_HEAD_DIM = 64
ROPE_AXIS_DIM = DA_HEAD_DIM // 2
ROPE_THETA = 10000.0
Q_BLOCK = 128
SUBLN_EPS = 1e-5
HY_ORDER = 2
HY_EMB_DIM = 33
HY_BANDS = (HY_EMB_DIM - 1) // 2
HY_FILTER_WIDTH = 64
HY_FAST_DECAY_PCT = 0.3
HY_SLOW_DECAY_PCT = 1.5
HY_DECAY_TARGET = 1e-2
N_EXPERTS = 16
D_EXPERT = 1024
EC_CAPACITY = 2
NORM_EPS = 1e-6
N_LAYERS_A = (DEPTH + 2) // 3
N_LAYERS_B = (DEPTH + 1) // 3
N_LAYERS_C = DEPTH // 3

kernel_name = 'hybrid_dit_shortconv_diffattn_hyena_ecmoe'


def rms_norm(x, g, eps=NORM_EPS):
    xf = x.astype(jnp.float32)
    y = xf * lax.rsqrt(jnp.mean(xf * xf, axis=-1, keepdims=True) + eps)
    return y.astype(x.dtype) * g


def modulate(h, shift, scale):
    return h * (1 + scale) + shift


def short_conv3(u, w):
    up = jnp.pad(u, ((0, 0), (1, 1), (0, 0)))
    return up[:, :-2] * w[0] + up[:, 1:-1] * w[1] + up[:, 2:] * w[2]


def short_conv_mixer(h, w_in, w_conv, w_out):
    b, cg, v = jnp.split(h @ w_in, 3, axis=-1)
    return (b * short_conv3(cg * v, w_conv)) @ w_out


def axial_rope_tables(seq_len):
    rows = seq_len // GRID_W
    row = jnp.repeat(jnp.arange(rows, dtype=jnp.float32), GRID_W)
    col = jnp.tile(jnp.arange(GRID_W, dtype=jnp.float32), rows)
    inv_freq = ROPE_THETA ** (-jnp.arange(0, ROPE_AXIS_DIM, 2, dtype=jnp.float32) / ROPE_AXIS_DIM)
    ang_r = row[:, None] * inv_freq
    ang_c = col[:, None] * inv_freq
    expand = lambda t: t[None, :, None, None, :]
    return (expand(jnp.cos(ang_r)), expand(jnp.sin(ang_r)),
            expand(jnp.cos(ang_c)), expand(jnp.sin(ang_c)))


def rotate_pairs(x, cos, sin):
    x1, x2 = jnp.split(x, 2, axis=-1)
    cos = cos.astype(x.dtype)
    sin = sin.astype(x.dtype)
    return jnp.concatenate([x1 * cos - x2 * sin, x2 * cos + x1 * sin], axis=-1)


def axial_rope(x, tables):
    cos_r, sin_r, cos_c, sin_c = tables
    xr, xc = jnp.split(x, 2, axis=-1)
    return jnp.concatenate([rotate_pairs(xr, cos_r, sin_r), rotate_pairs(xc, cos_c, sin_c)], axis=-1)


def diff_attend(q, k, v, lam):
    s = jnp.einsum('bqhrd,bkhrd->bhrqk', q, k).astype(jnp.float32) * (DA_HEAD_DIM ** -0.5)
    p = jax.nn.softmax(s, axis=-1)
    a = (p[:, :, 0] - lam * p[:, :, 1]).astype(v.dtype)
    return jnp.einsum('bhqk,bkhe->bqhe', a, v)


def diff_attention(h_lat, h_ctx, w_qkv, lq1, lk1, lq2, lk2, subln_g, w_out, lam_init, ctx_out):
    B, L, _ = h_lat.shape
    Lc = h_ctx.shape[1]
    H, d = DA_HEADS, DA_HEAD_DIM
    q, k, v = jnp.split(h_lat @ w_qkv, 3, axis=-1)
    tables = axial_rope_tables(L)
    q = axial_rope(q.reshape(B, L, H, 2, d), tables)
    k = axial_rope(k.reshape(B, L, H, 2, d), tables)
    v = v.reshape(B, L, H, 2 * d)
    kc, vc = jnp.split(h_ctx @ w_qkv[:, D_MODEL:], 2, axis=-1)
    kc = kc.reshape(B, Lc, H, 2, d)
    vc = vc.reshape(B, Lc, H, 2 * d)
    lam = (jnp.exp(jnp.sum(lq1 * lk1).astype(jnp.float32))
           - jnp.exp(jnp.sum(lq2 * lk2).astype(jnp.float32)) + lam_init)
    k_all = jnp.concatenate([kc, k], axis=1)
    v_all = jnp.concatenate([vc, v], axis=1)
    n_blocks = L // Q_BLOCK
    q_blocks = jnp.moveaxis(q.reshape(B, n_blocks, Q_BLOCK, H, 2, d), 1, 0)
    o = lax.map(lambda qb: diff_attend(qb, k_all, v_all, lam), q_blocks)
    o = jnp.moveaxis(o, 0, 1).reshape(B, L, H, 2 * d)

    def finish(o_heads):
        o_n = rms_norm(o_heads, subln_g, SUBLN_EPS) * (1 - lam_init)
        return o_n.reshape(o_heads.shape[0], o_heads.shape[1], D_MODEL) @ w_out

    y_lat = finish(o)
    y_ctx = None
    if ctx_out:
        qc = (h_ctx @ w_qkv[:, :D_MODEL]).reshape(B, Lc, H, 2, d)
        y_ctx = finish(diff_attend(qc, kc, vc, lam))
    return y_lat, y_ctx


def hyena_filters(seq_len, f1_w, f1_b, f1_freq, f2_w, f2_b, f2_freq, f3_w):
    t = jnp.linspace(0.0, 1.0, seq_len, dtype=jnp.float32)[:, None]
    w = 2.0 * math.pi * jnp.arange(seq_len, dtype=jnp.float32)[:, None] / seq_len
    f = jnp.linspace(1e-4, HY_BANDS - 1, HY_BANDS, dtype=jnp.float32)[None, :]
    z = jnp.concatenate([t, jnp.cos(f * w), -jnp.sin(f * w)], axis=-1)
    hid = jnp.sin(f1_freq * (z @ f1_w + f1_b))
    hid = jnp.sin(f2_freq * (hid @ f2_w + f2_b))
    filt = (hid @ f3_w).astype(jnp.float32).reshape(seq_len, 2 * HY_ORDER, D_MODEL)
    max_decay = math.log(HY_DECAY_TARGET) / HY_FAST_DECAY_PCT
    min_decay = math.log(HY_DECAY_TARGET) / HY_SLOW_DECAY_PCT
    deltas = jnp.abs(jnp.linspace(min_decay, max_decay, D_MODEL, dtype=jnp.float32))
    return filt * jnp.exp(-t[:, :, None] * deltas)


def bidir_fftconv(u, h_fwd, h_bwd):
    B, L, C = u.shape
    k = jnp.concatenate([h_fwd, jnp.zeros((1, C), jnp.float32), h_bwd[:0:-1]], axis=0)
    U = jnp.fft.rfft(u.astype(jnp.float32), n=2 * L, axis=1)
    K = jnp.fft.rfft(k, axis=0)
    y = jnp.fft.irfft(U * K[None], n=2 * L, axis=1)[:, :L]
    return y.astype(u.dtype)


def hyena_mixer(h, w_in, w_conv, f1_w, f1_b, f1_freq, f2_w, f2_b, f2_freq, f3_w, skip, w_out):
    L = h.shape[1]
    u = short_conv3(h @ w_in, w_conv)
    x1, x2, v = jnp.split(u, 3, axis=-1)
    filt = hyena_filters(L, f1_w, f1_b, f1_freq, f2_w, f2_b, f2_freq, f3_w)
    z = x1 * (bidir_fftconv(v, filt[:, 0], filt[:, 1]) + v * skip[0])
    z = x2 * (bidir_fftconv(z, filt[:, 2], filt[:, 3]) + z * skip[1])
    return z @ w_out


def ec_moe(h, w_router, w_gate, w_up, w_down):
    B, T, D = h.shape
    cap = max(1, EC_CAPACITY * T // N_EXPERTS)
    aff = jax.nn.softmax(jnp.einsum('btd,de->bte', h, w_router).astype(jnp.float32), axis=-1)
    gate, idx = lax.top_k(jnp.swapaxes(aff, 1, 2), cap)
    x_in = jax.vmap(lambda hb, ib: hb[ib])(h, idx)
    a = jnp.einsum('becd,edf->becf', x_in, w_gate)
    b = jnp.einsum('becd,edf->becf', x_in, w_up)
    y = jnp.einsum('becf,efd->becd', jax.nn.silu(a) * b, w_down) * gate[..., None].astype(h.dtype)
    return jax.vmap(lambda yb, ib: jnp.zeros((T, D), h.dtype).at[ib.reshape(-1)].add(yb.reshape(-1, D)))(y, idx)


def setup_inputs(seed: int = 0) -> dict:
    key = jax.random.key(seed)
    keys = iter(jax.random.split(key, 40))
    nrm = lambda shape, s: jax.random.normal(next(keys), shape, jnp.float32) * s
    D, F, E, d, W = D_MODEL, D_EXPERT, N_EXPERTS, DA_HEAD_DIM, HY_FILTER_WIDTH
    return {
        'x': nrm((BATCH, SEQ, D), 1.0),
        'c': nrm((BATCH, D), 1.0),
        'ctx': nrm((BATCH, CTX_LEN, D), 1.0),
        'c_ctx': nrm((D,), 1.0),
        'w_ada': nrm((DEPTH, D, 6 * D), 0.5 * D ** -0.5),
        'b_ada': nrm((DEPTH, 6 * D), 0.02),
        'norm1_g': 1.0 + nrm((DEPTH, D), 0.02),
        'norm2_g': 1.0 + nrm((DEPTH, D), 0.02),
        'final_g': 1.0 + nrm((D,), 0.02),
        'a_w_in': nrm((N_LAYERS_A, D, 3 * D), D ** -0.5),
        'a_conv': nrm((N_LAYERS_A, CONV_W, D), CONV_W ** -0.5),
        'a_w_out': nrm((N_LAYERS_A, D, D), D ** -0.5),
        'b_w_qkv': nrm((N_LAYERS_B, D, 3 * D), D ** -0.5),
        'b_lq1': nrm((N_LAYERS_B, d), 0.1),
        'b_lk1': nrm((N_LAYERS_B, d), 0.1),
        'b_lq2': nrm((N_LAYERS_B, d), 0.1),
        'b_lk2': nrm((N_LAYERS_B, d), 0.1),
        'b_subln_g': 1.0 + nrm((N_LAYERS_B, 2 * d), 0.02),
        'b_w_out': nrm((N_LAYERS_B, D, D), D ** -0.5),
        'c_w_in': nrm((N_LAYERS_C, D, 3 * D), D ** -0.5),
        'c_conv': nrm((N_LAYERS_C, CONV_W, 3 * D), CONV_W ** -0.5),
        'c_f1_w': nrm((N_LAYERS_C, HY_EMB_DIM, W), HY_EMB_DIM ** -0.5),
        'c_f1_b': nrm((N_LAYERS_C, W), 0.1),
        'c_f1_freq': 1.0 + nrm((N_LAYERS_C, W), 0.05),
        'c_f2_w': nrm((N_LAYERS_C, W, W), W ** -0.5),
        'c_f2_b': nrm((N_LAYERS_C, W), 0.1),
        'c_f2_freq': 1.0 + nrm((N_LAYERS_C, W), 0.05),
        'c_f3_w': nrm((N_LAYERS_C, W, 2 * HY_ORDER * D), 0.05 * W ** -0.5),
        'c_skip': nrm((N_LAYERS_C, HY_ORDER, D), 0.5),
        'c_w_out': nrm((N_LAYERS_C, D, D), D ** -0.5),
        'moe_router': nrm((DEPTH, D, E), D ** -0.5),
        'moe_w_gate': nrm((DEPTH, E, D, F), D ** -0.5),
        'moe_w_up': nrm((DEPTH, E, D, F), D ** -0.5),
        'moe_w_down': nrm((DEPTH, E, F, D), F ** -0.5),
    }


def reference(x, c, ctx, c_ctx, w_ada, b_ada, norm1_g, norm2_g, final_g,
              a_w_in, a_conv, a_w_out,
              b_w_qkv, b_lq1, b_lk1, b_lq2, b_lk2, b_subln_g, b_w_out,
              c_w_in, c_conv, c_f1_w, c_f1_b, c_f1_freq, c_f2_w, c_f2_b, c_f2_freq, c_f3_w, c_skip, c_w_out,
              moe_router, moe_w_gate, moe_w_up, moe_w_down):
    attn_layers = [i for i in range(DEPTH) if i % N_MIXERS == 1]
    last_ctx_read = max(attn_layers) if attn_layers else -1
    silu_c = jax.nn.silu(c)
    silu_cc = jax.nn.silu(c_ctx)
    for i in range(DEPTH):
        kind, j = i % N_MIXERS, i // N_MIXERS
        update_ctx = i < last_ctx_read
        use_ctx = update_ctx or kind == 1
        sh1, sc1, g1, sh2, sc2, g2 = [m[:, None, :] for m in jnp.split(silu_c @ w_ada[i] + b_ada[i], 6, axis=-1)]
        h = modulate(rms_norm(x, norm1_g[i]), sh1, sc1)
        hc = None
        if use_ctx:
            csh1, csc1, cg1, csh2, csc2, cg2 = jnp.split(silu_cc @ w_ada[i] + b_ada[i], 6, axis=-1)
            hc = modulate(rms_norm(ctx, norm1_g[i]), csh1, csc1)
        yc = None
        if kind == 0:
            params = (a_w_in[j], a_conv[j], a_w_out[j])
            y = short_conv_mixer(h, *params)
            if update_ctx:
                yc = short_conv_mixer(hc, *params)
        elif kind == 1:
            lam_init = 0.8 - 0.6 * math.exp(-0.3 * i)
            y, yc = diff_attention(h, hc, b_w_qkv[j], b_lq1[j], b_lk1[j], b_lq2[j], b_lk2[j],
                                   b_subln_g[j], b_w_out[j], lam_init, update_ctx)
        else:
            params = (c_w_in[j], c_conv[j], c_f1_w[j], c_f1_b[j], c_f1_freq[j], c_f2_w[j], c_f2_b[j],
                      c_f2_freq[j], c_f3_w[j], c_skip[j], c_w_out[j])
            y = hyena_mixer(h, *params)
            if update_ctx:
                yc = hyena_mixer(hc, *params)
        x = x + g1 * y
        x = x + g2 * ec_moe(modulate(rms_norm(x, norm2_g[i]), sh2, sc2),
                            moe_router[i], moe_w_gate[i], moe_w_up[i], moe_w_down[i])
        if update_ctx:
            ctx = ctx + cg1 * yc
            ctx = ctx + cg2 * ec_moe(modulate(rms_norm(ctx, norm2_g[i]), csh2, csc2),
                                     moe_router[i], moe_w_gate[i], moe_w_up[i], moe_w_down[i])
    return rms_norm(x, final_g)
```

```cpp
#include <hip/hip_runtime.h>
#include <hip/hip_cooperative_groups.h>
#include <cstdio>
#include <cstdint>
#include <cmath>
namespace cg = cooperative_groups;

#define LAS __attribute__((address_space(3)))
#define GAS __attribute__((address_space(1)))
#define DI __device__ __forceinline__

typedef unsigned short h16;
typedef _Float16 hf;
typedef _Float16 half8 __attribute__((ext_vector_type(8)));
typedef _Float16 half4 __attribute__((ext_vector_type(4)));
typedef _Float16 half2v __attribute__((ext_vector_type(2)));
typedef short s16x8 __attribute__((ext_vector_type(8)));
typedef short s16x4 __attribute__((ext_vector_type(4)));
typedef float f32x2 __attribute__((ext_vector_type(2)));
typedef float f32x4 __attribute__((ext_vector_type(4)));
typedef float f32x16 __attribute__((ext_vector_type(16)));
typedef unsigned u32x2 __attribute__((ext_vector_type(2)));
typedef unsigned u32x4 __attribute__((ext_vector_type(4)));

#ifndef MK_N_LAUNCHES
#define MK_N_LAUNCHES 1
#endif
#ifndef DBG_CHECK
#define DBG_CHECK 0
#endif
#ifndef DBG_STOP
#define DBG_STOP 35
#endif

constexpr int D = 1024, NB = 8, L = 2048, T = NB * L, LC = 256, TC = NB * LC, TT = T + TC;
constexpr int NE = 16, CAP = 256, CAPC = 32, NH = 8;
constexpr int NGL = NE * NB * CAP, NGC = NE * NB * CAPC, NG = NGL + NGC;
constexpr int KVR = LC + L;
constexpr int NWAVES = 8, NTHR = 512;

constexpr size_t MiB = 1u << 20;
constexpr size_t WS_CTL = 0, WS_MOD = 1 * MiB, WS_SMALL = 2 * MiB, WS_AFF = 3 * MiB, WS_SLOT = 5 * MiB, WS_GATE = 7 * MiB, WS_FILT = 8 * MiB;
constexpr size_t WS_WAIN = 24 * MiB, WS_WAOUT = 36 * MiB, WS_WQKV = 40 * MiB, WS_WBOUT = 46 * MiB, WS_WCIN = 48 * MiB, WS_WCOUT = 54 * MiB;
constexpr size_t WS_WGU = 56 * MiB, WS_WDN = 312 * MiB;
constexpr size_t WS_XC = 440 * MiB, WS_H = 512 * MiB, WS_BIG = 548 * MiB, WS_Z = 656 * MiB, WS_XIN = 692 * MiB, WS_END = 764 * MiB;
constexpr size_t CTL_ZERO_BYTES = 1 * MiB;

constexpr int LDS_BYTES = 160 * 1024;
constexpr int LDS_CTL_OFF = 159 * 1024;

DI unsigned pk2h(float lo, float hi) { f32x2 v = {lo, hi}; half2v h = __builtin_convertvector(v, half2v); return __builtin_bit_cast(unsigned, h); }
DI float h2f(h16 v) { return (float)__builtin_bit_cast(hf, v); }
DI f32x4 unpack4(const u32x2 w) { const half4 h = __builtin_bit_cast(half4, w); return (f32x4){(float)h[0], (float)h[1], (float)h[2], (float)h[3]}; }
DI float wave_sum(float v) {
#pragma unroll
    for (int o = 1; o < 64; o <<= 1) v += __shfl_xor(v, o);
    return v;
}
DI float silu_f(float a) { return a / (1.f + __expf(-a)); }
#define LDS_WAIT() asm volatile("s_waitcnt lgkmcnt(0)" ::: "memory")
#define VM_WAIT() asm volatile("s_waitcnt vmcnt(0)" ::: "memory")

namespace pg8 {
constexpr int BM = 256, BK = 64, HALF = 128, HTB = HALF * BK * 2, STAGE_BYTES = 8 * HTB, NXCD = 8, WGM = 8;
DI int lds_byte(int r, int c) { const int st = (r >> 4) * 2 + (c >> 5), rr = r & 15, cc = c & 31, ob = rr * 64 + cc * 2; return st * 1024 + (ob ^ (((ob >> 9) & 1) << 5)); }
DI void stage_rc(int b, int& R, int& C) { const int st = b / 1024, sb = b % 1024, swz = sb ^ (((sb >> 9) & 1) << 5); R = (st >> 1) * 16 + swz / 64; C = (st & 1) * 32 + (swz % 64) / 2; }
DI int perm32(int rho) { const int n = rho >> 4, i = rho & 15; return 8 * (i >> 2) + 4 * n + (i & 3); }

struct Unit { int pm, pn, ta, tb; };

DI bool tile_order(int i, int nM, int nN, int G, int c, int& pm, int& pn) {
    const int nwg = nM * nN; const long Lx = (long)i * G + c; if (Lx >= nwg) return false;
    int wgid = (int)Lx; { const int q = nwg / NXCD, r = nwg % NXCD, xcd = wgid % NXCD, off = wgid / NXCD; wgid = (xcd < r ? xcd * (q + 1) : r * (q + 1) + (xcd - r) * q) + off; }
    const int nig = WGM * nN, gid = wgid / nig, fm = gid * WGM, gsz = (nM - fm) < WGM ? (nM - fm) : WGM;
    pm = fm + ((wgid % nig) % gsz); pn = (wgid % nig) / gsz; return true;
}

template <class Epi, class Sched>
DI void gemm_phase(LAS unsigned char* lds, const int tid, const h16* Ag, const h16* Btg, const int K, const Sched& S, const Epi& E) {
    const int wid = __builtin_amdgcn_readfirstlane(tid >> 6), lane = tid & 63, wr = wid >> 2, wc = wid & 3, fr = lane & 15, fq = lane >> 4;
    const int nt = K / BK;
    unsigned voffA[2], voffB[2];
#pragma unroll
    for (int i = 0; i < 2; ++i) { int R, C; stage_rc(tid * 16 + i * 8192, R, C); const int Rb = (R & ~31) + perm32(R & 31);
        voffA[i] = (unsigned)(R * K + C) * 2u; voffB[i] = (unsigned)(Rb * K + C) * 2u; }
    const size_t kstep = (size_t)(BK * 2);
    const size_t hstep = (size_t)HALF * K * 2;
    const size_t tstep = 2 * hstep;
    const unsigned ldsw = (unsigned)wid * 1024u;
    const int aoff = lds_byte(wr * 64 + fr, fq * 8), boff = lds_byte(wc * 32 + fr, fq * 8);
#define PG8_SA(b, h) (((b) * 2 + (h)) * HTB)
#define PG8_SB(b, h) ((4 + (b) * 2 + (h)) * HTB)
#define PG8_STAGE(bufoff, gbase, voff) do { _Pragma("unroll") for (int _i = 0; _i < 2; ++_i) \
        __builtin_amdgcn_global_load_lds((const unsigned*)((const char*)(gbase) + (voff)[_i]), (LAS unsigned*)(lds + (bufoff) + ldsw + _i * 8192), 16, 0, 0); } while (0)
#define PG8_LDA(dst, b, h) do { _Pragma("unroll") for (int m = 0; m < 4; ++m) _Pragma("unroll") for (int k = 0; k < 2; ++k) dst[m][k] = *(const LAS half8*)(lds + PG8_SA(b, h) + aoff + m * 2048 + k * 1024); } while (0)
#define PG8_LDB(dst, b, h) do { _Pragma("unroll") for (int n = 0; n < 2; ++n) _Pragma("unroll") for (int k = 0; k < 2; ++k) dst[n][k] = *(const LAS half8*)(lds + PG8_SB(b, h) + boff + n * 2048 + k * 1024); } while (0)
#define PG8_MMA(ai, bj, At, Bt) do { __builtin_amdgcn_s_setprio(1); _Pragma("unroll") for (int m = 0; m < 4; ++m) _Pragma("unroll") for (int n = 0; n < 2; ++n) _Pragma("unroll") for (int k = 0; k < 2; ++k) \
        acc[ai][bj][m][n] = __builtin_amdgcn_mfma_f32_16x16x32_f16(Bt[n][k], At[m][k], acc[ai][bj][m][n], 0, 0, 0); __builtin_amdgcn_s_setprio(0); } while (0)
#define PG8_WAIT_V(n) asm volatile("s_waitcnt vmcnt(" #n ")" ::: "memory")
#define PG8_WAIT_L(n) asm volatile("s_waitcnt lgkmcnt(" #n ")" ::: "memory")
#define PG8_BAR __builtin_amdgcn_s_barrier()
#define PG8_SCHED __builtin_amdgcn_sched_barrier(0)
    Unit cur, nxt; int ui = 0;
    if (!S.next(0, cur)) return;
    f32x4 acc[2][2][4][2];
    half8 At[4][2], B0[2][2], B1[2][2];
    const char* cA = (const char*)Ag + (size_t)cur.ta * tstep; const char* cB = (const char*)Btg + (size_t)cur.tb * tstep;
    PG8_STAGE(PG8_SB(0, 0), cB, voffB); PG8_STAGE(PG8_SB(0, 1), cB + hstep, voffB); PG8_STAGE(PG8_SA(0, 0), cA, voffA); PG8_STAGE(PG8_SA(0, 1), cA + hstep, voffA);
    if (wr == 1) PG8_BAR;
    PG8_WAIT_V(2); PG8_BAR;
    PG8_STAGE(PG8_SB(1, 0), cB + kstep, voffB); PG8_STAGE(PG8_SA(1, 0), cA + kstep, voffA); PG8_STAGE(PG8_SB(1, 1), cB + hstep + kstep, voffB);
    PG8_WAIT_V(6); PG8_BAR;
#pragma unroll
    for (int a = 0; a < 2; ++a)
#pragma unroll
        for (int b = 0; b < 2; ++b)
#pragma unroll
            for (int m = 0; m < 4; ++m)
#pragma unroll
                for (int n = 0; n < 2; ++n) acc[a][b][m][n] = (f32x4){0.f, 0.f, 0.f, 0.f};
    for (;;) {
        const bool has_next = S.next(ui + 1, nxt);
        const char* nA = has_next ? (const char*)Ag + (size_t)nxt.ta * tstep : cA; const char* nB = has_next ? (const char*)Btg + (size_t)nxt.tb * tstep : cB;
        for (int t = 0; t < nt; t += 2) {
            const bool last = (t == nt - 2);
            const char* a1 = cA + (size_t)(t + 1) * kstep;
            const char* a2 = last ? nA : cA + (size_t)(t + 2) * kstep; const char* b2 = last ? nB : cB + (size_t)(t + 2) * kstep;
            const char* a3 = a2 + kstep; const char* b3 = b2 + kstep;
            PG8_LDB(B0, 0, 0); PG8_LDB(B1, 0, 1); PG8_SCHED; PG8_LDA(At, 0, 0); PG8_STAGE(PG8_SA(1, 1), a1 + hstep, voffA);
            PG8_WAIT_V(8); PG8_WAIT_L(0); PG8_BAR; PG8_MMA(0, 0, At, B0); PG8_MMA(0, 1, At, B1); PG8_BAR; PG8_SCHED;
            PG8_LDA(At, 0, 1); PG8_STAGE(PG8_SB(0, 0), b2, voffB); PG8_STAGE(PG8_SB(0, 1), b2 + hstep, voffB); PG8_STAGE(PG8_SA(0, 0), a2, voffA);
            PG8_WAIT_V(8); PG8_WAIT_L(0); PG8_BAR; PG8_MMA(1, 0, At, B0); PG8_MMA(1, 1, At, B1); PG8_BAR; PG8_SCHED;
            PG8_LDB(B0, 1, 0); PG8_LDB(B1, 1, 1); PG8_SCHED; PG8_LDA(At, 1, 0); PG8_STAGE(PG8_SA(0, 1), a2 + hstep, voffA);
            PG8_WAIT_V(8); PG8_WAIT_L(0); PG8_BAR; PG8_MMA(0, 0, At, B0); PG8_MMA(0, 1, At, B1); PG8_BAR; PG8_SCHED;
            PG8_LDA(At, 1, 1); PG8_STAGE(PG8_SB(1, 0), b3, voffB); PG8_STAGE(PG8_SB(1, 1), b3 + hstep, voffB); PG8_STAGE(PG8_SA(1, 0), a3, voffA);
            PG8_WAIT_V(8); PG8_WAIT_L(0); PG8_BAR; PG8_MMA(1, 0, At, B0); PG8_MMA(1, 1, At, B1); PG8_BAR; PG8_SCHED;
        }
        if (wr == 0) PG8_BAR;
        { int fr_ = fr, fq_ = fq; asm volatile("" : "+v"(fr_), "+v"(fq_)); E(acc, cur, wr, wc, fr_, fq_); }
        if (!has_next) break;
#pragma unroll
        for (int a = 0; a < 2; ++a)
#pragma unroll
            for (int b = 0; b < 2; ++b)
#pragma unroll
                for (int m = 0; m < 4; ++m)
#pragma unroll
                    for (int n = 0; n < 2; ++n) acc[a][b][m][n] = (f32x4){0.f, 0.f, 0.f, 0.f};
        cur = nxt; cA = nA; cB = nB; ++ui;
        if (wr == 1) PG8_BAR;
    }
    PG8_WAIT_V(0);
    PG8_BAR;
#undef PG8_SA
#undef PG8_SB
#undef PG8_STAGE
#undef PG8_LDA
#undef PG8_LDB
#undef PG8_MMA
#undef PG8_WAIT_V
#undef PG8_WAIT_L
#undef PG8_BAR
#undef PG8_SCHED
}

struct SchedPlain {
    int nM, nN, G, c;
    DI bool next(int i, Unit& u) const { if (!tile_order(i, nM, nN, G, c, u.pm, u.pn)) return false; u.ta = u.pm; u.tb = u.pn; return true; }
};
struct SchedMoe {
    int nM, nN, G, c, tpe;
    DI bool next(int i, Unit& u) const { if (!tile_order(i, nM, nN, G, c, u.pm, u.pn)) return false; const int e = u.pm < 128 ? (u.pm >> 3) : (u.pm - 128); u.ta = u.pm; u.tb = e * tpe + u.pn; return true; }
};
struct SchedQkv {
    int G, c;
    DI bool next(int i, Unit& u) const {
        const long Lx = (long)i * G + c;
        if (Lx < 768) { tile_order(i, 64, 12, G, c, u.pm, u.pn); u.ta = u.pm; u.tb = u.pn; return true; }
        const int r = (int)(Lx - 768); if (r >= 64) return false;
        u.pm = 64 + (r & 7); u.pn = 4 + (r >> 3); u.ta = u.pm; u.tb = u.pn; return true;
    }
};

struct EpiPlain {
    h16* O; int ldc;
    DI void operator()(const f32x4 (&acc)[2][2][4][2], const Unit& u, int wr, int wc, int fr, int fq) const {
        const int row0 = u.pm * BM + wr * 64 + fr, col0 = u.pn * BM + wc * 32 + 8 * fq;
#pragma unroll
        for (int ai = 0; ai < 2; ++ai)
#pragma unroll
            for (int m = 0; m < 4; ++m) { h16* rowp = O + (size_t)(row0 + ai * HALF + m * 16) * ldc + col0;
#pragma unroll
                for (int bj = 0; bj < 2; ++bj) { const f32x4 v0 = acc[ai][bj][m][0], v1 = acc[ai][bj][m][1];
                    u32x4 w; w.x = pk2h(v0[0], v0[1]); w.y = pk2h(v0[2], v0[3]); w.z = pk2h(v1[0], v1[1]); w.w = pk2h(v1[2], v1[3]);
                    *(u32x4*)(rowp + bj * HALF) = w; } }
    }
};
struct EpiResid {
    float* XC; const float* modl; int goff;
    DI void operator()(const f32x4 (&acc)[2][2][4][2], const Unit& u, int wr, int wc, int fr, int fq) const {
        const int row0 = u.pm * BM + wr * 64 + fr, col0 = u.pn * BM + wc * 32 + 8 * fq;
        const int r9 = u.pm < 64 ? (u.pm >> 3) : 8;
        const float* g = modl + r9 * 6144 + goff + col0;
        f32x4 gv[2][2];
#pragma unroll
        for (int bj = 0; bj < 2; ++bj)
#pragma unroll
            for (int n = 0; n < 2; ++n) gv[bj][n] = *(const f32x4*)(g + bj * HALF + 4 * n);
#pragma unroll
        for (int ai = 0; ai < 2; ++ai)
#pragma unroll
            for (int m = 0; m < 4; ++m) { float* rowp = XC + (size_t)(row0 + ai * HALF + m * 16) * D + col0;
#pragma unroll
                for (int bj = 0; bj < 2; ++bj)
#pragma unroll
                    for (int n = 0; n < 2; ++n) { f32x4* p = (f32x4*)(rowp + bj * HALF + 4 * n); f32x4 x = *p; x += gv[bj][n] * acc[ai][bj][m][n]; *p = x; } }
    }
};
struct EpiSwiglu {
    h16* HID;
    DI void operator()(const f32x4 (&acc)[2][2][4][2], const Unit& u, int wr, int wc, int fr, int fq) const {
        const int row0 = u.pm * BM + wr * 64 + fr, col0 = u.pn * HALF + wc * 32 + 8 * fq;
#pragma unroll
        for (int ai = 0; ai < 2; ++ai)
#pragma unroll
            for (int m = 0; m < 4; ++m) { h16* rowp = HID + (size_t)(row0 + ai * HALF + m * 16) * D + col0;
                float o[8];
#pragma unroll
                for (int n = 0; n < 2; ++n)
#pragma unroll
                    for (int j = 0; j < 4; ++j) { const float a = acc[ai][0][m][n][j], b = acc[ai][1][m][n][j]; o[4 * n + j] = silu_f(a) * b; }
                u32x4 w; w.x = pk2h(o[0], o[1]); w.y = pk2h(o[2], o[3]); w.z = pk2h(o[4], o[5]); w.w = pk2h(o[6], o[7]);
                *(u32x4*)rowp = w; }
    }
};
struct EpiDown {
    h16* YE; const float* GATE;
    DI void operator()(const f32x4 (&acc)[2][2][4][2], const Unit& u, int wr, int wc, int fr, int fq) const {
        const int row0 = u.pm * BM + wr * 64 + fr, col0 = u.pn * BM + wc * 32 + 8 * fq;
#pragma unroll
        for (int ai = 0; ai < 2; ++ai)
#pragma unroll
            for (int m = 0; m < 4; ++m) { const int row = row0 + ai * HALF + m * 16; const float gt = GATE[row]; h16* rowp = YE + (size_t)row * D + col0;
#pragma unroll
                for (int bj = 0; bj < 2; ++bj) { const f32x4 v0 = acc[ai][bj][m][0] * gt, v1 = acc[ai][bj][m][1] * gt;
                    u32x4 w; w.x = pk2h(v0[0], v0[1]); w.y = pk2h(v0[2], v0[3]); w.z = pk2h(v1[0], v1[1]); w.w = pk2h(v1[2], v1[3]);
                    *(u32x4*)(rowp + bj * HALF) = w; } }
    }
};
constexpr float ATT_C2 = 0.125f * 1.4426950408889634f;
struct EpiQkv {
    h16 *Q, *Kb, *Vb; const float *RC, *RS;
    DI void operator()(const f32x4 (&acc)[2][2][4][2], const Unit& u, int wr, int wc, int fr, int fq) const {
        const bool ctx = u.pm >= 64; const int sec = u.pn >> 2;
        const int lr0 = wr * 64 + fr, col0 = (u.pn & 3) * BM + wc * 32 + 8 * fq;
        h16* base; size_t rowb;
        if (sec == 0) { base = Q; rowb = (size_t)u.pm * BM; }
        else { base = sec == 1 ? Kb : Vb; rowb = ctx ? (size_t)(u.pm - 64) * KVR : (size_t)(u.pm >> 3) * KVR + LC + (size_t)(u.pm & 7) * BM; }
        const bool rope = (sec < 2) && !ctx; const float sc = sec == 0 ? ATT_C2 : 1.f;
#pragma unroll
        for (int ai = 0; ai < 2; ++ai)
#pragma unroll
            for (int m = 0; m < 4; ++m) { const int lr = lr0 + ai * HALF + m * 16; h16* rowp = base + (rowb + lr) * D + col0;
                f32x4 cs = {1.f, 1.f, 1.f, 1.f}, sn = {0.f, 0.f, 0.f, 0.f};
                if (rope) { const int t = (u.pm & 7) * BM + lr; const int pos = (wc & 1) ? (t & 63) : (t >> 6); cs = *(const f32x4*)(RC + pos * 16 + 4 * fq); sn = *(const f32x4*)(RS + pos * 16 + 4 * fq); }
#pragma unroll
                for (int bj = 0; bj < 2; ++bj) { const f32x4 x1 = acc[ai][bj][m][0], x2 = acc[ai][bj][m][1];
                    const f32x4 v0 = (x1 * cs - x2 * sn) * sc, v1 = (x2 * cs + x1 * sn) * sc;
                    u32x4 w; w.x = pk2h(v0[0], v0[1]); w.y = pk2h(v0[2], v0[3]); w.z = pk2h(v1[0], v1[1]); w.w = pk2h(v1[2], v1[3]);
                    *(u32x4*)(rowp + bj * HALF) = w; }
                asm volatile("" ::: "memory"); }
    }
};
}

#define XB_TMO      128
#define XB_XCNT(j)  (256  + 64 * (j))
#define XB_XSUB(j)  (1280 + 64 * (j))
#define XB_XGEN(j)  (2304 + 64 * (j))
#define XB_TOP      3328
#define XB_TOPGEN   3392
#define XCD_BAR_WORDS 3456
#define XB_SPIN_CAP (1u << 22)
DI unsigned xb_ld(unsigned* p)              { return __hip_atomic_load(p, __ATOMIC_RELAXED, __HIP_MEMORY_SCOPE_AGENT); }
DI unsigned xb_add(unsigned* p, unsigned v) { return __hip_atomic_fetch_add(p, v, __ATOMIC_RELAXED, __HIP_MEMORY_SCOPE_AGENT); }
DI unsigned xb_xcc_id() { return (unsigned)__builtin_amdgcn_s_getreg((3 << 11) | 20) & 0xFu; }
#define XB_SPIN(cond, bar) do { unsigned _sp = 0; while (cond) { __builtin_amdgcn_s_sleep(1); \
    if ((++_sp & 255u) == 0u) { if (xb_ld(&(bar)[XB_TMO])) break; if (_sp > XB_SPIN_CAP) { atomicAdd(&(bar)[XB_TMO], 1u); break; } } } } while (0)
struct XcdBarrier { unsigned* bar; unsigned x; volatile LAS unsigned* st; };
DI XcdBarrier xcd_barrier_post(unsigned* bar, volatile LAS unsigned* st) {
    XcdBarrier b; b.bar = bar; b.x = xb_xcc_id(); b.st = st;
    if (threadIdx.x == 0) (void)xb_add(&bar[XB_XCNT(b.x)], 1u);
    return b;
}
DI void xcd_barrier_complete(unsigned* bar, unsigned x, unsigned& nloc, unsigned& nx) {
    const unsigned G = gridDim.x * gridDim.y * gridDim.z;
    unsigned sum, cnt, mine, sp = 0u;
    for (;;) {
        sum = 0u; cnt = 0u; mine = 0u;
#pragma unroll
        for (unsigned j = 0; j < 16; ++j) { const unsigned c = xb_ld(&bar[XB_XCNT(j)]); sum += c; cnt += (c > 0u) ? 1u : 0u; mine = (j == x) ? c : mine; }
        if (sum == G) break;
        __builtin_amdgcn_s_sleep(1);
        if ((++sp & 255u) == 0u) { if (xb_ld(&bar[XB_TMO])) break; if (sp > XB_SPIN_CAP) { atomicAdd(&bar[XB_TMO], 1u); break; } }
    }
    nloc = mine > 0u ? mine : 1u; nx = cnt > 0u ? cnt : 1u;
}
DI void xcd_barrier(const XcdBarrier& b) {
    asm volatile("s_waitcnt vmcnt(0)" ::: "memory");
    __syncthreads();
    if (threadIdx.x == 0) {
        unsigned* bar = b.bar;
        __builtin_amdgcn_s_waitcnt(0);
        unsigned nloc = b.st[0], nx = b.st[1];
        if (nloc == 0u) { xcd_barrier_complete(bar, b.x, nloc, nx); b.st[0] = nloc; b.st[1] = nx; }
        const unsigned old = xb_add(&bar[XB_XSUB(b.x)], 1u);
        const unsigned gen = old / nloc;
        if (old + 1u == (gen + 1u) * nloc) {
            __builtin_amdgcn_fence(__ATOMIC_RELEASE, "agent");
            asm volatile("s_waitcnt vmcnt(0)" ::: "memory");
            const unsigned og = xb_add(&bar[XB_TOP], 1u);
            const unsigned tg = og / nx;
            if (og + 1u == (tg + 1u) * nx) xb_add(&bar[XB_TOPGEN], 1u);
            else XB_SPIN(xb_ld(&bar[XB_TOPGEN]) == tg, bar);
            __builtin_amdgcn_fence(__ATOMIC_ACQUIRE, "agent");
            xb_add(&bar[XB_XGEN(b.x)], 1u);
            asm volatile("s_waitcnt vmcnt(0)" ::: "memory");
        } else {
            XB_SPIN(xb_ld(&bar[XB_XGEN(b.x)]) == gen, bar);
            __builtin_amdgcn_fence(__ATOMIC_ACQUIRE, "agent");
            asm volatile("s_waitcnt vmcnt(0)" ::: "memory");
        }
    }
    __syncthreads();
}

struct Args { const float* in[34]; float* out; unsigned char* ws; int ph_lo, ph_hi; };
enum { I_X = 0, I_C, I_CTX, I_CCTX, I_WADA, I_BADA, I_N1G, I_N2G, I_FG, I_AWIN, I_ACONV, I_AWOUT, I_BQKV, I_LQ1, I_LK1, I_LQ2, I_LK2, I_SUBG, I_BWOUT,
       I_CWIN, I_CCONV, I_F1W, I_F1B, I_F1F, I_F2W, I_F2B, I_F2F, I_F3W, I_SKIP, I_CWOUT, I_ROUTER, I_WGATE, I_WUP, I_WDOWN };

typedef __attribute__((address_space(4))) const Args CArgs;
struct Ctx { LAS unsigned char* lds; int tid, lane, wave, G, bx, vcu, gw, NGW; };

DI int perm_l2p(int l) { return ((l >> 2) & 3) * 8 + (l >> 4) * 4 + (l & 3); }
DI int map_row(int mode, int n) {
    if (mode == 1) return n < 2048 ? (n & ~31) + perm_l2p(n & 31) : n;
    if (mode == 2) return (n >> 7) * 256 + (n & 127);
    if (mode == 3) return (n >> 7) * 256 + 128 + (n & 127);
    return n;
}
DI void p0_transpose_item(const float* W, int N, h16* WT, int mode, LAS float* scr, int item, int lane) {
    const int nblk = N / 32, kb = item / nblk, nb = item % nblk, k0 = 64 * kb, n0 = 32 * nb;
#pragma unroll 8
    for (int i = 0; i < 32; ++i) { const int kk = 2 * i + (lane >> 5); scr[kk * 33 + (lane & 31)] = W[(size_t)(k0 + kk) * N + n0 + (lane & 31)]; }
    LDS_WAIT(); asm volatile("" ::: "memory");
    const int c = lane & 7;
#pragma unroll
    for (int j = 0; j < 4; ++j) { const int n = (lane >> 3) + 8 * j; const LAS float* s = scr + (8 * c) * 33 + n;
        u32x4 o; o.x = pk2h(s[0 * 33], s[1 * 33]); o.y = pk2h(s[2 * 33], s[3 * 33]); o.z = pk2h(s[4 * 33], s[5 * 33]); o.w = pk2h(s[6 * 33], s[7 * 33]);
        *(u32x4*)(WT + (size_t)map_row(mode, n0 + n) * 1024 + k0 + 8 * c) = o; }
    LDS_WAIT(); asm volatile("" ::: "memory");
}

DI void p0_prologue(const Ctx& F, CArgs& a) {
    unsigned char* ws = a.ws;
    {
        LAS float* scr = (LAS float*)(F.lds + F.wave * 16384);
        constexpr int NSPEC = 8192, NMOE = 192 * 512, NITEMS = NSPEC + NMOE;
        for (int it = F.gw; it < NITEMS; it += F.NGW) {
            int r = it;
            if (r >= NSPEC) { r -= NSPEC; const int mat = r >> 9, item = r & 511; const int kind = mat >> 6, le = mat & 63;
                const float* src = a.in[I_WGATE + kind] + (size_t)le * 1024 * 1024;
                h16* dst = kind < 2 ? (h16*)(ws + WS_WGU) + (size_t)le * 2048 * 1024 : (h16*)(ws + WS_WDN) + (size_t)le * 1024 * 1024;
                p0_transpose_item(src, 1024, dst, kind == 0 ? 2 : (kind == 1 ? 3 : 0), scr, item, F.lane); continue; }
            if (r < 1536) { p0_transpose_item(a.in[I_AWIN], 3072, (h16*)(ws + WS_WAIN), 0, scr, r, F.lane); continue; } r -= 1536;
            if (r < 1536) { p0_transpose_item(a.in[I_AWIN] + (size_t)1024 * 3072, 3072, (h16*)(ws + WS_WAIN) + (size_t)3072 * 1024, 0, scr, r, F.lane); continue; } r -= 1536;
            if (r < 512) { p0_transpose_item(a.in[I_AWOUT], 1024, (h16*)(ws + WS_WAOUT), 0, scr, r, F.lane); continue; } r -= 512;
            if (r < 512) { p0_transpose_item(a.in[I_AWOUT] + (size_t)1024 * 1024, 1024, (h16*)(ws + WS_WAOUT) + (size_t)1024 * 1024, 0, scr, r, F.lane); continue; } r -= 512;
            if (r < 1536) { p0_transpose_item(a.in[I_BQKV], 3072, (h16*)(ws + WS_WQKV), 1, scr, r, F.lane); continue; } r -= 1536;
            if (r < 512) { p0_transpose_item(a.in[I_BWOUT], 1024, (h16*)(ws + WS_WBOUT), 0, scr, r, F.lane); continue; } r -= 512;
            if (r < 1536) { p0_transpose_item(a.in[I_CWIN], 3072, (h16*)(ws + WS_WCIN), 0, scr, r, F.lane); continue; } r -= 1536;
            p0_transpose_item(a.in[I_CWOUT], 1024, (h16*)(ws + WS_WCOUT), 0, scr, r, F.lane);
        }
    }
    __syncthreads();
    {
        LAS float* S = (LAS float*)F.lds;
        LAS float* P = (LAS float*)(F.lds + 40960);
        for (int i = F.tid; i < 9 * 1024; i += NTHR) { const int r = i >> 10, k = i & 1023; const float v = r < 8 ? a.in[I_C][r * 1024 + k] : a.in[I_CCTX][k]; S[i] = v / (1.f + expf(-v)); }
        __syncthreads();
        float* MOD = (float*)(ws + WS_MOD);
        for (int it = F.bx; it < 4 * 96; it += F.G) {
            const int l = it / 96, n0 = (it % 96) * 64;
            const float* W = a.in[I_WADA] + (size_t)l * 1024 * 6144 + n0 + F.lane;
            float acc[9];
#pragma unroll
            for (int r = 0; r < 9; ++r) acc[r] = 0.f;
            const int kb = F.wave * 128;
#pragma unroll 4
            for (int k = 0; k < 128; ++k) { const float w = W[(size_t)(kb + k) * 6144];
#pragma unroll
                for (int r = 0; r < 9; ++r) acc[r] += S[r * 1024 + kb + k] * w; }
#pragma unroll
            for (int r = 0; r < 9; ++r) P[(F.wave * 9 + r) * 64 + F.lane] = acc[r];
            __syncthreads();
            for (int o = F.tid; o < 9 * 64; o += NTHR) { const int r = o >> 6, n = o & 63; float s = 0.f;
#pragma unroll
                for (int w = 0; w < 8; ++w) s += P[(w * 9 + r) * 64 + n];
                MOD[((size_t)l * 9 + r) * 6144 + n0 + n] = s + a.in[I_BADA][l * 6144 + n0 + n]; }
            __syncthreads();
        }
    }
    if (F.bx == 0) {
        float* RC = (float*)(ws + WS_SMALL); float* RS = RC + 1024;
        for (int i = F.tid; i < 1024; i += NTHR) { const int pos = i >> 4, f = i & 15; const float inv = powf(10000.f, -(float)(2 * f) / 32.f); const float ang = (float)pos * inv; RC[i] = cosf(ang); RS[i] = sinf(ang); }
    }
    __syncthreads();
    {
        LAS float* ZB = (LAS float*)F.lds;
        LAS float* H1 = ZB + 512;
        LAS float* HB = H1 + 512;
        h16* FILT = (h16*)(ws + WS_FILT);
        const float* f1w = a.in[I_F1W]; const float* f2w = a.in[I_F2W]; const float* f3w = a.in[I_F3W];
        for (int it = F.bx; it < L / 8; it += F.G) {
            const int p0 = it * 8; const int t = p0 + F.wave;
            {
                const float tl = (float)t / (float)(L - 1); const float wang = 2.0f * 3.14159265358979323846f * (float)t / (float)L;
                float zv = 0.f;
                if (F.lane == 0) zv = tl;
                else if (F.lane < 33) { const int q = (F.lane - 1) & 15; const float fq = 1e-4f + (float)q * ((15.0f - 1e-4f) / 15.0f); const float ang = fq * wang; zv = F.lane < 17 ? cosf(ang) : -sinf(ang); }
                ZB[F.wave * 64 + F.lane] = zv;
                LDS_WAIT();
                float s = a.in[I_F1B][F.lane];
                for (int i = 0; i < 33; ++i) s += ZB[F.wave * 64 + i] * f1w[i * 64 + F.lane];
                const float h1 = sinf(a.in[I_F1F][F.lane] * s);
                H1[F.wave * 64 + F.lane] = h1;
                LDS_WAIT();
                float s2 = a.in[I_F2B][F.lane];
                for (int k = 0; k < 64; ++k) s2 += H1[F.wave * 64 + k] * f2w[k * 64 + F.lane];
                HB[F.wave * 64 + F.lane] = sinf(a.in[I_F2F][F.lane] * s2);
            }
            __syncthreads();
            for (int cc = F.wave; cc < 16; cc += 8) {
                const int n = cc * 256 + 4 * F.lane;
                f32x4 acc[8];
#pragma unroll
                for (int p = 0; p < 8; ++p) acc[p] = (f32x4){0.f, 0.f, 0.f, 0.f};
                for (int k = 0; k < 64; ++k) { const f32x4 w = *(const f32x4*)(f3w + (size_t)k * 4096 + n);
#pragma unroll
                    for (int p = 0; p < 8; ++p) acc[p] += w * HB[p * 64 + k]; }
                const int o2 = n >> 10, c0 = n & 1023;
                const float mind = logf(1e-2f) / 1.5f, maxd = logf(1e-2f) / 0.3f;
#pragma unroll
                for (int j = 0; j < 4; ++j) { const int c = c0 + j; const float delta = fabsf(mind + (float)c * ((maxd - mind) / (float)(D - 1)));
                    float o[8];
#pragma unroll
                    for (int p = 0; p < 8; ++p) { const float tl = (float)(p0 + p) / (float)(L - 1); o[p] = acc[p][j] * expf(-tl * delta); }
                    u32x4 w; w.x = pk2h(o[0], o[1]); w.y = pk2h(o[2], o[3]); w.z = pk2h(o[4], o[5]); w.w = pk2h(o[6], o[7]);
                    *(u32x4*)(FILT + ((size_t)(o2 * 1024 + c) * L + p0)) = w; }
            }
            __syncthreads();
        }
    }
}

DI void rows_phase(const Ctx& F, CArgs& a, int nrows, bool copy_in, bool combine, int lmoe, int lnext, bool final_out, bool from_input = false) {
    unsigned char* ws = a.ws;
    float* XC = (float*)(ws + WS_XC); h16* H = (h16*)(ws + WS_H);
    const float* MOD = (const float*)(ws + WS_MOD);
    const int* SLOT = (const int*)(ws + WS_SLOT); const h16* YE = (const h16*)(ws + WS_XIN);
    for (int row = F.gw; row < nrows; row += F.NGW) {
        const int r9 = row < T ? (row >> 11) : 8;
        f32x4 v[4];
        if (copy_in || from_input) { const float* src = row < T ? a.in[I_X] + (size_t)row * D : a.in[I_CTX] + (size_t)(row - T) * D;
#pragma unroll
            for (int j = 0; j < 4; ++j) v[j] = *(const f32x4*)(src + 4 * F.lane + 256 * j); }
        else {
#pragma unroll
            for (int j = 0; j < 4; ++j) v[j] = *(const f32x4*)(XC + (size_t)row * D + 4 * F.lane + 256 * j); }
        if (combine) {
            f32x4 s[4];
#pragma unroll
            for (int j = 0; j < 4; ++j) s[j] = (f32x4){0.f, 0.f, 0.f, 0.f};
            const int myslot = SLOT[(size_t)row * 16 + (F.lane & 15)];
            for (int e = 0; e < 16; ++e) { const int sl = __shfl(myslot, e);
                if (sl >= 0) { const h16* y = YE + (size_t)sl * D + 4 * F.lane;
#pragma unroll
                    for (int j = 0; j < 4; ++j) s[j] += unpack4(*(const u32x2*)(y + 256 * j)); } }
            const float* g2 = MOD + ((size_t)lmoe * 9 + r9) * 6144 + 5120 + 4 * F.lane;
#pragma unroll
            for (int j = 0; j < 4; ++j) v[j] += *(const f32x4*)(g2 + 256 * j) * s[j];
        }
        if (copy_in || combine) {
#pragma unroll
            for (int j = 0; j < 4; ++j) *(f32x4*)(XC + (size_t)row * D + 4 * F.lane + 256 * j) = v[j]; }
        float ss = 0.f;
#pragma unroll
        for (int j = 0; j < 4; ++j) ss += (v[j].x * v[j].x + v[j].y * v[j].y) + (v[j].z * v[j].z + v[j].w * v[j].w);
        const float rstd = 1.0f / sqrtf(wave_sum(ss) * (1.f / D) + 1e-6f);
        if (final_out) {
            if (row < T) {
#pragma unroll
                for (int j = 0; j < 4; ++j) { const f32x4 g = *(const f32x4*)(a.in[I_FG] + 4 * F.lane + 256 * j); *(f32x4*)(a.out + (size_t)row * D + 4 * F.lane + 256 * j) = v[j] * rstd * g; } }
        } else {
            const float* g1 = a.in[I_N1G] + lnext * D + 4 * F.lane; const float* md = MOD + ((size_t)lnext * 9 + r9) * 6144 + 4 * F.lane;
#pragma unroll
            for (int j = 0; j < 4; ++j) { const f32x4 g = *(const f32x4*)(g1 + 256 * j), sh = *(const f32x4*)(md + 256 * j), sc = *(const f32x4*)(md + 1024 + 256 * j);
                const f32x4 h = (v[j] * rstd * g) * (1.f + sc) + sh;
                u32x2 w; w.x = pk2h(h.x, h.y); w.y = pk2h(h.z, h.w); *(u32x2*)(H + (size_t)row * D + 4 * F.lane + 256 * j) = w; }
        }
    }
}


DI void unpack8(const u32x4 w, float (&o)[8]) {
    const half8 h = __builtin_bit_cast(half8, w);
#pragma unroll
    for (int i = 0; i < 8; ++i) o[i] = (float)h[i];
}
DI void cg_load_u(const h16* BCV, int row, int c0, float (&u)[8]) {
    float cg[8], v[8];
    unpack8(*(const u32x4*)(BCV + (size_t)row * 3072 + 1024 + c0), cg); unpack8(*(const u32x4*)(BCV + (size_t)row * 3072 + 2048 + c0), v);
#pragma unroll
    for (int q = 0; q < 8; ++q) u[q] = cg[q] * v[q];
}
DI void convgate_phase(const Ctx& F, CArgs& a, int j, int nrows) {
    const h16* BCV = (const h16*)(a.ws + WS_BIG); h16* Z = (h16*)(a.ws + WS_Z);
    const float* cw = a.in[I_ACONV] + (size_t)j * 3 * D;
    const int nitems = (nrows / 16) * 2;
    for (int it = F.gw; it < nitems; it += F.NGW) {
        const int half = it & 1, r0 = (it >> 1) * 16, c0 = half * 512 + 8 * F.lane;
        const int ls = r0 < T ? L : LC; const int t0 = r0 < T ? (r0 & (L - 1)) : ((r0 - T) & (LC - 1));
        float w0[8], w1[8], w2[8];
#pragma unroll
        for (int q = 0; q < 8; ++q) { w0[q] = cw[c0 + q]; w1[q] = cw[D + c0 + q]; w2[q] = cw[2 * D + c0 + q]; }
        for (int i = 0; i < 16; ++i) {
            const int row = r0 + i, t = t0 + i;
            float up[8], uc[8], un[8];
#pragma unroll
            for (int q = 0; q < 8; ++q) { up[q] = 0.f; un[q] = 0.f; }
            cg_load_u(BCV, row, c0, uc);
            if (t > 0) cg_load_u(BCV, row - 1, c0, up);
            if (t + 1 < ls) cg_load_u(BCV, row + 1, c0, un);
            float bv[8], o[8]; unpack8(*(const u32x4*)(BCV + (size_t)row * 3072 + c0), bv);
#pragma unroll
            for (int q = 0; q < 8; ++q) o[q] = bv[q] * (w0[q] * up[q] + w1[q] * uc[q] + w2[q] * un[q]);
            u32x4 w; w.x = pk2h(o[0], o[1]); w.y = pk2h(o[2], o[3]); w.z = pk2h(o[4], o[5]); w.w = pk2h(o[6], o[7]);
            *(u32x4*)(Z + (size_t)row * D + c0) = w;
        }
    }
}

DI void moe_rows_phase(const Ctx& F, CArgs& a, int l, int nrows) {
    unsigned char* ws = a.ws;
    const float* XC = (const float*)(ws + WS_XC); h16* H = (h16*)(ws + WS_H); const float* MOD = (const float*)(ws + WS_MOD); float* AFF = (float*)(ws + WS_AFF);
    LAS float* WR = (LAS float*)F.lds;
    const float* rt = a.in[I_ROUTER] + (size_t)l * 1024 * 16;
    for (int i = F.tid; i < 16384; i += NTHR) WR[(i & 15) * 1024 + (i >> 4)] = rt[i];
    __syncthreads();
    for (int row = F.gw; row < nrows; row += F.NGW) {
        const int r9 = row < T ? (row >> 11) : 8;
        f32x4 v[4];
#pragma unroll
        for (int j = 0; j < 4; ++j) v[j] = *(const f32x4*)(XC + (size_t)row * D + 4 * F.lane + 256 * j);
        float ss = 0.f;
#pragma unroll
        for (int j = 0; j < 4; ++j) ss += (v[j].x * v[j].x + v[j].y * v[j].y) + (v[j].z * v[j].z + v[j].w * v[j].w);
        const float rstd = 1.0f / sqrtf(wave_sum(ss) * (1.f / D) + 1e-6f);
        const float* g2 = a.in[I_N2G] + l * D + 4 * F.lane; const float* md = MOD + ((size_t)l * 9 + r9) * 6144 + 3072 + 4 * F.lane;
        f32x4 h[4];
#pragma unroll
        for (int j = 0; j < 4; ++j) { const f32x4 g = *(const f32x4*)(g2 + 256 * j), sh = *(const f32x4*)(md + 256 * j), sc = *(const f32x4*)(md + 1024 + 256 * j);
            h[j] = (v[j] * rstd * g) * (1.f + sc) + sh;
            u32x2 w; w.x = pk2h(h[j].x, h[j].y); w.y = pk2h(h[j].z, h[j].w); *(u32x2*)(H + (size_t)row * D + 4 * F.lane + 256 * j) = w; }
        float mylg = -1e30f;
#pragma unroll 1
        for (int e = 0; e < 16; ++e) { float p = 0.f;
#pragma unroll
            for (int j = 0; j < 4; ++j) { const f32x4 w = *(const LAS f32x4*)(WR + e * 1024 + 4 * F.lane + 256 * j); p += (h[j].x * w.x + h[j].y * w.y) + (h[j].z * w.z + h[j].w * w.w); }
            p = wave_sum(p); mylg = (F.lane == e) ? p : mylg; }
        float mx = mylg;
#pragma unroll
        for (int o = 1; o < 16; o <<= 1) mx = fmaxf(mx, __shfl_xor(mx, o));
        const float mine = (F.lane < 16) ? expf(mylg - mx) : 0.f;
        float sum = mine;
#pragma unroll
        for (int o = 1; o < 16; o <<= 1) sum += __shfl_xor(sum, o);
        if (F.lane < 16) {
            const float af = mine / sum;
            if (row < T) AFF[((size_t)(row >> 11) * 16 + F.lane) * L + (row & (L - 1))] = af;
            else { const int rc = row - T; AFF[(size_t)NB * 16 * L + ((size_t)(rc >> 8) * 16 + F.lane) * LC + (rc & (LC - 1))] = af; }
        }
    }
}

DI void topk_phase(const Ctx& F, CArgs& a, int l) {
    unsigned char* ws = a.ws;
    const float* AFF = (const float*)(ws + WS_AFF); int* SLOT = (int*)(ws + WS_SLOT); float* GATE = (float*)(ws + WS_GATE);
    const h16* H = (const h16*)(ws + WS_H); h16* XIN = (h16*)(ws + WS_XIN);
    LAS unsigned long long* KEY = (LAS unsigned long long*)F.lds;
    LAS int* SELR = (LAS int*)(F.lds + 16384);
    const int nitems = 128 + (l == 0 ? 128 : 0);
    for (int it = F.bx; it < nitems; it += F.G) {
        const bool ctx = it >= 128; const int id = it & 127, e = id >> 3, b = id & 7;
        const int N = ctx ? LC : L, cap = ctx ? CAPC : CAP;
        const float* src = ctx ? AFF + (size_t)NB * 16 * L + ((size_t)b * 16 + e) * LC : AFF + ((size_t)b * 16 + e) * L;
        for (int i = F.tid; i < N; i += NTHR) KEY[i] = ((unsigned long long)__float_as_uint(src[i]) << 32) | (unsigned long long)(0xFFFFFFFFu - (unsigned)i);
        __syncthreads();
        for (int k = 2; k <= N; k <<= 1)
            for (int j = k >> 1; j > 0; j >>= 1) {
                for (int idx = F.tid; idx < (N >> 1); idx += NTHR) {
                    const int i = ((idx & ~(j - 1)) << 1) | (idx & (j - 1)), p = i | j;
                    const bool up = (i & k) == 0;
                    const unsigned long long x = KEY[i], y = KEY[p];
                    if ((x > y) == up) { KEY[i] = y; KEY[p] = x; }
                }
                __syncthreads();
            }
        const int gbase = ctx ? NGL + id * CAPC : id * CAP, rowbase = ctx ? T + b * LC : b * L;
        for (int i = F.tid; i < N; i += NTHR) {
            const unsigned long long key = KEY[i]; const int r = N - 1 - i; const int t = (int)(0xFFFFFFFFu - (unsigned)key); const int row = rowbase + t;
            if (r < cap) { SLOT[(size_t)row * 16 + e] = gbase + r; GATE[gbase + r] = __uint_as_float((unsigned)(key >> 32)); SELR[r] = row; }
            else SLOT[(size_t)row * 16 + e] = -1;
        }
        __syncthreads();
        for (int r = F.wave; r < cap; r += NWAVES) { const int row = SELR[r];
            const u32x4* s = (const u32x4*)(H + (size_t)row * D); u32x4* d = (u32x4*)(XIN + (size_t)(gbase + r) * D);
            d[F.lane] = s[F.lane]; d[64 + F.lane] = s[64 + F.lane]; }
        __syncthreads();
    }
}

namespace attn_body {
constexpr int DM = 1024, NW = 8, QBLK = 32, QB = 256, KVBLK = 64, NT = KVR / KVBLK;
DI int crow(int r, int hi) { return (r & 3) + 8 * (r >> 2) + 4 * hi; }
#define SBAR() __builtin_amdgcn_sched_barrier(0)
constexpr int NSLOT = 3, SLOTB = 8192;
constexpr int LDS_K = 0, LDS_V = NSLOT * SLOTB, LDS_WS = 2 * NSLOT * SLOTB, LDS_OST = LDS_WS + NW * 64 * 4, LDS_BYTES_A = LDS_OST + NW * 4096;
DI void glds16(const void* gsrc, unsigned lds_dst) { unsigned keep;
    asm volatile("s_mov_b32 %0, m0\n\ts_mov_b32 m0, %2\n\ts_nop 0\n\tglobal_load_lds_dwordx4 %1, off\n\ts_mov_b32 m0, %0" : "=&s"(keep) : "v"(gsrc), "s"(lds_dst) : "memory"); }
DI float max3f(float a, float b, float c) { float r; asm("v_max3_f32 %0, %1, %2, %3" : "=v"(r) : "v"(a), "v"(b), "v"(c)); return r; }
DI float max2f(float a, float b) { float r; asm("v_max_f32_e32 %0, %1, %2" : "=v"(r) : "v"(a), "v"(b)); return r; }
DI float fadd_s(float a, float b) { float r; asm("v_add_f32_e32 %0, %1, %2" : "=v"(r) : "v"(a), "v"(b)); return r; }
DI float fsub_s(float a, float b) { float r; asm("v_sub_f32_e32 %0, %1, %2" : "=v"(r) : "v"(a), "v"(b)); return r; }
DI unsigned cvtpk_s(float lo, float hi) { return pk2h(lo, hi); }
DI f32x16 MF(s16x8 x, s16x8 y, f32x16 c) { return __builtin_amdgcn_mfma_f32_32x32x16_f16(__builtin_bit_cast(half8, x), __builtin_bit_cast(half8, y), c, 0, 0, 0); }
#define WAIT_BAR(N) asm volatile("s_waitcnt vmcnt(" #N ") lgkmcnt(0)\n\ts_barrier" ::: "memory")
DI void qkt(f32x16& p0, f32x16& p1, const char* Kslot, const s16x8* qr, const f32x16& negm, int r32, int hi) {
    const char* kb = Kslot + hi * 1024 + r32 * 16;
#pragma unroll
    for (int d0 = 0; d0 < 4; ++d0) {
        const s16x8 b0 = *reinterpret_cast<const s16x8*>(kb + d0 * 2048);
        const s16x8 b1 = *reinterpret_cast<const s16x8*>(kb + d0 * 2048 + 512);
        if (d0 == 0) { p0 = MF(b0, qr[0], negm); p1 = MF(b1, qr[0], negm); }
        else { p0 = MF(b0, qr[d0], p0); p1 = MF(b1, qr[d0], p1); } }
}
typedef __attribute__((address_space(3))) const char* lds_cptr;
typedef short v4i16_t __attribute__((ext_vector_type(4)));
DI void kload8(s16x8* kf, lds_cptr kp) {
    kf[0] = *(const LAS s16x8*)(kp);        kf[1] = *(const LAS s16x8*)(kp + 512);
    kf[2] = *(const LAS s16x8*)(kp + 2048); kf[3] = *(const LAS s16x8*)(kp + 2560);
    kf[4] = *(const LAS s16x8*)(kp + 4096); kf[5] = *(const LAS s16x8*)(kp + 4608);
    kf[6] = *(const LAS s16x8*)(kp + 6144); kf[7] = *(const LAS s16x8*)(kp + 6656);
}
DI void kload2(s16x8* kf, lds_cptr kp, int j) { kf[2 * j] = *(const LAS s16x8*)(kp + j * 2048); kf[2 * j + 1] = *(const LAS s16x8*)(kp + j * 2048 + 512); }
DI s16x4 vtr(lds_cptr p) { return __builtin_bit_cast(s16x4, __builtin_amdgcn_ds_read_tr16_b64_v4i16((LAS v4i16_t*)p)); }
DI float rowmax(const f32x16& p0, const f32x16& p1) {
    float a = max3f(p0[0], p0[1], p1[0]), b = max3f(p0[2], p0[3], p1[1]); a = max3f(a, p1[2], p1[3]);
#pragma unroll
    for (int r = 4; r < 16; r += 4) { a = max3f(a, p0[r], p0[r + 1]); b = max3f(b, p0[r + 2], p0[r + 3]); a = max3f(a, p1[r], p1[r + 1]); b = max3f(b, p1[r + 2], p1[r + 3]); }
    const float m = max2f(a, b);
    auto rr = __builtin_amdgcn_permlane32_swap(__float_as_uint(m), __float_as_uint(m), false, false);
    return max2f(__uint_as_float(rr[0]), __uint_as_float(rr[1]));
}
DI void pv(f32x16* o, int vb, s16x8 pa0, s16x8 pa1, s16x8 pa2, s16x8 pa3) {
#pragma unroll
    for (int d0 = 0; d0 < 2; ++d0) { s16x4 lo[4], hi[4];
#pragma unroll
        for (int ks = 0; ks < 4; ++ks) {
            asm volatile("ds_read_b64_tr_b16 %0,%1 offset:%c2" : "=&v"(lo[ks]) : "v"(vb), "i"(d0 * 4096 + ks * 1024) : "memory");
            asm volatile("ds_read_b64_tr_b16 %0,%1 offset:%c2" : "=&v"(hi[ks]) : "v"(vb), "i"(d0 * 4096 + ks * 1024 + 512) : "memory"); }
        asm volatile("s_waitcnt lgkmcnt(0)" ::: "memory"); SBAR();
#define PK(k) (s16x8){lo[k][0], lo[k][1], lo[k][2], lo[k][3], hi[k][0], hi[k][1], hi[k][2], hi[k][3]}
        o[d0] = MF(pa0, PK(0), o[d0]);
        o[d0] = MF(pa1, PK(1), o[d0]);
        o[d0] = MF(pa2, PK(2), o[d0]);
        o[d0] = MF(pa3, PK(3), o[d0]);
#undef PK
    }
}
template <int THRL> DI void attn_unit(const int tid, const hf* Qw0, const hf* __restrict__ Kh, const hf* __restrict__ Vh, hf* Ow0, char* shm) {
    const int lane = tid & 63, r32 = lane & 31, hi = lane >> 5; const int wid = __builtin_amdgcn_readfirstlane(tid >> 6);
    const hf* Qw = Qw0 + (long)(wid * QBLK) * DM;
    const unsigned lds0 = (unsigned)(uintptr_t)shm;
    float* wsf = (float*)(shm + LDS_WS) + wid * 64;
    const hf* ksrc = Kh + (long)lane * DM + wid * 8;
    const hf* vsrc = Vh + (long)(16 * (wid & 3) + (lane >> 2)) * DM + (wid >> 2) * 32 + (lane & 3) * 8;
    const unsigned kdst = lds0 + LDS_K + wid * 1024, vdst = lds0 + LDS_V + wid * 1024;
#define DMA_K(t, slot) glds16(ksrc + (long)(t) * KVBLK * DM, (unsigned)__builtin_amdgcn_readfirstlane(kdst + (slot)))
#define DMA_V(t, slot) glds16(vsrc + (long)(t) * KVBLK * DM, (unsigned)__builtin_amdgcn_readfirstlane(vdst + (slot)))
    const int vb0 = (int)(lds0 + LDS_V) + ((lane >> 4) & 1) * 32 + (lane & 3) * 8 + (4 * hi + ((lane & 15) >> 2)) * 64;
    const char* Kbase = shm + LDS_K; s16x8 kf[8];
    const lds_cptr shm3 = (lds_cptr)shm; const lds_cptr kp0 = shm3 + LDS_K + hi * 1024 + r32 * 16; const lds_cptr vp0 = shm3 + LDS_V + ((lane >> 4) & 1) * 32 + (lane & 3) * 8 + (4 * hi + ((lane & 15) >> 2)) * 64;
    DMA_K(0, 0); DMA_V(0, 0); DMA_K(1, SLOTB);
    s16x8 qr[4];
#pragma unroll
    for (int d0 = 0; d0 < 4; ++d0) qr[d0] = *reinterpret_cast<const s16x8*>(&Qw[(long)r32 * DM + d0 * 16 + hi * 8]);
    float mhat = 0.f, l_reg = 0.f; f32x16 o[2]; o[0] = f32x16{}; o[1] = f32x16{}; f32x16 negm = f32x16{}; asm volatile("" : "+v"(negm));
    bool resc = false;
#define START(P0, P1) do { const float rm = rowmax(P0, P1); resc = false; \
    { const float dl = rm; mhat = fadd_s(mhat, dl); \
      _Pragma("unroll") for (int r = 0; r < 16; ++r) { P0[r] = fsub_s(P0[r], dl); P1[r] = fsub_s(P1[r], dl); } \
      _Pragma("unroll") for (int r = 0; r < 16; ++r) negm[r] = -mhat; asm volatile("" : "+v"(negm)); } \
    _Pragma("unroll") for (int r = 0; r < 16; ++r) P0[r] = __builtin_amdgcn_exp2f(P0[r]); } while (0)
#define RESC() do { if (resc) { asm volatile("s_waitcnt lgkmcnt(0)" ::: "memory"); \
      _Pragma("unroll") for (int d_ = 0; d_ < 2; ++d_) _Pragma("unroll") for (int r = 0; r < 16; ++r) o[d_][r] *= wsf[crow(r, hi)]; } } while (0)
    f32x16 pA0, pA1, pB0, pB1;
    int sl_prev = 0, sl_cur = 0, sl_next = SLOTB;
#define ROT() do { sl_prev = sl_cur; sl_cur = sl_next; sl_next = (sl_next == (NSLOT - 1) * SLOTB) ? 0 : sl_next + SLOTB; } while (0)
    DMA_K(2, 2 * SLOTB);
    WAIT_BAR(3);
    qkt(pA0, pA1, Kbase, qr, negm, r32, hi); asm volatile("s_nop 15\n\ts_nop 7" : "+v"(pA0), "+v"(pA1));
    START(pA0, pA1);
    _Pragma("unroll") for (int r = 0; r < 16; ++r) pA1[r] = __builtin_amdgcn_exp2f(pA1[r]);
    WAIT_BAR(0);
    DMA_K(3, 0); DMA_V(1, SLOTB);
    ROT();
    kload8(kf, kp0 + sl_cur);
    WAIT_BAR(2);
    s16x4 vlo[8], vhi[8]; u32x4 pw0, pw1, pw2, pw3;
#define PKW(P, B) cvtpk_s(P[B], P[B + 1])
#define PAF(k) __builtin_bit_cast(s16x8, pw##k)
#define VFR(i) (s16x8){vlo[i][0], vlo[i][1], vlo[i][2], vlo[i][3], vhi[i][0], vhi[i][1], vhi[i][2], vhi[i][3]}
#define PIN(x) asm volatile("" : "+v"(x))
#define MX3(a, b, c) __builtin_fmaxf(__builtin_fmaxf((a), (b)), (c))
#define GAPA(MFX, A0, A1, A2, A3, W0, W1, PW) do { MFX; sacc += A0; sacc += A1; sacc += A2; sacc += A3; PIN(sacc); W0; W1; PIN(PW); SBAR(); } while (0)
#define EX(v) __builtin_amdgcn_exp2f(v)
#define GAPB(MFX, X, B) do { MFX; X[B] = EX(X[B]); X[B + 1] = EX(X[B + 1]); X[B + 2] = EX(X[B + 2]); X[B + 3] = EX(X[B + 3]); PIN(X); SBAR(); } while (0)
#define VRD(i) do { vlo[i] = vtr(vp_ + (((i) >> 2) * 4096 + ((i) & 3) * 1024)); vhi[i] = vtr(vp_ + (((i) >> 2) * 4096 + ((i) & 3) * 1024 + 512)); } while (0)
#define KRD(G, j) do { if (G) { kload2(kf, kp0 + sl_next, j); SBAR(); } } while (0)
#define STEP(C0, C1, P0, P1, t, GK, GV, GL) do { SBAR(); \
    const lds_cptr vp_ = vp0 + sl_prev; \
    VRD(0); SBAR(); float sacc = (P0[0] + P0[1]); \
    GAPA(C0 = MF(kf[0], qr[0], negm), P0[2], P0[3], P0[4], P0[5],     pw0[0] = PKW(P0, 0), pw0[1] = PKW(P0, 2), pw0); \
    VRD(4); SBAR(); GAPA(C1 = MF(kf[1], qr[0], negm), P0[6], P0[7], P0[8], P0[9],     pw0[2] = PKW(P0, 4), pw0[3] = PKW(P0, 6), pw0); \
    VRD(1); SBAR(); GAPA(C0 = MF(kf[2], qr[1], C0),   P0[10], P0[11], P0[12], P0[13], pw1[0] = PKW(P0, 8), pw1[1] = PKW(P0, 10), pw1); \
    VRD(5); SBAR(); GAPA(C1 = MF(kf[3], qr[1], C1),   P0[14], P0[15], P1[0], P1[1],   pw1[2] = PKW(P0, 12), pw1[3] = PKW(P0, 14), pw1); \
    VRD(2); SBAR(); GAPA(C0 = MF(kf[4], qr[2], C0),   P1[2], P1[3], P1[4], P1[5],     pw2[0] = PKW(P1, 0), pw2[1] = PKW(P1, 2), pw2); \
    VRD(6); SBAR(); GAPA(C1 = MF(kf[5], qr[2], C1),   P1[6], P1[7], P1[8], P1[9],     pw2[2] = PKW(P1, 4), pw2[3] = PKW(P1, 6), pw2); \
    VRD(3); SBAR(); GAPA(C0 = MF(kf[6], qr[3], C0),   P1[10], P1[11], P1[12], P1[13], pw3[0] = PKW(P1, 8), pw3[1] = PKW(P1, 10), pw3); \
    VRD(7); SBAR(); GAPA(C1 = MF(kf[7], qr[3], C1),   P1[14], P1[15], 0.f, 0.f,       pw3[2] = PKW(P1, 12), pw3[3] = PKW(P1, 14), pw3); \
    l_reg += sacc; \
    if (GK) { DMA_K((t) + 3, sl_cur); } if (GV) { DMA_V((t) + 1, sl_next); } \
    { float a = MX3(C0[0], C0[1], C1[0]), b = MX3(C0[2], C0[3], C1[1]); a = MX3(a, C1[2], C1[3]); \
      _Pragma("unroll") for (int r = 4; r < 16; r += 4) { a = MX3(a, C0[r], C0[r + 1]); b = MX3(b, C0[r + 2], C0[r + 3]); a = MX3(a, C1[r], C1[r + 1]); b = MX3(b, C1[r + 2], C1[r + 3]); } \
      float rm = __builtin_fmaxf(a, b); { auto rr = __builtin_amdgcn_permlane32_swap(__float_as_uint(rm), __float_as_uint(rm), false, false); rm = __builtin_fmaxf(__uint_as_float(rr[0]), __uint_as_float(rr[1])); } \
      resc = false; \
      if (__builtin_expect(__any(rm > (float)THRL), 0)) { const float dl = __builtin_fmaxf(rm, 0.f); mhat += dl; \
        _Pragma("unroll") for (int r = 0; r < 16; ++r) { C0[r] -= dl; C1[r] -= dl; } \
        _Pragma("unroll") for (int r = 0; r < 16; ++r) negm[r] = -mhat; asm volatile("" : "+v"(negm)); \
        const float f = __builtin_amdgcn_exp2f(-dl); l_reg *= f; if (hi == 0) wsf[r32] = f; resc = true; } } \
    SBAR(); \
    GAPB(o[0] = MF(PAF(0), VFR(0), o[0]), C0, 0); \
    GAPB(o[1] = MF(PAF(0), VFR(4), o[1]), C0, 4); \
    KRD(GL, 0); GAPB(o[0] = MF(PAF(1), VFR(1), o[0]), C0, 8); \
    KRD(GL, 1); GAPB(o[1] = MF(PAF(1), VFR(5), o[1]), C0, 12); \
    KRD(GL, 2); GAPB(o[0] = MF(PAF(2), VFR(2), o[0]), C1, 0); \
    KRD(GL, 3); GAPB(o[1] = MF(PAF(2), VFR(6), o[1]), C1, 4); \
    GAPB(o[0] = MF(PAF(3), VFR(3), o[0]), C1, 8); \
    GAPB(o[1] = MF(PAF(3), VFR(7), o[1]), C1, 12); \
    } while (0)
    int t = 1;
    for (; t + 5 < NT; t += 2) {
        STEP(pB0, pB1, pA0, pA1, t, true, true, true);     WAIT_BAR(2); RESC(); ROT();
        STEP(pA0, pA1, pB0, pB1, t + 1, true, true, true); WAIT_BAR(2); RESC(); ROT();
    }
#define ENDW(tt) do { if ((tt) + 3 < NT) { WAIT_BAR(2); } else if ((tt) + 2 < NT) { WAIT_BAR(1); } else { WAIT_BAR(0); } } while (0)
    for (; t + 1 < NT; t += 2) {
        STEP(pB0, pB1, pA0, pA1, t, (t + 3 < NT), (t + 1 < NT), (t + 1 < NT));         ENDW(t);     RESC(); ROT();
        STEP(pA0, pA1, pB0, pB1, t + 1, (t + 4 < NT), (t + 2 < NT), (t + 2 < NT));     ENDW(t + 1); RESC(); ROT();
    }
    STEP(pB0, pB1, pA0, pA1, NT - 1, false, false, false); RESC();
    { float sacc = pB0[0] + pB0[1]; _Pragma("unroll") for (int r = 2; r < 16; ++r) sacc += pB0[r]; _Pragma("unroll") for (int r = 0; r < 16; ++r) sacc += pB1[r]; l_reg += sacc;
      pw0 = (u32x4){PKW(pB0, 0), PKW(pB0, 2), PKW(pB0, 4), PKW(pB0, 6)}; pw1 = (u32x4){PKW(pB0, 8), PKW(pB0, 10), PKW(pB0, 12), PKW(pB0, 14)}; pw2 = (u32x4){PKW(pB1, 0), PKW(pB1, 2), PKW(pB1, 4), PKW(pB1, 6)}; pw3 = (u32x4){PKW(pB1, 8), PKW(pB1, 10), PKW(pB1, 12), PKW(pB1, 14)};
      SBAR(); pv(o, vb0 + sl_cur, PAF(0), PAF(1), PAF(2), PAF(3)); }
#undef PKW
#undef PAF
#undef VFR
#undef PIN
#undef MX3
#undef GAPA
#undef GAPB
#undef EX
#undef VRD
#undef KRD
#undef STEP
#undef ENDW
    { auto rr = __builtin_amdgcn_permlane32_swap(__float_as_uint(l_reg), __float_as_uint(l_reg), false, false); l_reg = __uint_as_float(rr[0]) + __uint_as_float(rr[1]); }
    if (hi == 0) wsf[32 + r32] = l_reg; asm volatile("s_waitcnt lgkmcnt(0)" ::: "memory");
    float rli[16];
#pragma unroll
    for (int r = 0; r < 16; ++r) rli[r] = __builtin_amdgcn_rcpf(wsf[32 + crow(r, hi)]);
    hf* Ow = Ow0 + (long)(wid * QBLK) * DM;
    { hf* stg = (hf*)(shm + LDS_OST) + wid * 2048;
#pragma unroll
      for (int r = 0; r < 16; ++r) { const int orow = crow(r, hi);
#pragma unroll
        for (int d0 = 0; d0 < 2; ++d0) stg[orow * 64 + d0 * 32 + r32] = (hf)(o[d0][r] * rli[r]); }
      asm volatile("s_waitcnt lgkmcnt(0)" ::: "memory");
#pragma unroll
      for (int i = 0; i < 4; ++i) { const int row = i * 8 + (lane >> 3), ch = lane & 7; const u32x4 v = *(const u32x4*)(stg + row * 64 + ch * 8); *(u32x4*)(Ow + (long)row * DM + ch * 8) = v; } }
    asm volatile("s_waitcnt lgkmcnt(0)\n\ts_barrier" ::: "memory");
#undef DMA_K
#undef DMA_V
#undef START
#undef RESC
#undef ROT
}
#undef SBAR
#undef WAIT_BAR
}

DI void attn_phase(const Ctx& F, CArgs& a) {
    unsigned char* ws = a.ws;
    const hf* Q = (const hf*)(ws + WS_BIG); const hf* Kb = Q + (size_t)T * D; const hf* Vb = Kb + (size_t)NB * KVR * D;
    hf* OP = (hf*)(ws + WS_XIN);
    for (int i = 0;; ++i) {
        const long U = (long)i * F.G + F.vcu; if (U >= 2048) break;
        const int qb = (int)(U & 7), bv = (int)(U >> 3), b = bv >> 5, vh32 = bv & 31, hh = vh32 >> 2, r = (vh32 >> 1) & 1, vh = vh32 & 1;
        const int qcol = hh * 128 + r * 64, vcol = hh * 128 + vh * 64;
        const hf* Qw0 = Q + ((size_t)b * L + (size_t)qb * 256) * D + qcol;
        const hf* Kh = Kb + (size_t)b * KVR * D + qcol; const hf* Vh = Vb + (size_t)b * KVR * D + vcol;
        hf* Ow0 = OP + (size_t)r * T * D + ((size_t)b * L + (size_t)qb * 256) * D + vcol;
        attn_body::attn_unit<8>(F.tid, Qw0, Kh, Vh, Ow0, (char*)F.lds);
    }
}

DI void attn_post_phase(const Ctx& F, CArgs& a) {
    unsigned char* ws = a.ws;
    const h16* O0 = (const h16*)(ws + WS_XIN); const h16* O1 = O0 + (size_t)T * D; h16* ON = (h16*)(ws + WS_Z);
    const float lam_init = 0.35550907f;
    const float l1 = wave_sum(a.in[I_LQ1][F.lane] * a.in[I_LK1][F.lane]), l2 = wave_sum(a.in[I_LQ2][F.lane] * a.in[I_LK2][F.lane]);
    const float lam = expf(l1) - expf(l2) + lam_init;
    float g[16];
#pragma unroll
    for (int i = 0; i < 16; ++i) g[i] = a.in[I_SUBG][(F.lane & 7) * 16 + i] * (1.f - lam_init);
    for (int row = F.gw; row < T; row += F.NGW) {
        const size_t off = (size_t)row * D + 16 * F.lane;
        float x0[8], x1[8], y0[8], y1[8];
        unpack8(*(const u32x4*)(O0 + off), x0); unpack8(*(const u32x4*)(O0 + off + 8), x1);
        unpack8(*(const u32x4*)(O1 + off), y0); unpack8(*(const u32x4*)(O1 + off + 8), y1);
        float o[16]; float ss = 0.f;
#pragma unroll
        for (int i = 0; i < 8; ++i) { o[i] = x0[i] - lam * y0[i]; o[8 + i] = x1[i] - lam * y1[i]; }
#pragma unroll
        for (int i = 0; i < 16; ++i) ss += o[i] * o[i];
        ss += __shfl_xor(ss, 1); ss += __shfl_xor(ss, 2); ss += __shfl_xor(ss, 4);
        const float rstd = 1.0f / sqrtf(ss * (1.f / 128.f) + 1e-5f);
        u32x4 w0, w1;
        w0.x = pk2h(o[0] * rstd * g[0], o[1] * rstd * g[1]); w0.y = pk2h(o[2] * rstd * g[2], o[3] * rstd * g[3]); w0.z = pk2h(o[4] * rstd * g[4], o[5] * rstd * g[5]); w0.w = pk2h(o[6] * rstd * g[6], o[7] * rstd * g[7]);
        w1.x = pk2h(o[8] * rstd * g[8], o[9] * rstd * g[9]); w1.y = pk2h(o[10] * rstd * g[10], o[11] * rstd * g[11]); w1.z = pk2h(o[12] * rstd * g[12], o[13] * rstd * g[13]); w1.w = pk2h(o[14] * rstd * g[14], o[15] * rstd * g[15]);
        *(u32x4*)(ON + off) = w0; *(u32x4*)(ON + off + 8) = w1;
    }
}

namespace hy {
constexpr int VPS = 2568;
constexpr int OFF_SA = 0, OFF_VP = 65536, OFF_G = OFF_VP + 8 * VPS * 2, OFF_RG = OFF_G + 32768, OFF_END = OFF_RG + 8192;
static_assert(OFF_END <= LDS_CTL_OFF, "hyena LDS map");
DI f32x16 MF(s16x8 x, s16x8 y, f32x16 c) { return __builtin_amdgcn_mfma_f32_32x32x16_f16(__builtin_bit_cast(half8, x), __builtin_bit_cast(half8, y), c, 0, 0, 0); }
DI int crow(int r, int hi) { return (r & 3) + 8 * (r >> 2) + 4 * hi; }

DI void load_conv3(const h16* UT, const float* cconv, int chr, LAS h16* dst, int pitch, int tid) {
    const int b = tid >> 6, t0 = (tid & 63) * 32;
    const h16* src = UT + (size_t)chr * T + (size_t)b * L + t0;
    const float w0 = cconv[chr], w1 = cconv[3072 + chr], w2 = cconv[2 * 3072 + chr];
    float u[34];
    u[0] = t0 > 0 ? h2f(src[-1]) : 0.f; u[33] = t0 + 32 < L ? h2f(src[32]) : 0.f;
#pragma unroll
    for (int q = 0; q < 4; ++q) { float tmp[8]; unpack8(*(const u32x4*)(src + 8 * q), tmp);
#pragma unroll
        for (int e = 0; e < 8; ++e) u[1 + 8 * q + e] = tmp[e]; }
#pragma unroll
    for (int q = 0; q < 4; ++q) { float o[8];
#pragma unroll
        for (int e = 0; e < 8; ++e) { const int i = 8 * q + e; o[e] = w0 * u[i] + w1 * u[i + 1] + w2 * u[i + 2]; }
        u32x4 w; w.x = pk2h(o[0], o[1]); w.y = pk2h(o[2], o[3]); w.z = pk2h(o[4], o[5]); w.w = pk2h(o[6], o[7]);
        *(LAS u32x4*)(dst + b * pitch + t0 + 8 * q) = w; }
}
DI void build_rg(const h16* hfw, const h16* hbw, LAS h16* RG, int tid) {
#pragma unroll
    for (int e = 0; e < 8; ++e) { const int idx = tid * 8 + e; h16 v = 0; if (idx >= 1 && idx <= L) v = hfw[L - idx]; else if (idx > L) v = hbw[idx - L]; RG[idx] = v; }
}
DI void build_sa(const LAS h16* RG, LAS unsigned char* SA, int tid) {
#pragma unroll
    for (int i = 0; i < 8; ++i) { const int q = tid + NTHR * i; unsigned short v[8];
#pragma unroll
        for (int e = 0; e < 8; ++e) v[e] = (q + e < 4096) ? RG[q + e] : (unsigned short)0;
        u32x4 w; w.x = v[0] | ((unsigned)v[1] << 16); w.y = v[2] | ((unsigned)v[3] << 16); w.z = v[4] | ((unsigned)v[5] << 16); w.w = v[6] | ((unsigned)v[7] << 16);
        *(LAS u32x4*)(SA + q * 16) = w; }
}
DI void toeplitz(const LAS unsigned char* SA, const LAS h16* VP, int wave, int lane, f32x16 (&acc)[2]) {
    const int i = lane & 31, hi = lane >> 5, n = lane & 31, b = n >> 2, q = n & 3;
    const int dlo = 256 * wave - 2016;
    const LAS unsigned char* ap = SA + (L - dlo + 8 * hi - i) * 16;
    const LAS h16* bp0 = VP + b * VPS + 256 + (128 * (2 * wave) + 32 * q - dlo) + 8 * hi;
    const LAS h16* bp1 = bp0 + 128;
    acc[0] = f32x16{}; acc[1] = f32x16{};
#pragma unroll 2
    for (int d = 0; d < 71; ++d) {
        const s16x8 a0 = *(const LAS s16x8*)(ap - d * 512), a1 = *(const LAS s16x8*)(ap - d * 512 + 256);
        const s16x8 b00 = *(const LAS s16x8*)(bp0 - d * 32), b01 = *(const LAS s16x8*)(bp0 - d * 32 + 16);
        const s16x8 b10 = *(const LAS s16x8*)(bp1 - d * 32), b11 = *(const LAS s16x8*)(bp1 - d * 32 + 16);
        acc[0] = MF(a0, b00, acc[0]); acc[1] = MF(a0, b10, acc[1]);
        acc[0] = MF(a1, b01, acc[0]); acc[1] = MF(a1, b11, acc[1]);
    }
}
}

DI void hyconv_phase(const Ctx& F, CArgs& a) {
    using namespace hy;
    unsigned char* ws = a.ws;
    const h16* UT = (const h16*)(ws + WS_BIG); h16* ZT = (h16*)(ws + WS_XIN); const h16* FILT = (const h16*)(ws + WS_FILT);
    const float* cconv = a.in[I_CCONV]; const float* skip = a.in[I_SKIP];
    LAS unsigned char* SA = F.lds + OFF_SA; LAS h16* VP = (LAS h16*)(F.lds + OFF_VP); LAS h16* GB = (LAS h16*)(F.lds + OFF_G); LAS h16* RG = (LAS h16*)(F.lds + OFF_RG);
    for (int i = F.tid; i < 8 * 512; i += NTHR) { const int b = i >> 9, p = i & 511; VP[b * VPS + (p < 256 ? p : 2048 + p)] = 0; }
    const int lane = F.lane, hi = lane >> 5, n = lane & 31, bq = n >> 2, q = n & 3;
    for (int ch = F.bx; ch < D; ch += F.G) {
        __syncthreads();
        load_conv3(UT, cconv, ch, GB, L, F.tid);
        load_conv3(UT, cconv, 2048 + ch, VP + 256, VPS, F.tid);
        build_rg(FILT + (size_t)(0 * 1024 + ch) * L, FILT + (size_t)(1 * 1024 + ch) * L, RG, F.tid);
        __syncthreads();
        build_sa(RG, SA, F.tid);
        __syncthreads();
        f32x16 acc[2];
        toeplitz(SA, VP, F.wave, lane, acc);
        const float sk0 = skip[ch], sk1 = skip[1024 + ch];
        u32x2 z1p[2][4];
#pragma unroll
        for (int tau = 0; tau < 2; ++tau)
#pragma unroll
            for (int g4 = 0; g4 < 4; ++g4) { const int t = 128 * (2 * F.wave + tau) + 32 * q + 8 * g4 + 4 * hi;
                const f32x4 vv = unpack4(*(const LAS u32x2*)(VP + bq * VPS + 256 + t)); const f32x4 xx = unpack4(*(const LAS u32x2*)(GB + bq * L + t));
                const float o0 = xx[0] * (acc[tau][4 * g4 + 0] + vv[0] * sk0); const float o1 = xx[1] * (acc[tau][4 * g4 + 1] + vv[1] * sk0);
                const float o2 = xx[2] * (acc[tau][4 * g4 + 2] + vv[2] * sk0); const float o3 = xx[3] * (acc[tau][4 * g4 + 3] + vv[3] * sk0);
                z1p[tau][g4].x = pk2h(o0, o1); z1p[tau][g4].y = pk2h(o2, o3); }
        __syncthreads();
#pragma unroll
        for (int tau = 0; tau < 2; ++tau)
#pragma unroll
            for (int g4 = 0; g4 < 4; ++g4) { const int t = 128 * (2 * F.wave + tau) + 32 * q + 8 * g4 + 4 * hi; *(LAS u32x2*)(VP + bq * VPS + 256 + t) = z1p[tau][g4]; }
        load_conv3(UT, cconv, 1024 + ch, GB, L, F.tid);
        build_rg(FILT + (size_t)(2 * 1024 + ch) * L, FILT + (size_t)(3 * 1024 + ch) * L, RG, F.tid);
        __syncthreads();
        build_sa(RG, SA, F.tid);
        __syncthreads();
        toeplitz(SA, VP, F.wave, lane, acc);
#pragma unroll
        for (int tau = 0; tau < 2; ++tau)
#pragma unroll
            for (int g4 = 0; g4 < 4; ++g4) { const int t = 128 * (2 * F.wave + tau) + 32 * q + 8 * g4 + 4 * hi;
                const f32x4 vv = unpack4(*(const LAS u32x2*)(VP + bq * VPS + 256 + t)); const f32x4 xx = unpack4(*(const LAS u32x2*)(GB + bq * L + t));
                const float o0 = xx[0] * (acc[tau][4 * g4 + 0] + vv[0] * sk1); const float o1 = xx[1] * (acc[tau][4 * g4 + 1] + vv[1] * sk1);
                const float o2 = xx[2] * (acc[tau][4 * g4 + 2] + vv[2] * sk1); const float o3 = xx[3] * (acc[tau][4 * g4 + 3] + vv[3] * sk1);
                u32x2 w; w.x = pk2h(o0, o1); w.y = pk2h(o2, o3);
                *(u32x2*)(ZT + (size_t)ch * T + (size_t)bq * L + t) = w; }
    }
}

DI void trans_phase(const Ctx& F, CArgs& a) {
    const h16* ZT = (const h16*)(a.ws + WS_XIN); h16* Z = (h16*)(a.ws + WS_Z);
    LAS h16* tile = (LAS h16*)(F.lds + F.wave * 16384);
    const int nitems = (D / 64) * (T / 64);
    for (int it = F.gw; it < nitems; it += F.NGW) {
        const int cb = it & 15, tb = it >> 4, c0 = cb * 64, t0 = tb * 64;
#pragma unroll
        for (int i = 0; i < 8; ++i) { const int c = (F.lane >> 3) + 8 * i, ck = F.lane & 7; const u32x4 w = *(const u32x4*)(ZT + (size_t)(c0 + c) * T + t0 + 8 * ck); *(LAS u32x4*)(tile + c * 72 + 8 * ck) = w; }
        LDS_WAIT(); asm volatile("" ::: "memory");
#pragma unroll
        for (int i = 0; i < 8; ++i) { const int t = (F.lane >> 3) + 8 * i, ck = F.lane & 7; unsigned short v[8];
#pragma unroll
            for (int e = 0; e < 8; ++e) v[e] = tile[(8 * ck + e) * 72 + t];
            u32x4 w; w.x = v[0] | ((unsigned)v[1] << 16); w.y = v[2] | ((unsigned)v[3] << 16); w.z = v[4] | ((unsigned)v[5] << 16); w.w = v[6] | ((unsigned)v[7] << 16);
            *(u32x4*)(Z + (size_t)(t0 + t) * D + c0 + 8 * ck) = w; }
        LDS_WAIT(); asm volatile("" ::: "memory");
    }
}

enum { K_PRO = 0, K_ROWS, K_GIN, K_CONVGATE, K_GOUT, K_MOEROWS, K_TOPK, K_GMOE1, K_GMOE2, K_GQKV, K_ATTN, K_ATTNPOST, K_GHYIN, K_HYCONV, K_TRANS };
constexpr int NPHASE = 36;
DI void phase_desc(int ph, int& kind, int& layer) {
    if (ph == 0) { kind = K_PRO; layer = 0; return; }
    if (ph == 1) { kind = K_ROWS; layer = -1; return; }
    int l, r;
    if (ph < 10) { l = 0; r = ph - 2; } else if (ph < 19) { l = 1; r = ph - 10; } else if (ph < 28) { l = 2; r = ph - 19; } else { l = 3; r = ph - 28; }
    layer = l;
    const int nmix = (l == 1) ? 4 : (l == 2 ? 4 : 3);
    if (r >= nmix) { const int m = r - nmix; kind = m == 0 ? K_MOEROWS : m == 1 ? K_TOPK : m == 2 ? K_GMOE1 : m == 3 ? K_GMOE2 : K_ROWS; return; }
    if (l == 0 || l == 3) kind = r == 0 ? K_GIN : r == 1 ? K_CONVGATE : K_GOUT;
    else if (l == 1) kind = r == 0 ? K_GQKV : r == 1 ? K_ATTN : r == 2 ? K_ATTNPOST : K_GOUT;
    else kind = r == 0 ? K_GHYIN : r == 1 ? K_HYCONV : r == 2 ? K_TRANS : K_GOUT;
}

__global__ void __launch_bounds__(NTHR, 2) mk_fwd(Args a_) {
    extern __shared__ __attribute__((aligned(16))) unsigned char lds_raw[];
    cg::grid_group grid = cg::this_grid();
    const int ph_lo = a_.ph_lo, ph_hi = a_.ph_hi;
    { volatile LAS unsigned* st0 = (volatile LAS unsigned*)((LAS unsigned char*)lds_raw + LDS_CTL_OFF); if (threadIdx.x < 16) st0[threadIdx.x] = 0u; }
    __syncthreads();
    XcdBarrier xbar = xcd_barrier_post((unsigned*)(a_.ws + WS_CTL) + 4096, (volatile LAS unsigned*)((LAS unsigned char*)lds_raw + LDS_CTL_OFF));
    bool first_sync = true;
    for (int ph = ph_lo; ph < ph_hi; ++ph) {
        Ctx F;
        { int tid_ = threadIdx.x; asm volatile("" : "+v"(tid_)); int bx = blockIdx.x; asm volatile("" : "+s"(bx));
          F.lds = (LAS unsigned char*)lds_raw; F.tid = tid_; F.lane = tid_ & 63; F.wave = __builtin_amdgcn_readfirstlane(tid_ >> 6);
          int G_ = gridDim.x; asm volatile("" : "+s"(G_)); F.G = G_; F.bx = bx; F.vcu = (F.G % 8 == 0) ? (bx % 8) * (F.G / 8) + bx / 8 : bx;
          F.gw = F.vcu * NWAVES + F.wave; F.NGW = F.G * NWAVES; }
        CArgs* apl = (CArgs*)__builtin_amdgcn_kernarg_segment_ptr(); asm volatile("" : "+s"(apl)); CArgs& a = *apl;
        unsigned char* ws = a.ws;
        int kind, l; phase_desc(ph, kind, l);
        const bool dbg_final = (ph > DBG_STOP);
        if (dbg_final && ph != NPHASE - 1) continue;
        if (dbg_final) { kind = K_ROWS; }
#ifdef ONLY_KIND
        kind = ONLY_KIND;
#endif
        switch (kind) {
        case K_PRO: p0_prologue(F, a); break;
        case K_ROWS: {
            const bool first = (l < 0) && !dbg_final, fin = dbg_final || l == 3;
            const int lm = l < 0 ? 0 : l;
            rows_phase(F, a, (first || lm == 0) && !dbg_final ? TT : T, first, !first && !dbg_final, lm, lm + (first ? 0 : 1), fin, dbg_final && DBG_CHECK);
        } break;
        case K_GIN: { const int j = l == 0 ? 0 : 1;
            pg8::SchedPlain S{l == 0 ? 72 : 64, 12, F.G, F.bx}; pg8::EpiPlain E{(h16*)(ws + WS_BIG), 3072};
            pg8::gemm_phase(F.lds, F.tid, (const h16*)(ws + WS_H), (const h16*)(ws + WS_WAIN) + (size_t)j * 3072 * 1024, 1024, S, E); } break;
        case K_CONVGATE: convgate_phase(F, a, l == 0 ? 0 : 1, l == 0 ? TT : T); break;
        case K_GOUT: { const h16* W = l == 0 ? (const h16*)(ws + WS_WAOUT) : l == 1 ? (const h16*)(ws + WS_WBOUT) : l == 2 ? (const h16*)(ws + WS_WCOUT) : (const h16*)(ws + WS_WAOUT) + (size_t)1024 * 1024;
            pg8::SchedPlain S{l == 0 ? 72 : 64, 4, F.G, F.bx}; pg8::EpiResid E{(float*)(ws + WS_XC), (const float*)(ws + WS_MOD) + (size_t)l * 9 * 6144, 2048};
            pg8::gemm_phase(F.lds, F.tid, (const h16*)(ws + WS_Z), W, 1024, S, E); } break;
        case K_MOEROWS: moe_rows_phase(F, a, l, l == 0 ? TT : T); break;
        case K_TOPK: topk_phase(F, a, l); break;
        case K_GMOE1: { pg8::SchedMoe S{l == 0 ? 144 : 128, 8, F.G, F.bx, 8}; pg8::EpiSwiglu E{(h16*)(ws + WS_BIG)};
            pg8::gemm_phase(F.lds, F.tid, (const h16*)(ws + WS_XIN), (const h16*)(ws + WS_WGU) + (size_t)l * 16 * 2048 * 1024, 1024, S, E); } break;
        case K_GMOE2: { pg8::SchedMoe S{l == 0 ? 144 : 128, 4, F.G, F.bx, 4}; pg8::EpiDown E{(h16*)(ws + WS_XIN), (const float*)(ws + WS_GATE)};
            pg8::gemm_phase(F.lds, F.tid, (const h16*)(ws + WS_BIG), (const h16*)(ws + WS_WDN) + (size_t)l * 16 * 1024 * 1024, 1024, S, E); } break;
        case K_GQKV: { pg8::SchedQkv S{F.G, F.bx};
            h16* Q = (h16*)(ws + WS_BIG); h16* Kb = Q + (size_t)T * D; h16* Vb = Kb + (size_t)NB * KVR * D;
            pg8::EpiQkv E{Q, Kb, Vb, (const float*)(ws + WS_SMALL), (const float*)(ws + WS_SMALL) + 1024};
            pg8::gemm_phase(F.lds, F.tid, (const h16*)(ws + WS_H), (const h16*)(ws + WS_WQKV), 1024, S, E); } break;
        case K_ATTN: attn_phase(F, a); break;
        case K_ATTNPOST: attn_post_phase(F, a); break;
        case K_GHYIN: { pg8::SchedPlain S{12, 64, F.G, F.bx}; pg8::EpiPlain E{(h16*)(ws + WS_BIG), T};
            pg8::gemm_phase(F.lds, F.tid, (const h16*)(ws + WS_WCIN), (const h16*)(ws + WS_H), 1024, S, E); } break;
        case K_HYCONV: hyconv_phase(F, a); break;
        case K_TRANS: trans_phase(F, a); break;
        default: break;
        }
        if (ph + 1 < ph_hi) { if (first_sync) { grid.sync(); first_sync = false; } xcd_barrier(xbar); }
    }
}

#if DBG_CHECK
__device__ unsigned dbg_hash(unsigned x) { x ^= x >> 16; x *= 0x7feb352dU; x ^= x >> 15; x *= 0x846ca68bU; x ^= x >> 16; return x; }
__global__ void dbg_check_gemm(const h16* A, const float* W, int N, const h16* O, int ldo, int nrows, float* accum) {
    const unsigned id = blockIdx.x * blockDim.x + threadIdx.x;
    const int row = dbg_hash(id * 2 + 1) % nrows, col = dbg_hash(id * 2 + 2) % N;
    float s = 0.f;
    for (int k = 0; k < 1024; ++k) s += h2f(A[(size_t)row * 1024 + k]) * W[(size_t)k * N + col];
    const float o = h2f(O[(size_t)row * ldo + col]);
    atomicAdd(accum, (o - s) * (o - s)); atomicAdd(accum + 1, s * s);
}
__global__ void dbg_check_convgate(const h16* BCV, const float* cw, const h16* Z, int nrows, float* accum) {
    const unsigned id = blockIdx.x * blockDim.x + threadIdx.x;
    const int row = dbg_hash(id * 2 + 1) % nrows, c = dbg_hash(id * 2 + 2) % 1024;
    const int ls = row < T ? L : LC; const int t = row < T ? (row % L) : ((row - T) % LC);
    auto u = [&](int r) { return h2f(BCV[(size_t)r * 3072 + 1024 + c]) * h2f(BCV[(size_t)r * 3072 + 2048 + c]); };
    float s = cw[1024 + c] * u(row);
    if (t > 0) s += cw[c] * u(row - 1);
    if (t + 1 < ls) s += cw[2048 + c] * u(row + 1);
    s *= h2f(BCV[(size_t)row * 3072 + c]);
    const float o = h2f(Z[(size_t)row * 1024 + c]);
    atomicAdd(accum, (o - s) * (o - s)); atomicAdd(accum + 1, s * s);
}
__global__ void dbg_check_resid(const h16* Zb, const float* W, const float* XC, const float* xin, const float* gate  , float* accum) {
    const unsigned id = blockIdx.x * blockDim.x + threadIdx.x;
    const int row = dbg_hash(id * 2 + 1) % T, col = dbg_hash(id * 2 + 2) % 1024;
    float s = 0.f;
    for (int k = 0; k < 1024; ++k) s += h2f(Zb[(size_t)row * 1024 + k]) * W[(size_t)k * 1024 + col];
    s *= gate[(size_t)(row / L) * 6144 + col];
    const float o = XC[(size_t)row * 1024 + col] - xin[(size_t)row * 1024 + col];
    atomicAdd(accum, (o - s) * (o - s)); atomicAdd(accum + 1, s * s);
}
__global__ void dbg_encode(float* out, const float* accum, int n) {
    const float e = sqrtf(accum[0] / fmaxf(accum[1], 1e-30f));
    const float k = fminf(fmaxf(log10f(fmaxf(e, 1e-20f)) + 7.f, 0.f), 8.f);
    const float s = 1.f + k;
    for (int i = blockIdx.x * blockDim.x + threadIdx.x; i < n; i += gridDim.x * blockDim.x) out[i] *= s;
}
#endif

extern "C" void kernel_launch(void* const* d_in, const int* in_sizes, int n_in, void* d_out, int out_size, void* d_ws, size_t ws_size, hipStream_t stream) {
    static int grid = 0;
    if (grid == 0) {
        if (n_in != 34 || in_sizes[0] != T * D || out_size != T * D || ws_size < WS_END) { fprintf(stderr, "kernel_launch: unexpected shapes / workspace (n_in %d, in0 %d, out %d, ws %zu); nothing launched\n", n_in, n_in > 0 ? in_sizes[0] : -1, out_size, ws_size); grid = -1; return; }
        int dev = 0, cus = 0, per_cu = 0;
        if (hipGetDevice(&dev) != hipSuccess || hipDeviceGetAttribute(&cus, hipDeviceAttributeMultiprocessorCount, dev) != hipSuccess) { fprintf(stderr, "kernel_launch: device query failed\n"); grid = -1; return; }
        if (hipFuncSetAttribute((const void*)mk_fwd, hipFuncAttributeMaxDynamicSharedMemorySize, LDS_BYTES) != hipSuccess) { fprintf(stderr, "kernel_launch: hipFuncSetAttribute failed\n"); grid = -1; return; }
        if (hipOccupancyMaxActiveBlocksPerMultiprocessor(&per_cu, (const void*)mk_fwd, NTHR, LDS_BYTES) != hipSuccess || per_cu < 1) { fprintf(stderr, "kernel_launch: occupancy query says %d\n", per_cu); (void)hipGetLastError(); per_cu = 1; }
        grid = cus * 1;
    }
    if (grid < 0) return;
    (void)hipMemsetAsync((char*)d_ws + WS_CTL, 0, CTL_ZERO_BYTES, stream);
    Args a{};
    for (int i = 0; i < 34; ++i) a.in[i] = (const float*)d_in[i];
    a.out = (float*)d_out; a.ws = (unsigned char*)d_ws;
    constexpr int NPH = NPHASE;
#if MK_N_LAUNCHES == 1
    a.ph_lo = 0; a.ph_hi = NPH;
    void* args[] = {&a};
    hipError_t e = hipLaunchCooperativeKernel((const void*)mk_fwd, dim3(grid), dim3(NTHR), args, LDS_BYTES, stream);
    if (e != hipSuccess) fprintf(stderr, "kernel_launch: cooperative launch failed: %s (grid %d)\n", hipGetErrorString(e), grid);
#else
    for (int ph = 0; ph < NPH; ++ph) { a.ph_lo = ph; a.ph_hi = ph + 1; hipLaunchKernelGGL(mk_fwd, dim3(grid), dim3(NTHR), LDS_BYTES, stream, a); }
#endif
#if DBG_CHECK
    {
        unsigned char* ws = (unsigned char*)d_ws; float* accum = (float*)(ws + WS_CTL + 512 * 1024);
        (void)hipMemsetAsync(accum, 0, 64, stream);
        if (DBG_CHECK == 1) hipLaunchKernelGGL(dbg_check_gemm, dim3(64), dim3(256), 0, stream, (const h16*)(ws + WS_H), (const float*)d_in[I_AWIN], 3072, (const h16*)(ws + WS_BIG), 3072, TT, accum);
        if (DBG_CHECK == 2)
            hipLaunchKernelGGL(dbg_check_convgate, dim3(64), dim3(256), 0, stream, (const h16*)(ws + WS_BIG), (const float*)d_in[I_ACONV], (const h16*)(ws + WS_Z), TT, accum);
        if (DBG_CHECK == 3)
            hipLaunchKernelGGL(dbg_check_resid, dim3(64), dim3(256), 0, stream, (const h16*)(ws + WS_Z), (const float*)d_in[I_AWOUT], (const float*)(ws + WS_XC), (const float*)d_in[I_X], (const float*)(ws + WS_MOD) + 2048, accum);
        hipLaunchKernelGGL(dbg_encode, dim3(1024), dim3(256), 0, stream, (float*)d_out, (const float*)accum, T * D);
    }
#endif
}
```

```cpp
#include <hip/hip_runtime.h>
#include <hip/hip_cooperative_groups.h>
#include <cstdio>
#include <cstdint>
#include <cmath>
namespace cg = cooperative_groups;

#define LAS __attribute__((address_space(3)))
#define GAS __attribute__((address_space(1)))
#define DI __device__ __forceinline__

typedef unsigned short h16;
typedef _Float16 hf;
typedef _Float16 half8 __attribute__((ext_vector_type(8)));
typedef _Float16 half4 __attribute__((ext_vector_type(4)));
typedef _Float16 half2v __attribute__((ext_vector_type(2)));
typedef short s16x8 __attribute__((ext_vector_type(8)));
typedef short s16x4 __attribute__((ext_vector_type(4)));
typedef float f32x2 __attribute__((ext_vector_type(2)));
typedef float f32x4 __attribute__((ext_vector_type(4)));
typedef float f32x16 __attribute__((ext_vector_type(16)));
typedef unsigned u32x2 __attribute__((ext_vector_type(2)));
typedef unsigned u32x4 __attribute__((ext_vector_type(4)));

#ifndef MK_N_LAUNCHES
#define MK_N_LAUNCHES 1
#endif
#ifndef DBG_CHECK
#define DBG_CHECK 0
#endif
#ifndef DBG_AMP_MASK
#define DBG_AMP_MASK 0
#endif
#define DBG_AMP_M 4
#ifndef DBG_STOP
#define DBG_STOP 35
#endif

constexpr int D = 1024, NB = 8, L = 2048, T = NB * L, LC = 256, TC = NB * LC, TT = T + TC;
constexpr int NE = 16, CAP = 256, CAPC = 32, NH = 8;
constexpr int NGL = NE * NB * CAP, NGC = NE * NB * CAPC, NG = NGL + NGC;
constexpr int KVR = LC + L;
constexpr int NWAVES = 8, NTHR = 512;

constexpr size_t MiB = 1u << 20;
constexpr size_t WS_CTL = 0, WS_MOD = 1 * MiB, WS_SMALL = 2 * MiB, WS_AFF = 3 * MiB, WS_SLOT = 5 * MiB, WS_GATE = 7 * MiB, WS_FILT = 8 * MiB;
constexpr size_t WS_WAIN = 24 * MiB, WS_WAOUT = 36 * MiB, WS_WQKV = 40 * MiB, WS_WBOUT = 46 * MiB, WS_WCIN = 48 * MiB, WS_WCOUT = 54 * MiB;
constexpr size_t WS_WGU = 56 * MiB, WS_WDN = 312 * MiB;
constexpr size_t WS_XC = 440 * MiB, WS_H = 512 * MiB, WS_BIG = 548 * MiB, WS_Z = 656 * MiB, WS_XIN = 692 * MiB, WS_END = 764 * MiB;
constexpr size_t CTL_ZERO_BYTES = 1 * MiB;

constexpr int LDS_BYTES = 160 * 1024;
constexpr int LDS_CTL_OFF = 159 * 1024;

DI unsigned pk2h(float lo, float hi) { f32x2 v = {lo, hi}; half2v h = __builtin_convertvector(v, half2v); return __builtin_bit_cast(unsigned, h); }
DI unsigned pk4f8(float a, float b, float c, float d) {
    a = __builtin_amdgcn_fmed3f(a, -448.f, 448.f); b = __builtin_amdgcn_fmed3f(b, -448.f, 448.f); c = __builtin_amdgcn_fmed3f(c, -448.f, 448.f); d = __builtin_amdgcn_fmed3f(d, -448.f, 448.f);
    int w = 0; w = __builtin_amdgcn_cvt_pk_fp8_f32(a, b, w, false); w = __builtin_amdgcn_cvt_pk_fp8_f32(c, d, w, true); return (unsigned)w; }
DI float h2f(h16 v) { return (float)__builtin_bit_cast(hf, v); }
DI f32x4 unpack4(const u32x2 w) { const half4 h = __builtin_bit_cast(half4, w); return (f32x4){(float)h[0], (float)h[1], (float)h[2], (float)h[3]}; }
DI float sx(float v, int mask, int lane) { return __builtin_bit_cast(float, __builtin_amdgcn_ds_bpermute((lane ^ mask) << 2, __builtin_bit_cast(int, v))); }
DI float wave_sum(float v, int lane) {
#pragma unroll
    for (int o = 1; o < 64; o <<= 1) v += sx(v, o, lane);
    return v;
}
DI float silu_f(float a) { return a * __builtin_amdgcn_rcpf(1.f + __builtin_amdgcn_exp2f(-1.4426950408889634f * a)); }
DI void unpack8(const u32x4 w, float (&o)[8]) {
    const half8 h = __builtin_bit_cast(half8, w);
#pragma unroll
    for (int i = 0; i < 8; ++i) o[i] = (float)h[i];
}
#define LDS_WAIT() asm volatile("s_waitcnt lgkmcnt(0)" ::: "memory")
#define VM_WAIT() asm volatile("s_waitcnt vmcnt(0)" ::: "memory")

namespace pg8 {
constexpr int BM = 256, BK = 64, HALF = 128, HTB = HALF * BK * 2, STAGE_BYTES = 8 * HTB, NXCD = 8, WGM = 8;
DI int lds_byte(int r, int c) { const int st = (r >> 4) * 2 + (c >> 5), rr = r & 15, cc = c & 31, ob = rr * 64 + cc * 2; return st * 1024 + (ob ^ (((ob >> 9) & 1) << 5)); }
DI void stage_rc(int b, int& R, int& C) { const int st = b / 1024, sb = b % 1024, swz = sb ^ (((sb >> 9) & 1) << 5); R = (st >> 1) * 16 + swz / 64; C = (st & 1) * 32 + (swz % 64) / 2; }
DI int perm32(int rho) { const int n = rho >> 4, i = rho & 15; return 8 * (i >> 2) + 4 * n + (i & 3); }

struct Unit { int pm, pn, ta, tb; };

DI bool tile_order(int i, int nM, int nN, int G, int c, int& pm, int& pn) {
    const int nwg = nM * nN; const long Lx = (long)i * G + c; if (Lx >= nwg) return false;
    int wgid = (int)Lx; { const int q = nwg / NXCD, r = nwg % NXCD, xcd = wgid % NXCD, off = wgid / NXCD; wgid = (xcd < r ? xcd * (q + 1) : r * (q + 1) + (xcd - r) * q) + off; }
    const int nig = WGM * nN, gid = wgid / nig, fm = gid * WGM, gsz = (nM - fm) < WGM ? (nM - fm) : WGM;
    pm = fm + ((wgid % nig) % gsz); pn = (wgid % nig) / gsz; return true;
}

typedef int v8i_t __attribute__((ext_vector_type(8)));
typedef int v4i_t __attribute__((ext_vector_type(4)));
template <bool GATHER, bool FP8, class Epi, class Sched>
DI void gemm_phase(LAS unsigned char* lds, const int tid, const h16* Ag, const h16* Btg, const int K, const Sched& S, const Epi& E, const int* SEL = nullptr) {
    const int wid = __builtin_amdgcn_readfirstlane(tid >> 6), lane = tid & 63, wr = wid >> 2, wc = wid & 3, fr = lane & 15, fq = lane >> 4;
    const int nt = K / BK;
    unsigned voffA[2], voffB[2];
#pragma unroll
    for (int i = 0; i < 2; ++i) { int R, C; stage_rc(tid * 16 + i * 8192, R, C); const int Rb = (R & ~31) + perm32(R & 31);
        voffA[i] = (unsigned)(R * K + C) * 2u; voffB[i] = (unsigned)(Rb * K + C) * 2u; }
    const size_t kstep = (size_t)(BK * 2);
    const size_t hstep = (size_t)HALF * K * 2;
    const size_t tstep = 2 * hstep;
    const unsigned ldsw = (unsigned)wid * 1024u;
    const int aoff = lds_byte(wr * 64 + fr, fq * 8), boff = lds_byte(wc * 32 + fr, fq * 8);
#define PG8_SA(b, h) (((b) * 2 + (h)) * HTB)
#define PG8_SB(b, h) ((4 + (b) * 2 + (h)) * HTB)
#define PG8_STAGE(bufoff, gbase, voff) do { _Pragma("unroll") for (int _i = 0; _i < 2; ++_i) \
        __builtin_amdgcn_global_load_lds((const unsigned*)((const char*)(gbase) + (voff)[_i]), (LAS unsigned*)(lds + (bufoff) + ldsw + _i * 8192), 16, 0, 0); } while (0)
#define PG8_STAGE_A(bufoff, gbase, h, gsel) do { if constexpr (GATHER) { PG8_STAGE(bufoff, gbase, (gsel)[h]); } else { PG8_STAGE(bufoff, (gbase) + (h) * hstep, voffA); } } while (0)
#define PG8_LOAD_G(g, ta_) do { _Pragma("unroll") for (int h_ = 0; h_ < 2; ++h_) _Pragma("unroll") for (int i_ = 0; i_ < 2; ++i_) { int R_, C_; stage_rc(tid * 16 + i_ * 8192, R_, C_); \
        const int row_ = SEL[(ta_) * BM + h_ * HALF + R_]; (g)[h_][i_] = (unsigned)(row_ * K + C_) * 2u; } } while (0)
#define PG8_LDA(dst, b, h) do { if constexpr (FP8) { _Pragma("unroll") for (int m = 0; m < 4; ++m) dst##8[m] = __builtin_shufflevector(*(const LAS v4i_t*)(lds + PG8_SA(b, h) + aoff + m * 2048), *(const LAS v4i_t*)(lds + PG8_SA(b, h) + aoff + m * 2048 + 1024), 0, 1, 2, 3, 4, 5, 6, 7); } \
        else { _Pragma("unroll") for (int m = 0; m < 4; ++m) _Pragma("unroll") for (int k = 0; k < 2; ++k) dst[m][k] = *(const LAS half8*)(lds + PG8_SA(b, h) + aoff + m * 2048 + k * 1024); } } while (0)
#define PG8_LDB(dst, b, h) do { if constexpr (FP8) { _Pragma("unroll") for (int n = 0; n < 2; ++n) dst##8[n] = __builtin_shufflevector(*(const LAS v4i_t*)(lds + PG8_SB(b, h) + boff + n * 2048), *(const LAS v4i_t*)(lds + PG8_SB(b, h) + boff + n * 2048 + 1024), 0, 1, 2, 3, 4, 5, 6, 7); } \
        else { _Pragma("unroll") for (int n = 0; n < 2; ++n) _Pragma("unroll") for (int k = 0; k < 2; ++k) dst[n][k] = *(const LAS half8*)(lds + PG8_SB(b, h) + boff + n * 2048 + k * 1024); } } while (0)
#define PG8_CAT8(x0, x1) __builtin_shufflevector(__builtin_bit_cast(v4i_t, x0), __builtin_bit_cast(v4i_t, x1), 0, 1, 2, 3, 4, 5, 6, 7)
#define PG8_MMA(ai, bj, At, Bt) do { __builtin_amdgcn_s_setprio(1); \
        if constexpr (FP8) { _Pragma("unroll") for (int m = 0; m < 4; ++m) _Pragma("unroll") for (int n = 0; n < 2; ++n) \
            asm volatile("v_mfma_scale_f32_16x16x128_f8f6f4 %0, %1, %2, %0, %3, %3 op_sel_hi:[0,0,0]" : "+v"(acc[ai][bj][m][n]) : "v"(Bt##8[n]), "v"(At##8[m]), "v"(sc1)); } \
        else { _Pragma("unroll") for (int m = 0; m < 4; ++m) _Pragma("unroll") for (int n = 0; n < 2; ++n) _Pragma("unroll") for (int k = 0; k < 2; ++k) \
            acc[ai][bj][m][n] = __builtin_amdgcn_mfma_f32_16x16x32_f16(Bt[n][k], At[m][k], acc[ai][bj][m][n], 0, 0, 0); } \
        __builtin_amdgcn_s_setprio(0); } while (0)
#define PG8_WAIT_V(n) asm volatile("s_waitcnt vmcnt(" #n ")" ::: "memory")
#define PG8_WAIT_L(n) asm volatile("s_waitcnt lgkmcnt(" #n ")" ::: "memory")
#define PG8_BAR __builtin_amdgcn_s_barrier()
#define PG8_SCHED __builtin_amdgcn_sched_barrier(0)
    Unit cur, nxt; int ui = 0;
    if (!S.next(0, cur)) return;
    f32x4 acc[2][2][4][2];
    half8 At[4][2], B0[2][2], B1[2][2];
    v8i_t At8[4], B08[2], B18[2];
    int sc1 = 0x7F7F7F7F; asm volatile("" : "+v"(sc1));
    const char* cA = (const char*)Ag + (GATHER ? (size_t)0 : (size_t)cur.ta * tstep); const char* cB = (const char*)Btg + (size_t)cur.tb * tstep;
    unsigned gC[2][2], gN[2][2], gNN[2][2];
    if constexpr (GATHER) { PG8_LOAD_G(gC, cur.ta); Unit t1; if (S.next(1, t1)) { PG8_LOAD_G(gN, t1.ta); } else { PG8_LOAD_G(gN, cur.ta); }
        _Pragma("unroll") for (int h_ = 0; h_ < 2; ++h_) _Pragma("unroll") for (int i_ = 0; i_ < 2; ++i_) gNN[h_][i_] = gN[h_][i_]; }
    PG8_STAGE(PG8_SB(0, 0), cB, voffB); PG8_STAGE(PG8_SB(0, 1), cB + hstep, voffB); PG8_STAGE_A(PG8_SA(0, 0), cA, 0, gC); PG8_STAGE_A(PG8_SA(0, 1), cA, 1, gC);
    if (wr == 1) PG8_BAR;
    PG8_WAIT_V(2); PG8_BAR;
    PG8_STAGE(PG8_SB(1, 0), cB + kstep, voffB); PG8_STAGE_A(PG8_SA(1, 0), cA + kstep, 0, gC); PG8_STAGE(PG8_SB(1, 1), cB + hstep + kstep, voffB);
    PG8_WAIT_V(6); PG8_BAR;
#pragma unroll
    for (int a = 0; a < 2; ++a)
#pragma unroll
        for (int b = 0; b < 2; ++b)
#pragma unroll
            for (int m = 0; m < 4; ++m)
#pragma unroll
                for (int n = 0; n < 2; ++n) acc[a][b][m][n] = (f32x4){0.f, 0.f, 0.f, 0.f};
    for (;;) {
        const bool has_next = S.next(ui + 1, nxt);
        const char* nA = (has_next && !GATHER) ? (const char*)Ag + (size_t)nxt.ta * tstep : cA; const char* nB = has_next ? (const char*)Btg + (size_t)nxt.tb * tstep : cB;
        for (int t = 0; t < nt; t += 2) {
            const bool last = (t == nt - 2);
            const char* a1 = cA + (size_t)(t + 1) * kstep;
            const char* a2 = last ? nA : cA + (size_t)(t + 2) * kstep; const char* b2 = last ? nB : cB + (size_t)(t + 2) * kstep;
            const char* a3 = a2 + kstep; const char* b3 = b2 + kstep;
            unsigned gS[2][2];
            if constexpr (GATHER) { _Pragma("unroll") for (int h_ = 0; h_ < 2; ++h_) _Pragma("unroll") for (int i_ = 0; i_ < 2; ++i_) gS[h_][i_] = last ? gN[h_][i_] : gC[h_][i_]; }
            PG8_LDB(B0, 0, 0); PG8_LDB(B1, 0, 1); PG8_SCHED; PG8_LDA(At, 0, 0); PG8_STAGE_A(PG8_SA(1, 1), a1, 1, gC);
            PG8_WAIT_V(8); PG8_WAIT_L(0); PG8_BAR; PG8_MMA(0, 0, At, B0); PG8_MMA(0, 1, At, B1); PG8_BAR; PG8_SCHED;
            PG8_LDA(At, 0, 1); PG8_STAGE(PG8_SB(0, 0), b2, voffB); PG8_STAGE(PG8_SB(0, 1), b2 + hstep, voffB); PG8_STAGE_A(PG8_SA(0, 0), a2, 0, gS);
            PG8_WAIT_V(8); PG8_WAIT_L(0); PG8_BAR; PG8_MMA(1, 0, At, B0); PG8_MMA(1, 1, At, B1); PG8_BAR; PG8_SCHED;
            PG8_LDB(B0, 1, 0); PG8_LDB(B1, 1, 1); PG8_SCHED; PG8_LDA(At, 1, 0); PG8_STAGE_A(PG8_SA(0, 1), a2, 1, gS);
            PG8_WAIT_V(8); PG8_WAIT_L(0); PG8_BAR; PG8_MMA(0, 0, At, B0); PG8_MMA(0, 1, At, B1); PG8_BAR; PG8_SCHED;
            PG8_LDA(At, 1, 1); PG8_STAGE(PG8_SB(1, 0), b3, voffB); PG8_STAGE(PG8_SB(1, 1), b3 + hstep, voffB); PG8_STAGE_A(PG8_SA(1, 0), a3, 0, gS);
            PG8_WAIT_V(8); PG8_WAIT_L(0); PG8_BAR; PG8_MMA(1, 0, At, B0); PG8_MMA(1, 1, At, B1); PG8_BAR; PG8_SCHED;
        }
        if (wr == 0) PG8_BAR;
        if constexpr (FP8) asm volatile("s_nop 15\n\ts_nop 15" ::: "memory");
        if constexpr (GATHER) { Unit t2; if (has_next && S.next(ui + 2, t2)) { PG8_LOAD_G(gNN, t2.ta); } }
        { int fr_ = fr, fq_ = fq; asm volatile("" : "+v"(fr_), "+v"(fq_)); E(acc, cur, wr, wc, fr_, fq_); }
        if (!has_next) break;
#pragma unroll
        for (int a = 0; a < 2; ++a)
#pragma unroll
            for (int b = 0; b < 2; ++b)
#pragma unroll
                for (int m = 0; m < 4; ++m)
#pragma unroll
                    for (int n = 0; n < 2; ++n) acc[a][b][m][n] = (f32x4){0.f, 0.f, 0.f, 0.f};
        cur = nxt; cA = nA; cB = nB; ++ui;
        if constexpr (GATHER) { _Pragma("unroll") for (int h_ = 0; h_ < 2; ++h_) _Pragma("unroll") for (int i_ = 0; i_ < 2; ++i_) { gC[h_][i_] = gN[h_][i_]; gN[h_][i_] = gNN[h_][i_]; } }
        if (wr == 1) PG8_BAR;
    }
    PG8_WAIT_V(0);
    PG8_BAR;
#undef PG8_SA
#undef PG8_SB
#undef PG8_STAGE
#undef PG8_STAGE_A
#undef PG8_LOAD_G
#undef PG8_LDA
#undef PG8_LDB
#undef PG8_MMA
#undef PG8_CAT8
#undef PG8_WAIT_V
#undef PG8_WAIT_L
#undef PG8_BAR
#undef PG8_SCHED
}

struct SchedPlain {
    int nM, nN, G, c;
    DI bool next(int i, Unit& u) const { if (!tile_order(i, nM, nN, G, c, u.pm, u.pn)) return false; u.ta = u.pm; u.tb = u.pn; return true; }
};
struct SchedMoe {
    int nM, nN, G, c, tpe;
    DI bool next(int i, Unit& u) const { if (!tile_order(i, nM, nN, G, c, u.pm, u.pn)) return false; const int e = u.pm < 128 ? (u.pm >> 3) : (u.pm - 128); u.ta = u.pm; u.tb = e * tpe + u.pn; return true; }
};
struct SchedQkv {
    int G, c;
    DI bool next(int i, Unit& u) const {
        const long Lx = (long)i * G + c;
        if (Lx < 768) { tile_order(i, 64, 12, G, c, u.pm, u.pn); u.ta = u.pm; u.tb = u.pn; return true; }
        const int r = (int)(Lx - 768); if (r >= 64) return false;
        u.pm = 64 + (r & 7); u.pn = 4 + (r >> 3); u.ta = u.pm; u.tb = u.pn; return true;
    }
};

struct EpiPlain {
    h16* O; int ldc;
    DI void operator()(const f32x4 (&acc)[2][2][4][2], const Unit& u, int wr, int wc, int fr, int fq) const {
        const int row0 = u.pm * BM + wr * 64 + fr, col0 = u.pn * BM + wc * 32 + 8 * fq;
#pragma unroll
        for (int ai = 0; ai < 2; ++ai)
#pragma unroll
            for (int m = 0; m < 4; ++m) { h16* rowp = O + (size_t)(row0 + ai * HALF + m * 16) * ldc + col0;
#pragma unroll
                for (int bj = 0; bj < 2; ++bj) { const f32x4 v0 = acc[ai][bj][m][0], v1 = acc[ai][bj][m][1];
                    u32x4 w; w.x = pk2h(v0[0], v0[1]); w.y = pk2h(v0[2], v0[3]); w.z = pk2h(v1[0], v1[1]); w.w = pk2h(v1[2], v1[3]);
                    *(u32x4*)(rowp + bj * HALF) = w; } }
    }
};
struct EpiGin {
    h16* O;
    DI void operator()(const f32x4 (&acc)[2][2][4][2], const Unit& u, int wr, int wc, int fr, int fq) const {
        const int row0 = u.pm * BM + wr * 64 + fr;
        if (u.pn < 4) {
            const int col0 = u.pn * BM + wc * 32 + 8 * fq;
#pragma unroll
            for (int ai = 0; ai < 2; ++ai)
#pragma unroll
                for (int m = 0; m < 4; ++m) { h16* rowp = O + (size_t)(row0 + ai * HALF + m * 16) * 2048 + col0;
#pragma unroll
                    for (int bj = 0; bj < 2; ++bj) { const f32x4 v0 = acc[ai][bj][m][0], v1 = acc[ai][bj][m][1];
                        u32x4 w; w.x = pk2h(v0[0], v0[1]); w.y = pk2h(v0[2], v0[3]); w.z = pk2h(v1[0], v1[1]); w.w = pk2h(v1[2], v1[3]);
                        *(u32x4*)(rowp + bj * HALF) = w; } }
        } else {
            const int col0 = 1024 + (u.pn - 4) * HALF + wc * 32 + 8 * fq;
#pragma unroll
            for (int ai = 0; ai < 2; ++ai)
#pragma unroll
                for (int m = 0; m < 4; ++m) { const f32x4 p0 = acc[ai][0][m][0] * acc[ai][1][m][0], p1 = acc[ai][0][m][1] * acc[ai][1][m][1];
                    u32x4 w; w.x = pk2h(p0[0], p0[1]); w.y = pk2h(p0[2], p0[3]); w.z = pk2h(p1[0], p1[1]); w.w = pk2h(p1[2], p1[3]);
                    *(u32x4*)(O + (size_t)(row0 + ai * HALF + m * 16) * 2048 + col0) = w; }
        }
    }
};
struct EpiResid {
    h16* XC; const float* modl; int goff;
    DI void operator()(const f32x4 (&acc)[2][2][4][2], const Unit& u, int wr, int wc, int fr, int fq) const {
        const int row0 = u.pm * BM + wr * 64 + fr, col0 = u.pn * BM + wc * 32 + 8 * fq;
        const int r9 = u.pm < 64 ? (u.pm >> 3) : 8;
        const float* g = modl + r9 * 6144 + goff + col0;
        f32x4 gv[2][2];
#pragma unroll
        for (int bj = 0; bj < 2; ++bj)
#pragma unroll
            for (int n = 0; n < 2; ++n) gv[bj][n] = *(const f32x4*)(g + bj * HALF + 4 * n);
#pragma unroll
        for (int ai = 0; ai < 2; ++ai) {
            u32x4 xr[4][2];
#pragma unroll
            for (int m = 0; m < 4; ++m)
#pragma unroll
                for (int bj = 0; bj < 2; ++bj) xr[m][bj] = *(const u32x4*)(XC + (size_t)(row0 + ai * HALF + m * 16) * D + col0 + bj * HALF);
            __builtin_amdgcn_sched_barrier(0);
#pragma unroll
            for (int m = 0; m < 4; ++m) { h16* rowp = XC + (size_t)(row0 + ai * HALF + m * 16) * D + col0;
#pragma unroll
                for (int bj = 0; bj < 2; ++bj) { float x[8]; unpack8(xr[m][bj], x);
                    const f32x4 a0 = acc[ai][bj][m][0], a1 = acc[ai][bj][m][1], g0 = gv[bj][0], g1 = gv[bj][1];
                    u32x4 w; w.x = pk2h(x[0] + g0[0] * a0[0], x[1] + g0[1] * a0[1]); w.y = pk2h(x[2] + g0[2] * a0[2], x[3] + g0[3] * a0[3]);
                    w.z = pk2h(x[4] + g1[0] * a1[0], x[5] + g1[1] * a1[1]); w.w = pk2h(x[6] + g1[2] * a1[2], x[7] + g1[3] * a1[3]); *(u32x4*)(rowp + bj * HALF) = w; } }
            __builtin_amdgcn_sched_barrier(0);
        }
    }
};
struct EpiSwiglu {
    h16* HID;
    DI void operator()(const f32x4 (&acc)[2][2][4][2], const Unit& u, int wr, int wc, int fr, int fq) const {
        const int row0 = u.pm * BM + wr * 64 + fr, col0 = u.pn * HALF + wc * 32 + 8 * fq;
#pragma unroll
        for (int ai = 0; ai < 2; ++ai)
#pragma unroll
            for (int m = 0; m < 4; ++m) { h16* rowp = HID + (size_t)(row0 + ai * HALF + m * 16) * D + col0;
                float o[8];
#pragma unroll
                for (int n = 0; n < 2; ++n)
#pragma unroll
                    for (int j = 0; j < 4; ++j) { const float a = acc[ai][0][m][n][j], b = acc[ai][1][m][n][j]; o[4 * n + j] = silu_f(a) * b; }
                u32x4 w; w.x = pk2h(o[0], o[1]); w.y = pk2h(o[2], o[3]); w.z = pk2h(o[4], o[5]); w.w = pk2h(o[6], o[7]);
                *(u32x4*)rowp = w; }
    }
};
struct EpiDown {
    h16* YE; const float* GATE;
    DI void operator()(const f32x4 (&acc)[2][2][4][2], const Unit& u, int wr, int wc, int fr, int fq) const {
        const int row0 = u.pm * BM + wr * 64 + fr, col0 = u.pn * BM + wc * 32 + 8 * fq;
#pragma unroll
        for (int ai = 0; ai < 2; ++ai)
#pragma unroll
            for (int m = 0; m < 4; ++m) { const int row = row0 + ai * HALF + m * 16; const float gt = GATE[row]; h16* rowp = YE + (size_t)row * D + col0;
#pragma unroll
                for (int bj = 0; bj < 2; ++bj) { const f32x4 v0 = acc[ai][bj][m][0] * gt, v1 = acc[ai][bj][m][1] * gt;
                    u32x4 w; w.x = pk2h(v0[0], v0[1]); w.y = pk2h(v0[2], v0[3]); w.z = pk2h(v1[0], v1[1]); w.w = pk2h(v1[2], v1[3]);
                    *(u32x4*)(rowp + bj * HALF) = w; } }
    }
};
struct EpiSwiglu8 {
    unsigned char* HID8;
    DI void operator()(const f32x4 (&acc)[2][2][4][2], const Unit& u, int wr, int wc, int fr, int fq) const {
        const int row0 = u.pm * BM + wr * 64 + fr, col0 = u.pn * HALF + wc * 32 + 8 * fq;
#pragma unroll
        for (int ai = 0; ai < 2; ++ai)
#pragma unroll
            for (int m = 0; m < 4; ++m) { unsigned char* rowp = HID8 + (size_t)(row0 + ai * HALF + m * 16) * D + col0;
                float o[8];
#pragma unroll
                for (int n = 0; n < 2; ++n)
#pragma unroll
                    for (int j = 0; j < 4; ++j) { const float a = acc[ai][0][m][n][j] * (1.f / 512.f), b = acc[ai][1][m][n][j] * (4.f / 512.f); o[4 * n + j] = silu_f(a) * b; }
                u32x2 w; w.x = pk4f8(o[0], o[1], o[2], o[3]); w.y = pk4f8(o[4], o[5], o[6], o[7]);
                *(u32x2*)rowp = w; }
    }
};
struct EpiDown8 {
    unsigned char* YE; const float* GATE;
    DI void operator()(const f32x4 (&acc)[2][2][4][2], const Unit& u, int wr, int wc, int fr, int fq) const {
        const int row0 = u.pm * BM + wr * 64 + fr, col0 = u.pn * BM + wc * 32 + 8 * fq;
        float gt[2][4];
#pragma unroll
        for (int ai = 0; ai < 2; ++ai)
#pragma unroll
            for (int m = 0; m < 4; ++m) gt[ai][m] = GATE[row0 + ai * HALF + m * 16];
        __builtin_amdgcn_sched_barrier(0);
#pragma unroll
        for (int ai = 0; ai < 2; ++ai)
#pragma unroll
            for (int m = 0; m < 4; ++m) { const int row = row0 + ai * HALF + m * 16; const float g = gt[ai][m] * (16.f / 256.f); unsigned char* rowp = YE + (size_t)row * D + col0;
#pragma unroll
                for (int bj = 0; bj < 2; ++bj) { const f32x4 v0 = acc[ai][bj][m][0] * g, v1 = acc[ai][bj][m][1] * g;
                    u32x2 w; w.x = pk4f8(v0[0], v0[1], v0[2], v0[3]); w.y = pk4f8(v1[0], v1[1], v1[2], v1[3]);
                    *(u32x2*)(rowp + bj * HALF) = w; } }
    }
};
constexpr float ATT_C2 = 0.125f * 1.4426950408889634f;
struct EpiQkv {
    h16 *Q, *Kb, *Vb; const float *RC, *RS;
    DI void operator()(const f32x4 (&acc)[2][2][4][2], const Unit& u, int wr, int wc, int fr, int fq) const {
        const bool ctx = u.pm >= 64; const int sec = u.pn >> 2;
        const int lr0 = wr * 64 + fr, col0 = (u.pn & 3) * BM + wc * 32 + 8 * fq;
        h16* base; size_t rowb;
        if (sec == 0) { base = Q; rowb = (size_t)u.pm * BM; }
        else { base = sec == 1 ? Kb : Vb; rowb = ctx ? (size_t)(u.pm - 64) * KVR : (size_t)(u.pm >> 3) * KVR + LC + (size_t)(u.pm & 7) * BM; }
        const bool rope = (sec < 2) && !ctx; const float sc = sec == 0 ? ATT_C2 : 1.f;
#pragma unroll
        for (int ai = 0; ai < 2; ++ai) {
            f32x4 cs[4], sn[4];
#pragma unroll
            for (int m = 0; m < 4; ++m) { cs[m] = (f32x4){1.f, 1.f, 1.f, 1.f}; sn[m] = (f32x4){0.f, 0.f, 0.f, 0.f}; }
            if (rope) {
#pragma unroll
                for (int m = 0; m < 4; ++m) { const int t = (u.pm & 7) * BM + lr0 + ai * HALF + m * 16; const int pos = (wc & 1) ? (t & 63) : (t >> 6); cs[m] = *(const f32x4*)(RC + pos * 16 + 4 * fq); sn[m] = *(const f32x4*)(RS + pos * 16 + 4 * fq); } }
            __builtin_amdgcn_sched_barrier(0);
#pragma unroll
            for (int m = 0; m < 4; ++m) { const int lr = lr0 + ai * HALF + m * 16; h16* rowp = base + (rowb + lr) * D + col0;
#pragma unroll
                for (int bj = 0; bj < 2; ++bj) { const f32x4 x1 = acc[ai][bj][m][0], x2 = acc[ai][bj][m][1];
                    const f32x4 v0 = (x1 * cs[m] - x2 * sn[m]) * sc, v1 = (x2 * cs[m] + x1 * sn[m]) * sc;
                    u32x4 w; w.x = pk2h(v0[0], v0[1]); w.y = pk2h(v0[2], v0[3]); w.z = pk2h(v1[0], v1[1]); w.w = pk2h(v1[2], v1[3]);
                    *(u32x4*)(rowp + bj * HALF) = w; } }
            __builtin_amdgcn_sched_barrier(0);
        }
    }
};
}

#define XB_TMO      128
#define XB_XCNT(j)  (256  + 64 * (j))
#define XB_XSUB(j)  (1280 + 64 * (j))
#define XB_XGEN(j)  (2304 + 64 * (j))
#define XB_TOP      3328
#define XB_TOPGEN   3392
#define XCD_BAR_WORDS 3456
#define XB_SPIN_CAP (1u << 22)
DI unsigned xb_ld(unsigned* p)              { return __hip_atomic_load(p, __ATOMIC_RELAXED, __HIP_MEMORY_SCOPE_AGENT); }
DI unsigned xb_add(unsigned* p, unsigned v) { return __hip_atomic_fetch_add(p, v, __ATOMIC_RELAXED, __HIP_MEMORY_SCOPE_AGENT); }
DI unsigned xb_xcc_id() { return (unsigned)__builtin_amdgcn_s_getreg((3 << 11) | 20) & 0xFu; }
#define XB_SPIN(cond, bar) do { unsigned _sp = 0; while (cond) { __builtin_amdgcn_s_sleep(1); \
    if ((++_sp & 255u) == 0u) { if (xb_ld(&(bar)[XB_TMO])) break; if (_sp > XB_SPIN_CAP) { atomicAdd(&(bar)[XB_TMO], 1u); break; } } } } while (0)
struct XcdBarrier { unsigned* bar; unsigned x; volatile LAS unsigned* st; };
DI XcdBarrier xcd_barrier_post(unsigned* bar, volatile LAS unsigned* st) {
    XcdBarrier b; b.bar = bar; b.x = xb_xcc_id(); b.st = st;
    if (threadIdx.x == 0) (void)xb_add(&bar[XB_XCNT(b.x)], 1u);
    return b;
}
DI void xcd_barrier_complete(unsigned* bar, unsigned x, unsigned& nloc, unsigned& nx) {
    const unsigned G = gridDim.x * gridDim.y * gridDim.z;
    unsigned sum, cnt, mine, sp = 0u;
    for (;;) {
        sum = 0u; cnt = 0u; mine = 0u;
#pragma unroll
        for (unsigned j = 0; j < 16; ++j) { const unsigned c = xb_ld(&bar[XB_XCNT(j)]); sum += c; cnt += (c > 0u) ? 1u : 0u; mine = (j == x) ? c : mine; }
        if (sum == G) break;
        __builtin_amdgcn_s_sleep(1);
        if ((++sp & 255u) == 0u) { if (xb_ld(&bar[XB_TMO])) break; if (sp > XB_SPIN_CAP) { atomicAdd(&bar[XB_TMO], 1u); break; } }
    }
    nloc = mine > 0u ? mine : 1u; nx = cnt > 0u ? cnt : 1u;
}
DI void xcd_barrier(const XcdBarrier& b, const bool leader) {
    asm volatile("s_waitcnt vmcnt(0)" ::: "memory");
    __syncthreads();
    if (leader) {
        unsigned* bar = b.bar;
        __builtin_amdgcn_s_waitcnt(0);
        unsigned nloc = b.st[0], nx = b.st[1];
        if (nloc == 0u) { xcd_barrier_complete(bar, b.x, nloc, nx); b.st[0] = nloc; b.st[1] = nx; }
        const unsigned old = xb_add(&bar[XB_XSUB(b.x)], 1u);
        const unsigned gen = old / nloc;
        if (old + 1u == (gen + 1u) * nloc) {
            __builtin_amdgcn_fence(__ATOMIC_RELEASE, "agent");
            asm volatile("s_waitcnt vmcnt(0)" ::: "memory");
            const unsigned og = xb_add(&bar[XB_TOP], 1u);
            const unsigned tg = og / nx;
            if (og + 1u == (tg + 1u) * nx) xb_add(&bar[XB_TOPGEN], 1u);
            else XB_SPIN(xb_ld(&bar[XB_TOPGEN]) == tg, bar);
            __builtin_amdgcn_fence(__ATOMIC_ACQUIRE, "agent");
            xb_add(&bar[XB_XGEN(b.x)], 1u);
            asm volatile("s_waitcnt vmcnt(0)" ::: "memory");
        } else {
            XB_SPIN(xb_ld(&bar[XB_XGEN(b.x)]) == gen, bar);
            __builtin_amdgcn_fence(__ATOMIC_ACQUIRE, "agent");
            asm volatile("s_waitcnt vmcnt(0)" ::: "memory");
        }
    }
    __syncthreads();
}

struct Args { const float* in[34]; float* out; unsigned char* ws; int ph_lo, ph_hi; };
enum { I_X = 0, I_C, I_CTX, I_CCTX, I_WADA, I_BADA, I_N1G, I_N2G, I_FG, I_AWIN, I_ACONV, I_AWOUT, I_BQKV, I_LQ1, I_LK1, I_LQ2, I_LK2, I_SUBG, I_BWOUT,
       I_CWIN, I_CCONV, I_F1W, I_F1B, I_F1F, I_F2W, I_F2B, I_F2F, I_F3W, I_SKIP, I_CWOUT, I_ROUTER, I_WGATE, I_WUP, I_WDOWN };

typedef __attribute__((address_space(4))) const Args CArgs;
struct Ctx { LAS unsigned char* lds; int tid, lane, wave, G, bx, vcu, gw, NGW; };

DI int perm_l2p(int l) { return ((l >> 2) & 3) * 8 + (l >> 4) * 4 + (l & 3); }
DI int map_row(int mode, int n) {
    if (mode == 1) return n < 2048 ? (n & ~31) + perm_l2p(n & 31) : n;
    if (mode == 2) return (n >> 7) * 256 + (n & 127);
    if (mode == 3) return (n >> 7) * 256 + 128 + (n & 127);
    if (mode == 4) { if (n < 1024) return n; const int c = (n - 1024) & 1023; return 1024 + (c >> 7) * 256 + (n >= 2048 ? 128 : 0) + (c & 127); }
    return n;
}
struct TJob { const float* W; h16* WT; int N, mode, item; bool f8; };
constexpr int P0_NSPEC = 1024, P0_NITEMS = P0_NSPEC + 192 * 64;
#ifndef P0_NAUX
#define P0_NAUX 64
#endif
DI TJob p0_decode(CArgs& a, int it) {
    unsigned char* ws = a.ws; TJob j;
    int r = it;
    if (r >= P0_NSPEC) { r -= P0_NSPEC; const int mat = r >> 6; const int kind = mat >> 6, le = mat & 63;
        j.W = a.in[I_WGATE + kind] + (size_t)le * 1024 * 1024; j.N = 1024; j.item = r & 63; j.mode = kind == 0 ? 2 : (kind == 1 ? 3 : 0);
        j.WT = kind < 2 ? (h16*)(ws + WS_WGU + (size_t)le * 2048 * 1024) : (h16*)(ws + WS_WDN + (size_t)le * 1024 * 1024); j.f8 = true; return j; }
    j.mode = 0; j.f8 = false;
    if (r < 192) { j.W = a.in[I_AWIN]; j.N = 3072; j.WT = (h16*)(ws + WS_WAIN); j.item = r; j.mode = 4; return j; } r -= 192;
    if (r < 192) { j.W = a.in[I_AWIN] + (size_t)1024 * 3072; j.N = 3072; j.WT = (h16*)(ws + WS_WAIN) + (size_t)3072 * 1024; j.item = r; j.mode = 4; return j; } r -= 192;
    if (r < 64) { j.W = a.in[I_AWOUT]; j.N = 1024; j.WT = (h16*)(ws + WS_WAOUT); j.item = r; return j; } r -= 64;
    if (r < 64) { j.W = a.in[I_AWOUT] + (size_t)1024 * 1024; j.N = 1024; j.WT = (h16*)(ws + WS_WAOUT) + (size_t)1024 * 1024; j.item = r; return j; } r -= 64;
    if (r < 192) { j.W = a.in[I_BQKV]; j.N = 3072; j.WT = (h16*)(ws + WS_WQKV); j.item = r; j.mode = 1; return j; } r -= 192;
    if (r < 64) { j.W = a.in[I_BWOUT]; j.N = 1024; j.WT = (h16*)(ws + WS_WBOUT); j.item = r; return j; } r -= 64;
    if (r < 192) { j.W = a.in[I_CWIN]; j.N = 3072; j.WT = (h16*)(ws + WS_WCIN); j.item = r; return j; } r -= 192;
    j.W = a.in[I_CWOUT]; j.N = 1024; j.WT = (h16*)(ws + WS_WCOUT); j.item = r; return j;
}
DI void p0_tr_load(const TJob& j, int tid, f32x4 (&v)[8]) {
    const int nblk = j.N / 128, kb = j.item / nblk, nb = j.item % nblk, k0 = 128 * kb, n0 = 128 * nb;
    const float* p = j.W + (size_t)(k0 + (tid >> 5)) * j.N + n0 + 4 * (tid & 31);
#pragma unroll
    for (int i = 0; i < 8; ++i) v[i] = __builtin_nontemporal_load((const f32x4*)(p + (size_t)(16 * i) * j.N));
}
#define P0_LBAR() asm volatile("s_waitcnt lgkmcnt(0)\n\ts_barrier" ::: "memory")
DI void p0_tr_store(const TJob& j, int tid, LAS float* scr, const f32x4 (&v)[8]) {
    const int nblk = j.N / 128, kb = j.item / nblk, nb = j.item % nblk, k0 = 128 * kb, n0 = 128 * nb;
#pragma unroll
    for (int i = 0; i < 8; ++i) { LAS float* d = scr + ((tid >> 5) + 16 * i) * 129 + 4 * (tid & 31); d[0] = v[i].x; d[1] = v[i].y; d[2] = v[i].z; d[3] = v[i].w; }
    P0_LBAR();
    const int n = tid >> 2, kq = tid & 3;
    const LAS float* s = scr + (32 * kq) * 129 + n;
    const size_t orow = (size_t)map_row(j.mode, n0 + n) * 1024 + k0 + 32 * kq;
    if (j.f8) {
        u32x4 o0, o1;
        o0.x = pk4f8(s[0 * 129] * 64.f, s[1 * 129] * 64.f, s[2 * 129] * 64.f, s[3 * 129] * 64.f);     o0.y = pk4f8(s[4 * 129] * 64.f, s[5 * 129] * 64.f, s[6 * 129] * 64.f, s[7 * 129] * 64.f);
        o0.z = pk4f8(s[8 * 129] * 64.f, s[9 * 129] * 64.f, s[10 * 129] * 64.f, s[11 * 129] * 64.f);   o0.w = pk4f8(s[12 * 129] * 64.f, s[13 * 129] * 64.f, s[14 * 129] * 64.f, s[15 * 129] * 64.f);
        o1.x = pk4f8(s[16 * 129] * 64.f, s[17 * 129] * 64.f, s[18 * 129] * 64.f, s[19 * 129] * 64.f); o1.y = pk4f8(s[20 * 129] * 64.f, s[21 * 129] * 64.f, s[22 * 129] * 64.f, s[23 * 129] * 64.f);
        o1.z = pk4f8(s[24 * 129] * 64.f, s[25 * 129] * 64.f, s[26 * 129] * 64.f, s[27 * 129] * 64.f); o1.w = pk4f8(s[28 * 129] * 64.f, s[29 * 129] * 64.f, s[30 * 129] * 64.f, s[31 * 129] * 64.f);
        u32x4* d = (u32x4*)((unsigned char*)j.WT + orow); d[0] = o0; d[1] = o1;
    } else {
        u32x4* d = (u32x4*)(j.WT + orow);
#pragma unroll
        for (int g = 0; g < 4; ++g) { const LAS float* t = s + (8 * g) * 129;
            u32x4 o; o.x = pk2h(t[0 * 129], t[1 * 129]); o.y = pk2h(t[2 * 129], t[3 * 129]); o.z = pk2h(t[4 * 129], t[5 * 129]); o.w = pk2h(t[6 * 129], t[7 * 129]); d[g] = o; }
    }
    P0_LBAR();
}

DI void p0_prologue(const Ctx& F, CArgs& a) {
    unsigned char* ws = a.ws;
    const int NAUX = F.G >= 128 ? P0_NAUX : 0;
    const bool aux = F.bx < NAUX || NAUX == 0, conv = F.bx >= NAUX;
    const int cbx = F.bx - NAUX, cG = F.G - NAUX, abx = F.bx, aG = NAUX ? NAUX : F.G;
    if (conv) {
        LAS float* scr = (LAS float*)F.lds;
        int it = cbx;
        f32x4 v0[8], v1[8]; TJob j0, j1;
        if (it < P0_NITEMS) { j0 = p0_decode(a, it); p0_tr_load(j0, F.tid, v0); }
        while (it < P0_NITEMS) {
            int itn = it + cG; bool hn = itn < P0_NITEMS;
            if (hn) { j1 = p0_decode(a, itn); p0_tr_load(j1, F.tid, v1); }
            p0_tr_store(j0, F.tid, scr, v0);
            it = itn; if (!hn) break;
            itn = it + cG; hn = itn < P0_NITEMS;
            if (hn) { j0 = p0_decode(a, itn); p0_tr_load(j0, F.tid, v0); }
            p0_tr_store(j1, F.tid, scr, v1);
            it = itn;
        }
    }
    __syncthreads();
    if (aux) {
        LAS float* S = (LAS float*)F.lds;
        LAS float* P = (LAS float*)(F.lds + 40960);
        for (int i = F.tid; i < 9 * 1024; i += NTHR) { const int r = i >> 10, k = i & 1023; const float v = r < 8 ? a.in[I_C][r * 1024 + k] : a.in[I_CCTX][k]; S[i] = v / (1.f + expf(-v)); }
        __syncthreads();
        float* MOD = (float*)(ws + WS_MOD);
        for (int it = abx; it < 4 * 96; it += aG) {
            const int l = it / 96, n0 = (it % 96) * 64;
            const float* W = a.in[I_WADA] + (size_t)l * 1024 * 6144 + n0 + F.lane;
            float acc[9];
#pragma unroll
            for (int r = 0; r < 9; ++r) acc[r] = 0.f;
            const int kb = F.wave * 128;
            for (int k0 = 0; k0 < 128; k0 += 32) {
                float w[32];
#pragma unroll
                for (int kk = 0; kk < 32; ++kk) w[kk] = __builtin_nontemporal_load(W + (size_t)(kb + k0 + kk) * 6144);
#pragma unroll
                for (int kk = 0; kk < 32; ++kk) {
#pragma unroll
                    for (int r = 0; r < 9; ++r) acc[r] += S[r * 1024 + kb + k0 + kk] * w[kk]; } }
#pragma unroll
            for (int r = 0; r < 9; ++r) P[(F.wave * 9 + r) * 64 + F.lane] = acc[r];
            __syncthreads();
            for (int o = F.tid; o < 9 * 64; o += NTHR) { const int r = o >> 6, n = o & 63; float s = 0.f;
#pragma unroll
                for (int w = 0; w < 8; ++w) s += P[(w * 9 + r) * 64 + n];
                MOD[((size_t)l * 9 + r) * 6144 + n0 + n] = s + a.in[I_BADA][l * 6144 + n0 + n]; }
            __syncthreads();
        }
    }
    if (aux && abx == 0) {
        float* RC = (float*)(ws + WS_SMALL); float* RS = RC + 1024;
        for (int i = F.tid; i < 1024; i += NTHR) { const int pos = i >> 4, f = i & 15; const float inv = powf(10000.f, -(float)(2 * f) / 32.f); const float ang = (float)pos * inv; RC[i] = cosf(ang); RS[i] = sinf(ang); }
    }
    __syncthreads();
    if (aux) {
        LAS float* ZB = (LAS float*)F.lds;
        LAS float* H1 = ZB + 512;
        LAS float* HB = H1 + 512;
        h16* FILT = (h16*)(ws + WS_FILT);
        const float* f1w = a.in[I_F1W]; const float* f2w = a.in[I_F2W]; const float* f3w = a.in[I_F3W];
        for (int it = abx; it < L / 8; it += aG) {
            const int p0 = it * 8; const int t = p0 + F.wave;
            {
                const float tl = (float)t / (float)(L - 1); const float wang = 2.0f * 3.14159265358979323846f * (float)t / (float)L;
                float zv = 0.f;
                if (F.lane == 0) zv = tl;
                else if (F.lane < 33) { const int q = (F.lane - 1) & 15; const float fq = 1e-4f + (float)q * ((15.0f - 1e-4f) / 15.0f); const float ang = fq * wang; zv = F.lane < 17 ? cosf(ang) : -sinf(ang); }
                ZB[F.wave * 64 + F.lane] = zv;
                LDS_WAIT();
                float s = a.in[I_F1B][F.lane];
                for (int i = 0; i < 33; ++i) s += ZB[F.wave * 64 + i] * f1w[i * 64 + F.lane];
                const float h1 = sinf(a.in[I_F1F][F.lane] * s);
                H1[F.wave * 64 + F.lane] = h1;
                LDS_WAIT();
                float s2 = a.in[I_F2B][F.lane];
                for (int k = 0; k < 64; ++k) s2 += H1[F.wave * 64 + k] * f2w[k * 64 + F.lane];
                HB[F.wave * 64 + F.lane] = sinf(a.in[I_F2F][F.lane] * s2);
            }
            __syncthreads();
            for (int cc = F.wave; cc < 16; cc += 8) {
                const int n = cc * 256 + 4 * F.lane;
                f32x4 acc[8];
#pragma unroll
                for (int p = 0; p < 8; ++p) acc[p] = (f32x4){0.f, 0.f, 0.f, 0.f};
                for (int k = 0; k < 64; ++k) { const f32x4 w = *(const f32x4*)(f3w + (size_t)k * 4096 + n);
#pragma unroll
                    for (int p = 0; p < 8; ++p) acc[p] += w * HB[p * 64 + k]; }
                const int o2 = n >> 10, c0 = n & 1023;
                const float mind = logf(1e-2f) / 1.5f, maxd = logf(1e-2f) / 0.3f;
#pragma unroll
                for (int j = 0; j < 4; ++j) { const int c = c0 + j; const float delta = fabsf(mind + (float)c * ((maxd - mind) / (float)(D - 1)));
                    float o[8];
#pragma unroll
                    for (int p = 0; p < 8; ++p) { const float tl = (float)(p0 + p) / (float)(L - 1); o[p] = acc[p][j] * expf(-tl * delta); }
                    u32x4 w; w.x = pk2h(o[0], o[1]); w.y = pk2h(o[2], o[3]); w.z = pk2h(o[4], o[5]); w.w = pk2h(o[6], o[7]);
                    *(u32x4*)(FILT + ((size_t)(o2 * 1024 + c) * L + p0)) = w; }
            }
            __syncthreads();
        }
    }
}

DI void rows_load(const float* src, int lane, f32x4 (&v)[4]) {
#pragma unroll
    for (int j = 0; j < 4; ++j) v[j] = __builtin_nontemporal_load((const f32x4*)(src + 4 * lane + 256 * j));
}
DI void rows_load_h(const h16* src, int lane, f32x4 (&v)[4]) {
#pragma unroll
    for (int j = 0; j < 4; ++j) v[j] = unpack4(*(const u32x2*)(src + 4 * lane + 256 * j));
}
DI void rows_phase(const Ctx& F, CArgs& a, int nrows, bool copy_in, bool combine, int lmoe, int lnext, bool final_out, bool from_input = false) {
    unsigned char* ws = a.ws;
    h16* XC = (h16*)(ws + WS_XC); h16* H = (h16*)(ws + WS_H);
    const float* MOD = (const float*)(ws + WS_MOD);
    const int* SLOT = (const int*)(ws + WS_SLOT); const unsigned char* YE = ws + WS_XIN;
    const bool ext = copy_in || from_input;
    int row = F.gw;
    f32x4 nv[4]; int nslot = -1;
    if (row < nrows) { if (ext) rows_load(row < T ? a.in[I_X] + (size_t)row * D : a.in[I_CTX] + (size_t)(row - T) * D, F.lane, nv); else rows_load_h(XC + (size_t)row * D, F.lane, nv);
        if (combine) nslot = SLOT[(size_t)row * 16 + (F.lane & 15)]; }
    for (; row < nrows; row += F.NGW) {
        const int r9 = row < T ? (row >> 11) : 8;
        f32x4 v[4];
#pragma unroll
        for (int j = 0; j < 4; ++j) v[j] = nv[j];
        const int myslot = nslot;
        { const int nr = row + F.NGW < nrows ? row + F.NGW : row;
          if (ext) rows_load(nr < T ? a.in[I_X] + (size_t)nr * D : a.in[I_CTX] + (size_t)(nr - T) * D, F.lane, nv); else rows_load_h(XC + (size_t)nr * D, F.lane, nv);
          if (combine) nslot = SLOT[(size_t)nr * 16 + (F.lane & 15)]; }
        f32x4 g2v[4], gA[4], shA[4], scA[4];
        if (combine) { const float* g2 = MOD + ((size_t)lmoe * 9 + r9) * 6144 + 5120 + 4 * F.lane;
#pragma unroll
            for (int j = 0; j < 4; ++j) g2v[j] = *(const f32x4*)(g2 + 256 * j); }
        if (final_out) {
#pragma unroll
            for (int j = 0; j < 4; ++j) gA[j] = *(const f32x4*)(a.in[I_FG] + 4 * F.lane + 256 * j);
        } else { const float* g1 = a.in[I_N1G] + lnext * D + 4 * F.lane; const float* md = MOD + ((size_t)lnext * 9 + r9) * 6144 + 4 * F.lane;
#pragma unroll
            for (int j = 0; j < 4; ++j) { gA[j] = *(const f32x4*)(g1 + 256 * j); shA[j] = *(const f32x4*)(md + 256 * j); scA[j] = *(const f32x4*)(md + 1024 + 256 * j); } }
        if (combine) {
            f32x4 s[4];
#pragma unroll
            for (int j = 0; j < 4; ++j) s[j] = (f32x4){0.f, 0.f, 0.f, 0.f};
            unsigned m = (unsigned)(__ballot(myslot >= 0) & 0xFFFFull);
            while (m) {
                int sl[4]; unsigned y[4][4];
#pragma unroll
                for (int q = 0; q < 4; ++q) { sl[q] = -1; if (m) { const int e = __builtin_ctz(m); m &= m - 1; sl[q] = __builtin_amdgcn_readlane(myslot, e); } }
#pragma unroll
                for (int q = 0; q < 4; ++q) if (sl[q] >= 0) { const unsigned char* yp = YE + (size_t)sl[q] * D + 4 * F.lane;
#pragma unroll
                    for (int j = 0; j < 4; ++j) y[q][j] = *(const unsigned*)(yp + 256 * j); }
#pragma unroll
                for (int q = 0; q < 4; ++q) if (sl[q] >= 0) {
#pragma unroll
                    for (int j = 0; j < 4; ++j) { const f32x2 lo = __builtin_amdgcn_cvt_pk_f32_fp8((int)y[q][j], false), hi2 = __builtin_amdgcn_cvt_pk_f32_fp8((int)y[q][j], true);
                        s[j] += (f32x4){lo.x, lo.y, hi2.x, hi2.y}; } }
            }
#pragma unroll
            for (int j = 0; j < 4; ++j) v[j] += g2v[j] * s[j] * (1.f / 16.f);
        }
        float ss = 0.f;
#pragma unroll
        for (int j = 0; j < 4; ++j) ss += (v[j].x * v[j].x + v[j].y * v[j].y) + (v[j].z * v[j].z + v[j].w * v[j].w);
        const float rstd = 1.0f / sqrtf(wave_sum(ss, F.lane) * (1.f / D) + 1e-6f);
        if (final_out) {
            f32x4 o[4];
#pragma unroll
            for (int j = 0; j < 4; ++j) o[j] = v[j] * rstd * gA[j];
            if (row < T) {
#pragma unroll
                for (int j = 0; j < 4; ++j) __builtin_nontemporal_store(o[j], (f32x4*)(a.out + (size_t)row * D + 4 * F.lane + 256 * j)); }
        } else {
            u32x2 hw[4];
#pragma unroll
            for (int j = 0; j < 4; ++j) { const f32x4 h = (v[j] * rstd * gA[j]) * (1.f + scA[j]) + shA[j];
                hw[j].x = pk2h(h.x, h.y); hw[j].y = pk2h(h.z, h.w); }
            if (copy_in || combine) {
#pragma unroll
                for (int j = 0; j < 4; ++j) { u32x2 w; w.x = pk2h(v[j].x, v[j].y); w.y = pk2h(v[j].z, v[j].w); *(u32x2*)(XC + (size_t)row * D + 4 * F.lane + 256 * j) = w; } }
#pragma unroll
            for (int j = 0; j < 4; ++j) *(u32x2*)(H + (size_t)row * D + 4 * F.lane + 256 * j) = hw[j];
        }
    }
}


DI void cg_load_u(const h16* BCV, int row, int c0, float (&u)[8]) {
    float cg[8], v[8];
    unpack8(*(const u32x4*)(BCV + (size_t)row * 3072 + 1024 + c0), cg); unpack8(*(const u32x4*)(BCV + (size_t)row * 3072 + 2048 + c0), v);
#pragma unroll
    for (int q = 0; q < 8; ++q) u[q] = cg[q] * v[q];
}
DI void cg_raw(const h16* BU, int row, int c0, u32x4& ur) { ur = *(const u32x4*)(BU + (size_t)row * 2048 + 1024 + c0); }
DI void cg_mul(const u32x4& ur, bool valid, float (&u)[8]) {
    float t[8]; unpack8(ur, t);
#pragma unroll
    for (int q = 0; q < 8; ++q) u[q] = valid ? t[q] : 0.f;
}
DI void convgate_phase(const Ctx& F, CArgs& a, int j, int nrows) {
    const h16* BU = (const h16*)(a.ws + WS_BIG); h16* Z = (h16*)(a.ws + WS_Z);
    const float* cw = a.in[I_ACONV] + (size_t)j * 3 * D;
    const int RI = nrows == T ? 16 : 8;
    const int nitems = (nrows / RI) * 2;
    for (int it = F.gw; it < nitems; it += F.NGW) {
        const int hsel = it & 1, r0 = (it >> 1) * RI, c0 = hsel * 512 + 8 * F.lane;
        const int ls = r0 < T ? L : LC; const int t0 = r0 < T ? (r0 & (L - 1)) : ((r0 - T) & (LC - 1));
        u32x4 cm, c0r, c1r, cA, cB, bw, bw1;
        cg_raw(BU, r0 - 1, c0, cm); cg_raw(BU, r0, c0, c0r); cg_raw(BU, r0 + 1, c0, c1r);
        bw = *(const u32x4*)(BU + (size_t)r0 * 2048 + c0);
        cg_raw(BU, r0 + 2, c0, cA); cg_raw(BU, r0 + 3, c0, cB);
        bw1 = *(const u32x4*)(BU + (size_t)(r0 + 1) * 2048 + c0);
        float w0[8], w1[8], w2[8];
#pragma unroll
        for (int q = 0; q < 8; ++q) { w0[q] = cw[c0 + q]; w1[q] = cw[D + c0 + q]; w2[q] = cw[2 * D + c0 + q]; }
        __builtin_amdgcn_sched_barrier(0);
        float up[8], uc[8], un[8];
        cg_mul(cm, t0 > 0, up); cg_mul(c0r, true, uc); cg_mul(c1r, t0 + 1 < ls, un);
        for (int i = 0; i < RI; ++i) {
            const int row = r0 + i;
            u32x4 cN, bw2;
            { const int k4 = i + 4 < RI ? i + 4 : RI, k2 = i + 2 < RI ? i + 2 : RI - 1;
              cg_raw(BU, r0 + k4, c0, cN); bw2 = *(const u32x4*)(BU + (size_t)(r0 + k2) * 2048 + c0); }
            float un2[8]; cg_mul(cA, (i + 2 <= RI) && (t0 + i + 2 < ls), un2);
            float bv[8], o[8]; unpack8(bw, bv);
#pragma unroll
            for (int q = 0; q < 8; ++q) o[q] = bv[q] * (w0[q] * up[q] + w1[q] * uc[q] + w2[q] * un[q]);
            u32x4 w; w.x = pk2h(o[0], o[1]); w.y = pk2h(o[2], o[3]); w.z = pk2h(o[4], o[5]); w.w = pk2h(o[6], o[7]);
            *(u32x4*)(Z + (size_t)row * D + c0) = w;
#pragma unroll
            for (int q = 0; q < 8; ++q) { up[q] = uc[q]; uc[q] = un[q]; un[q] = un2[q]; }
            bw = bw1; bw1 = bw2; cA = cB; cB = cN;
        }
    }
}

DI void moe_rows_phase(const Ctx& F, CArgs& a, int l, int nrows) {
    unsigned char* ws = a.ws;
    const h16* XC = (const h16*)(ws + WS_XC); unsigned char* H8 = ws + WS_Z; const float* MOD = (const float*)(ws + WS_MOD); float* AFF = (float*)(ws + WS_AFF);
    LAS float* WR = (LAS float*)F.lds;
    const float* rt = a.in[I_ROUTER] + (size_t)l * 1024 * 16;
    const int ngroups = nrows >> 2;
    u32x2 raw[4][4];
    if (F.gw < ngroups) {
#pragma unroll
        for (int r = 0; r < 4; ++r)
#pragma unroll
            for (int c = 0; c < 4; ++c) raw[r][c] = *(const u32x2*)(XC + (size_t)(F.gw * 4 + r) * D + 4 * F.lane + 256 * c); }
    { float tv[32];
#pragma unroll
      for (int k = 0; k < 32; ++k) tv[k] = rt[F.tid + NTHR * k];
      __builtin_amdgcn_sched_barrier(0);
#pragma unroll
      for (int k = 0; k < 32; ++k) { const int i = F.tid + NTHR * k; WR[(i & 15) * 1028 + (i >> 4)] = tv[k]; } }
    __syncthreads();
    const int rs = F.lane >> 4, l16 = F.lane & 15;
    const float* g2 = a.in[I_N2G] + l * D + 4 * F.lane;
    for (int grp = F.gw; grp < ngroups; grp += F.NGW) {
        const int row0 = grp * 4;
        const int r9 = row0 < T ? (row0 >> 11) : 8;
        f32x4 gq[4], shq[4], scq[4];
        const float* md = MOD + ((size_t)l * 9 + r9) * 6144 + 3072 + 4 * F.lane;
#pragma unroll
        for (int c = 0; c < 4; ++c) { gq[c] = *(const f32x4*)(g2 + 256 * c); shq[c] = *(const f32x4*)(md + 256 * c); scq[c] = *(const f32x4*)(md + 1024 + 256 * c); }
        __builtin_amdgcn_sched_barrier(0);
        f32x4 h[4][4];
        float ss[4];
#pragma unroll
        for (int r = 0; r < 4; ++r) { float s_ = 0.f;
#pragma unroll
            for (int c = 0; c < 4; ++c) { h[r][c] = unpack4(raw[r][c]); s_ += (h[r][c].x * h[r][c].x + h[r][c].y * h[r][c].y) + (h[r][c].z * h[r][c].z + h[r][c].w * h[r][c].w); }
            ss[r] = s_; }
        { const int gnx = min(grp + F.NGW, ngroups - 1);
#pragma unroll
            for (int r = 0; r < 4; ++r)
#pragma unroll
                for (int c = 0; c < 4; ++c) raw[r][c] = *(const u32x2*)(XC + (size_t)(gnx * 4 + r) * D + 4 * F.lane + 256 * c); }
        __builtin_amdgcn_sched_barrier(0);
#pragma unroll
        for (int o = 1; o < 64; o <<= 1)
#pragma unroll
            for (int r = 0; r < 4; ++r) ss[r] += sx(ss[r], o, F.lane);
        unsigned w8[4][4];
        f32x2 hx[2][4][4];
#pragma unroll
        for (int c = 0; c < 4; ++c) { const f32x4 g = gq[c], sh = shq[c], sc = scq[c];
#pragma unroll
            for (int r = 0; r < 4; ++r) { const float rstd = 1.0f / sqrtf(ss[r] * (1.f / D) + 1e-6f);
                const f32x4 v = (h[r][c] * rstd * g) * (1.f + sc) + sh;
                w8[r][c] = pk4f8(v.x * 8.f, v.y * 8.f, v.z * 8.f, v.w * 8.f);
                hx[r >> 1][c][0][r & 1] = v.x; hx[r >> 1][c][1][r & 1] = v.y; hx[r >> 1][c][2][r & 1] = v.z; hx[r >> 1][c][3][r & 1] = v.w; } }
        f32x2 p[2][16];
#pragma unroll
        for (int e = 0; e < 16; ++e) { f32x2 q0 = {0.f, 0.f}, q1_ = {0.f, 0.f};
#pragma unroll
            for (int c = 0; c < 4; ++c) { const f32x4 w = *(const LAS f32x4*)(WR + e * 1028 + 4 * F.lane + 256 * c);
#pragma unroll
                for (int i = 0; i < 4; ++i) { const f32x2 wv = {w[i], w[i]}; q0 = __builtin_elementwise_fma(hx[0][c][i], wv, q0); q1_ = __builtin_elementwise_fma(hx[1][c][i], wv, q1_); } }
            p[0][e] = q0; p[1][e] = q1_; if ((e & 1) == 1) __builtin_amdgcn_sched_barrier(0); }
        float p16[16];
        { const bool hb = (F.lane & 32) != 0; float t2[2][16];
#pragma unroll
          for (int e = 0; e < 16; ++e)
#pragma unroll
              for (int k = 0; k < 2; ++k) { const float send = hb ? p[0][e][k] : p[1][e][k], keep = hb ? p[1][e][k] : p[0][e][k]; t2[k][e] = keep + sx(send, 32, F.lane); }
          const bool hc = (F.lane & 16) != 0;
#pragma unroll
          for (int e = 0; e < 16; ++e) { const float send = hc ? t2[0][e] : t2[1][e], keep = hc ? t2[1][e] : t2[0][e]; p16[e] = keep + sx(send, 16, F.lane); } }
        float q8[8], q4[4], q2[2], q1;
        { const bool hb = (l16 & 8) != 0;
#pragma unroll
          for (int i = 0; i < 8; ++i) { const float send = hb ? p16[i] : p16[i + 8], keep = hb ? p16[i + 8] : p16[i]; q8[i] = keep + sx(send, 8, F.lane); } }
        { const bool hb = (l16 & 4) != 0;
#pragma unroll
          for (int i = 0; i < 4; ++i) { const float send = hb ? q8[i] : q8[i + 4], keep = hb ? q8[i + 4] : q8[i]; q4[i] = keep + sx(send, 4, F.lane); } }
        { const bool hb = (l16 & 2) != 0;
#pragma unroll
          for (int i = 0; i < 2; ++i) { const float send = hb ? q4[i] : q4[i + 2], keep = hb ? q4[i + 2] : q4[i]; q2[i] = keep + sx(send, 2, F.lane); } }
        { const bool hb = (l16 & 1) != 0; const float send = hb ? q2[0] : q2[1], keep = hb ? q2[1] : q2[0]; q1 = keep + sx(send, 1, F.lane); }
        float mx = q1;
#pragma unroll
        for (int o = 1; o < 16; o <<= 1) mx = fmaxf(mx, sx(mx, o, F.lane));
        const float mine = expf(q1 - mx);
        float sum = mine;
#pragma unroll
        for (int o = 1; o < 16; o <<= 1) sum += sx(sum, o, F.lane);
        const float af = mine / sum;
#pragma unroll
        for (int r = 0; r < 4; ++r)
#pragma unroll
            for (int c = 0; c < 4; ++c) *(unsigned*)(H8 + (size_t)(row0 + r) * D + 4 * F.lane + 256 * c) = w8[r][c];
        const int row = row0 + rs;
        if (row < T) AFF[((size_t)(row >> 11) * 16 + l16) * L + (row & (L - 1))] = af;
        else { const int rc = row - T; AFF[(size_t)NB * 16 * L + ((size_t)(rc >> 8) * 16 + l16) * LC + (rc & (LC - 1))] = af; }
    }
}

DI int lanes_below(unsigned long long m) { return (int)__builtin_amdgcn_mbcnt_hi((unsigned)(m >> 32), __builtin_amdgcn_mbcnt_lo((unsigned)m, 0u)); }
DI void topk_phase(const Ctx& F, CArgs& a, int l) {
    unsigned char* ws = a.ws;
    const float* AFF = (const float*)(ws + WS_AFF); int* SLOT = (int*)(ws + WS_SLOT); float* GATE = (float*)(ws + WS_GATE);
    int* SEL = (int*)(ws + WS_GATE + 512 * 1024);
    volatile LAS int* CNT = (volatile LAS int*)F.lds;
    const int nitems = 128 + (l == 0 ? 128 : 0);
    for (int it = F.bx; it < nitems; it += F.G) {
        const bool ctx = it >= 128; const int id = it & 127, e = id >> 3, b = id & 7;
        const int N = ctx ? LC : L, cap = ctx ? CAPC : CAP;
        const float* src = ctx ? AFF + (size_t)NB * 16 * L + ((size_t)b * 16 + e) * LC : AFF + ((size_t)b * 16 + e) * L;
        unsigned kb[4];
        { f32x4 v = {0.f, 0.f, 0.f, 0.f}; if (4 * F.tid < N) v = *(const f32x4*)(src + 4 * F.tid);
          kb[0] = __float_as_uint(v.x); kb[1] = __float_as_uint(v.y); kb[2] = __float_as_uint(v.z); kb[3] = __float_as_uint(v.w); }
        unsigned cur = 0u; int par = 0;
        for (int bit = 30; bit >= 0; --bit) {
            const unsigned cand = cur | (1u << bit);
            int c = 0;
#pragma unroll
            for (int q = 0; q < 4; ++q) c += __builtin_popcountll(__ballot(kb[q] >= cand));
            if (F.lane == 0) CNT[par * 8 + F.wave] = c;
            __syncthreads();
            int tot = 0;
#pragma unroll
            for (int w = 0; w < 8; ++w) tot += CNT[par * 8 + w];
            if (tot >= cap) cur = cand;
            par ^= 1;
        }
        unsigned long long mg[4], me[4]; int cg = 0, ce = 0;
#pragma unroll
        for (int q = 0; q < 4; ++q) { mg[q] = __ballot(kb[q] > cur); me[q] = __ballot(kb[q] == cur); cg += __builtin_popcountll(mg[q]); ce += __builtin_popcountll(me[q]); }
        __syncthreads();
        if (F.lane == 0) { CNT[16 + F.wave] = cg; CNT[24 + F.wave] = ce; }
        __syncthreads();
        int n_gt = 0, eq_before_wave = 0;
#pragma unroll
        for (int w = 0; w < 8; ++w) { const int g_ = CNT[16 + w], e_ = CNT[24 + w]; n_gt += g_; eq_before_wave += (w < F.wave) ? e_ : 0; }
        const int need_eq = cap - n_gt;
        int eqb = eq_before_wave;
#pragma unroll
        for (int q = 0; q < 4; ++q) eqb += lanes_below(me[q]);
        bool sel[4]; int eq_run = eqb;
#pragma unroll
        for (int q = 0; q < 4; ++q) { const bool isg = kb[q] > cur, ise = kb[q] == cur; sel[q] = isg || (ise && eq_run < need_eq); eq_run += ise ? 1 : 0; }
        unsigned long long ms[4]; int cs = 0;
#pragma unroll
        for (int q = 0; q < 4; ++q) { ms[q] = __ballot(sel[q]); cs += __builtin_popcountll(ms[q]); }
        __syncthreads();
        if (F.lane == 0) CNT[16 + F.wave] = cs;
        __syncthreads();
        int slot = 0;
#pragma unroll
        for (int w = 0; w < 8; ++w) slot += (w < F.wave) ? CNT[16 + w] : 0;
#pragma unroll
        for (int q = 0; q < 4; ++q) slot += lanes_below(ms[q]);
        const int gbase = ctx ? NGL + id * CAPC : id * CAP, rowbase = ctx ? T + b * LC : b * L;
        if (4 * F.tid < N) {
#pragma unroll
            for (int q = 0; q < 4; ++q) { const int row = rowbase + 4 * F.tid + q;
                if (sel[q]) { const int g = gbase + slot; SLOT[(size_t)row * 16 + e] = g; GATE[g] = __uint_as_float(kb[q]); SEL[g] = row; ++slot; }
                else SLOT[(size_t)row * 16 + e] = -1; }
        }
        __syncthreads();
    }
}

namespace attn_body {
constexpr int DM = 1024, NW = 8, QBLK = 32, QB = 256, KVBLK = 64, NT = KVR / KVBLK;
DI int crow(int r, int hi) { return (r & 3) + 8 * (r >> 2) + 4 * hi; }
#define SBAR() __builtin_amdgcn_sched_barrier(0)
constexpr int NSLOT = 3, SLOTB = 8192;
constexpr int LDS_K = 0, LDS_V = NSLOT * SLOTB, LDS_WS = 2 * NSLOT * SLOTB, LDS_OST = LDS_WS + NW * 64 * 4, LDS_BYTES_A = LDS_OST + NW * 4096;
DI void glds16(const void* gsrc, unsigned lds_dst) { unsigned keep;
    asm volatile("s_mov_b32 %0, m0\n\ts_mov_b32 m0, %2\n\ts_nop 0\n\tglobal_load_lds_dwordx4 %1, off\n\ts_mov_b32 m0, %0" : "=&s"(keep) : "v"(gsrc), "s"(lds_dst) : "memory"); }
DI float max3f(float a, float b, float c) { float r; asm("v_max3_f32 %0, %1, %2, %3" : "=v"(r) : "v"(a), "v"(b), "v"(c)); return r; }
DI float max2f(float a, float b) { float r; asm("v_max_f32_e32 %0, %1, %2" : "=v"(r) : "v"(a), "v"(b)); return r; }
DI float fadd_s(float a, float b) { float r; asm("v_add_f32_e32 %0, %1, %2" : "=v"(r) : "v"(a), "v"(b)); return r; }
DI float fsub_s(float a, float b) { float r; asm("v_sub_f32_e32 %0, %1, %2" : "=v"(r) : "v"(a), "v"(b)); return r; }
DI unsigned cvtpk_s(float lo, float hi) { return pk2h(lo, hi); }
DI f32x16 MF(s16x8 x, s16x8 y, f32x16 c) { return __builtin_amdgcn_mfma_f32_32x32x16_f16(__builtin_bit_cast(half8, x), __builtin_bit_cast(half8, y), c, 0, 0, 0); }
#define WAIT_BAR(N) asm volatile("s_waitcnt vmcnt(" #N ") lgkmcnt(0)\n\ts_barrier" ::: "memory")
DI void qkt(f32x16& p0, f32x16& p1, const char* Kslot, const s16x8* qr, const f32x16& negm, int r32, int hi) {
    const char* kb = Kslot + hi * 1024 + r32 * 16;
#pragma unroll
    for (int d0 = 0; d0 < 4; ++d0) {
        const s16x8 b0 = *reinterpret_cast<const s16x8*>(kb + d0 * 2048);
        const s16x8 b1 = *reinterpret_cast<const s16x8*>(kb + d0 * 2048 + 512);
        if (d0 == 0) { p0 = MF(b0, qr[0], negm); p1 = MF(b1, qr[0], negm); }
        else { p0 = MF(b0, qr[d0], p0); p1 = MF(b1, qr[d0], p1); } }
}
typedef __attribute__((address_space(3))) const char* lds_cptr;
typedef short v4i16_t __attribute__((ext_vector_type(4)));
DI void kload8(s16x8* kf, lds_cptr kp) {
    kf[0] = *(const LAS s16x8*)(kp);        kf[1] = *(const LAS s16x8*)(kp + 512);
    kf[2] = *(const LAS s16x8*)(kp + 2048); kf[3] = *(const LAS s16x8*)(kp + 2560);
    kf[4] = *(const LAS s16x8*)(kp + 4096); kf[5] = *(const LAS s16x8*)(kp + 4608);
    kf[6] = *(const LAS s16x8*)(kp + 6144); kf[7] = *(const LAS s16x8*)(kp + 6656);
}
DI void kload2(s16x8* kf, lds_cptr kp, int j) { kf[2 * j] = *(const LAS s16x8*)(kp + j * 2048); kf[2 * j + 1] = *(const LAS s16x8*)(kp + j * 2048 + 512); }
DI s16x4 vtr(lds_cptr p) { return __builtin_bit_cast(s16x4, __builtin_amdgcn_ds_read_tr16_b64_v4i16((LAS v4i16_t*)p)); }
DI float rowmax(const f32x16& p0, const f32x16& p1) {
    float a = max3f(p0[0], p0[1], p1[0]), b = max3f(p0[2], p0[3], p1[1]); a = max3f(a, p1[2], p1[3]);
#pragma unroll
    for (int r = 4; r < 16; r += 4) { a = max3f(a, p0[r], p0[r + 1]); b = max3f(b, p0[r + 2], p0[r + 3]); a = max3f(a, p1[r], p1[r + 1]); b = max3f(b, p1[r + 2], p1[r + 3]); }
    const float m = max2f(a, b);
    auto rr = __builtin_amdgcn_permlane32_swap(__float_as_uint(m), __float_as_uint(m), false, false);
    return max2f(__uint_as_float(rr[0]), __uint_as_float(rr[1]));
}
DI void pv(f32x16* o, int vb, s16x8 pa0, s16x8 pa1, s16x8 pa2, s16x8 pa3) {
#pragma unroll
    for (int d0 = 0; d0 < 2; ++d0) { s16x4 lo[4], hi[4];
#pragma unroll
        for (int ks = 0; ks < 4; ++ks) {
            asm volatile("ds_read_b64_tr_b16 %0,%1 offset:%c2" : "=&v"(lo[ks]) : "v"(vb), "i"(d0 * 4096 + ks * 1024) : "memory");
            asm volatile("ds_read_b64_tr_b16 %0,%1 offset:%c2" : "=&v"(hi[ks]) : "v"(vb), "i"(d0 * 4096 + ks * 1024 + 512) : "memory"); }
        asm volatile("s_waitcnt lgkmcnt(0)" ::: "memory"); SBAR();
#define PK(k) (s16x8){lo[k][0], lo[k][1], lo[k][2], lo[k][3], hi[k][0], hi[k][1], hi[k][2], hi[k][3]}
        o[d0] = MF(pa0, PK(0), o[d0]);
        o[d0] = MF(pa1, PK(1), o[d0]);
        o[d0] = MF(pa2, PK(2), o[d0]);
        o[d0] = MF(pa3, PK(3), o[d0]);
#undef PK
    }
}
template <int THRL> DI void attn_unit2(const int tid, const hf* Qw0, const hf* __restrict__ Kh, const hf* __restrict__ Vh, hf* Ow0, char* shm,
                                        const bool fuse = false, const hf* O1src = nullptr, const float lam = 0.f, const float* subg = nullptr) {
    const int lane = tid & 63, r32 = lane & 31, hi = lane >> 5; const int wid = __builtin_amdgcn_readfirstlane(tid >> 6);
    const hf* Qw = Qw0 + (long)(wid * QBLK) * DM;
    const unsigned lds0 = (unsigned)(uintptr_t)shm;
    constexpr int LDS_V2 = NSLOT * SLOTB, LDS_WS2 = LDS_V2 + NSLOT * 2 * SLOTB, LDS_OST2 = LDS_WS2 + NW * 64 * 4;
    float* wsf = (float*)(shm + LDS_WS2) + wid * 64;
    const hf* ksrc = Kh + (long)lane * DM + wid * 8;
    const hf* vsrc = Vh + (long)(16 * (wid & 3) + (lane >> 2)) * DM + (wid >> 2) * 32 + (lane & 3) * 8;
    const unsigned kdst = lds0 + LDS_K + wid * 1024, vdst = lds0 + LDS_V2 + wid * 1024;
#define DMA_K(t, slot) glds16(ksrc + (long)(t) * KVBLK * DM, (unsigned)__builtin_amdgcn_readfirstlane(kdst + (slot)))
#define DMA_V(t, slot) do { glds16(vsrc + (long)(t) * KVBLK * DM, (unsigned)__builtin_amdgcn_readfirstlane(vdst + 2 * (slot))); glds16(vsrc + (long)(t) * KVBLK * DM + 64, (unsigned)__builtin_amdgcn_readfirstlane(vdst + 2 * (slot) + 8192)); } while (0)
    const int vb0 = (int)(lds0 + LDS_V2) + ((lane >> 4) & 1) * 32 + (lane & 3) * 8 + (4 * hi + ((lane & 15) >> 2)) * 64;
    const char* Kbase = shm + LDS_K; s16x8 kf[8];
    const lds_cptr shm3 = (lds_cptr)shm; const lds_cptr kp0 = shm3 + LDS_K + hi * 1024 + r32 * 16; const lds_cptr vp0 = shm3 + LDS_V2 + ((lane >> 4) & 1) * 32 + (lane & 3) * 8 + (4 * hi + ((lane & 15) >> 2)) * 64;
    DMA_K(0, 0); DMA_V(0, 0); DMA_K(1, SLOTB);
    constexpr int LDS_Q2 = LDS_OST2 + NW * 4096;
    const lds_cptr qp0 = shm3 + LDS_Q2 + wid * 4096 + lane * 16;
    s16x8 qr[4];
#pragma unroll
    for (int d0 = 0; d0 < 4; ++d0) { qr[d0] = *reinterpret_cast<const s16x8*>(&Qw[(long)r32 * DM + d0 * 16 + hi * 8]); *(LAS s16x8*)((LAS char*)qp0 + d0 * 1024) = qr[d0]; }
#define QLD(d0) (*(const LAS s16x8*)(qp0 + (d0) * 1024))
    float mhat = 0.f, l_reg = 0.f; f32x16 o[4]; o[0] = f32x16{}; o[1] = f32x16{}; o[2] = f32x16{}; o[3] = f32x16{}; const f32x16 zero16 = f32x16{};
    bool resc = false;
#define START(P0, P1) do { const float rm = rowmax(P0, P1); resc = false; \
    { const float dl = rm; mhat = fadd_s(mhat, dl); \
      _Pragma("unroll") for (int r = 0; r < 16; ++r) { P0[r] = fsub_s(P0[r], dl); P1[r] = fsub_s(P1[r], dl); } } \
    _Pragma("unroll") for (int r = 0; r < 16; ++r) P0[r] = __builtin_amdgcn_exp2f(P0[r]); } while (0)
#define RESC() do { if (resc) { asm volatile("s_waitcnt lgkmcnt(0)" ::: "memory"); \
      _Pragma("unroll") for (int d_ = 0; d_ < 4; ++d_) _Pragma("unroll") for (int r = 0; r < 16; ++r) o[d_][r] *= wsf[crow(r, hi)]; } } while (0)
    f32x16 pA0, pA1, pB0, pB1;
    int sl_prev = 0, sl_cur = 0, sl_next = SLOTB;
#define ROT() do { sl_prev = sl_cur; sl_cur = sl_next; sl_next = (sl_next == (NSLOT - 1) * SLOTB) ? 0 : sl_next + SLOTB; } while (0)
    DMA_K(2, 2 * SLOTB);
    WAIT_BAR(3);
    qkt(pA0, pA1, Kbase, qr, zero16, r32, hi); asm volatile("s_nop 15\n\ts_nop 7" : "+v"(pA0), "+v"(pA1));
    START(pA0, pA1);
    _Pragma("unroll") for (int r = 0; r < 16; ++r) pA1[r] = __builtin_amdgcn_exp2f(pA1[r]);
    WAIT_BAR(0);
    DMA_K(3, 0); DMA_V(1, SLOTB);
    ROT();
    kload8(kf, kp0 + sl_cur);
    WAIT_BAR(3);
    s16x4 vlo[8], vhi[8]; u32x4 pw0, pw1, pw2, pw3;
    s16x8 qa_ = QLD(0), qb_ = QLD(1);
#define PKW(P, B) cvtpk_s(P[B], P[B + 1])
#define PAF(k) __builtin_bit_cast(s16x8, pw##k)
#define VFR(i) (s16x8){vlo[i][0], vlo[i][1], vlo[i][2], vlo[i][3], vhi[i][0], vhi[i][1], vhi[i][2], vhi[i][3]}
#define PIN(x) asm volatile("" : "+v"(x))
#define MX3(a, b, c) __builtin_fmaxf(__builtin_fmaxf((a), (b)), (c))
#define GAPA(MFX, A0, A1, A2, A3, W0, W1, PW) do { MFX; sacc += A0; sacc += A1; sacc += A2; sacc += A3; PIN(sacc); W0; W1; PIN(PW); SBAR(); } while (0)
#define EX(v) __builtin_amdgcn_exp2f(v)
#define GAPB(MFX, X, B) do { MFX; X[B] = EX(X[B]); X[B + 1] = EX(X[B + 1]); PIN(X); SBAR(); } while (0)
#define VRD(i) do { vlo[i] = vtr(vp_ + (((i) >> 2) * 4096 + ((i) & 3) * 1024)); vhi[i] = vtr(vp_ + (((i) >> 2) * 4096 + ((i) & 3) * 1024 + 512)); } while (0)
#define VRD2(i) do { vlo[i] = vtr(vp_ + (8192 + ((i) >> 2) * 4096 + ((i) & 3) * 1024)); vhi[i] = vtr(vp_ + (8192 + ((i) >> 2) * 4096 + ((i) & 3) * 1024 + 512)); } while (0)
#define KRD(G, j) do { if (G) { kload2(kf, kp0 + sl_next, j); SBAR(); } } while (0)
#define STEP(C0, C1, P0, P1, t, GK, GV, GL) do { SBAR(); \
    const lds_cptr vp_ = vp0 + 2 * sl_prev; \
    VRD(0); SBAR(); float sacc = (P0[0] + P0[1]); \
    GAPA(C0 = MF(kf[0], qa_, zero16), P0[2], P0[3], P0[4], P0[5],     pw0[0] = PKW(P0, 0), pw0[1] = PKW(P0, 2), pw0); \
    VRD(4); SBAR(); GAPA(C1 = MF(kf[1], qa_, zero16), P0[6], P0[7], P0[8], P0[9],     pw0[2] = PKW(P0, 4), pw0[3] = PKW(P0, 6), pw0); \
    qa_ = QLD(2); VRD(1); SBAR(); GAPA(C0 = MF(kf[2], qb_, C0),   P0[10], P0[11], P0[12], P0[13], pw1[0] = PKW(P0, 8), pw1[1] = PKW(P0, 10), pw1); \
    VRD(5); SBAR(); GAPA(C1 = MF(kf[3], qb_, C1),   P0[14], P0[15], P1[0], P1[1],   pw1[2] = PKW(P0, 12), pw1[3] = PKW(P0, 14), pw1); \
    qb_ = QLD(3); VRD(2); SBAR(); GAPA(C0 = MF(kf[4], qa_, C0),   P1[2], P1[3], P1[4], P1[5],     pw2[0] = PKW(P1, 0), pw2[1] = PKW(P1, 2), pw2); \
    VRD(6); SBAR(); GAPA(C1 = MF(kf[5], qa_, C1),   P1[6], P1[7], P1[8], P1[9],     pw2[2] = PKW(P1, 4), pw2[3] = PKW(P1, 6), pw2); \
    VRD(3); SBAR(); GAPA(C0 = MF(kf[6], qb_, C0),   P1[10], P1[11], P1[12], P1[13], pw3[0] = PKW(P1, 8), pw3[1] = PKW(P1, 10), pw3); \
    VRD(7); SBAR(); GAPA(C1 = MF(kf[7], qb_, C1),   P1[14], P1[15], 0.f, 0.f,       pw3[2] = PKW(P1, 12), pw3[3] = PKW(P1, 14), pw3); \
    l_reg += sacc; \
    if (GK) { DMA_K((t) + 3, sl_cur); } if (GV) { DMA_V((t) + 1, sl_next); } \
    { float a = MX3(C0[0], C0[1], C1[0]), b = MX3(C0[2], C0[3], C1[1]); a = MX3(a, C1[2], C1[3]); \
      _Pragma("unroll") for (int r = 4; r < 16; r += 4) { a = MX3(a, C0[r], C0[r + 1]); b = MX3(b, C0[r + 2], C0[r + 3]); a = MX3(a, C1[r], C1[r + 1]); b = MX3(b, C1[r + 2], C1[r + 3]); } \
      float rm = __builtin_fmaxf(a, b); { auto rr = __builtin_amdgcn_permlane32_swap(__float_as_uint(rm), __float_as_uint(rm), false, false); rm = __builtin_fmaxf(__uint_as_float(rr[0]), __uint_as_float(rr[1])); } \
      rm -= mhat;                                                       \
      resc = false; \
      if (__builtin_expect(__any(rm > (float)THRL), 0)) { const float dl = __builtin_fmaxf(rm, 0.f); mhat += dl; \
        const float f = __builtin_amdgcn_exp2f(-dl); l_reg *= f; if (hi == 0) wsf[r32] = f; resc = true; } \
      _Pragma("unroll") for (int r = 0; r < 16; ++r) { C0[r] -= mhat; C1[r] -= mhat; } } \
    SBAR(); \
    GAPB(o[0] = MF(PAF(0), VFR(0), o[0]), C0, 0); \
    GAPB(o[1] = MF(PAF(0), VFR(4), o[1]), C0, 2); \
    KRD(GL, 0); GAPB(o[0] = MF(PAF(1), VFR(1), o[0]), C0, 4); \
    VRD2(0); VRD2(4); SBAR(); \
    KRD(GL, 1); GAPB(o[1] = MF(PAF(1), VFR(5), o[1]), C0, 6); \
    KRD(GL, 2); GAPB(o[0] = MF(PAF(2), VFR(2), o[0]), C0, 8); \
    VRD2(1); VRD2(5); SBAR(); \
    KRD(GL, 3); GAPB(o[1] = MF(PAF(2), VFR(6), o[1]), C0, 10); \
    GAPB(o[0] = MF(PAF(3), VFR(3), o[0]), C0, 12); \
    VRD2(2); VRD2(6); SBAR(); \
    GAPB(o[1] = MF(PAF(3), VFR(7), o[1]), C0, 14); \
    VRD2(3); VRD2(7); SBAR(); \
    GAPB(o[2] = MF(PAF(0), VFR(0), o[2]), C1, 0); \
    GAPB(o[3] = MF(PAF(0), VFR(4), o[3]), C1, 2); \
    GAPB(o[2] = MF(PAF(1), VFR(1), o[2]), C1, 4); \
    GAPB(o[3] = MF(PAF(1), VFR(5), o[3]), C1, 6); \
    qa_ = QLD(0); qb_ = QLD(1); SBAR(); \
    GAPB(o[2] = MF(PAF(2), VFR(2), o[2]), C1, 8); \
    GAPB(o[3] = MF(PAF(2), VFR(6), o[3]), C1, 10); \
    GAPB(o[2] = MF(PAF(3), VFR(3), o[2]), C1, 12); \
    GAPB(o[3] = MF(PAF(3), VFR(7), o[3]), C1, 14); \
    } while (0)
    int t = 1;
    for (; t + 5 < NT; t += 2) {
        STEP(pB0, pB1, pA0, pA1, t, true, true, true);     WAIT_BAR(3); RESC(); ROT();
        STEP(pA0, pA1, pB0, pB1, t + 1, true, true, true); WAIT_BAR(3); RESC(); ROT();
    }
#define ENDW(tt) do { if ((tt) + 3 < NT) { WAIT_BAR(3); } else if ((tt) + 2 < NT) { WAIT_BAR(2); } else { WAIT_BAR(0); } } while (0)
    for (; t + 1 < NT; t += 2) {
        STEP(pB0, pB1, pA0, pA1, t, (t + 3 < NT), (t + 1 < NT), (t + 1 < NT));         ENDW(t);     RESC(); ROT();
        STEP(pA0, pA1, pB0, pB1, t + 1, (t + 4 < NT), (t + 2 < NT), (t + 2 < NT));     ENDW(t + 1); RESC(); ROT();
    }
    STEP(pB0, pB1, pA0, pA1, NT - 1, false, false, false); RESC();
    { float sacc = pB0[0] + pB0[1]; _Pragma("unroll") for (int r = 2; r < 16; ++r) sacc += pB0[r]; _Pragma("unroll") for (int r = 0; r < 16; ++r) sacc += pB1[r]; l_reg += sacc;
      pw0 = (u32x4){PKW(pB0, 0), PKW(pB0, 2), PKW(pB0, 4), PKW(pB0, 6)}; pw1 = (u32x4){PKW(pB0, 8), PKW(pB0, 10), PKW(pB0, 12), PKW(pB0, 14)}; pw2 = (u32x4){PKW(pB1, 0), PKW(pB1, 2), PKW(pB1, 4), PKW(pB1, 6)}; pw3 = (u32x4){PKW(pB1, 8), PKW(pB1, 10), PKW(pB1, 12), PKW(pB1, 14)};
      SBAR(); pv(o, vb0 + 2 * sl_cur, PAF(0), PAF(1), PAF(2), PAF(3)); pv(o + 2, vb0 + 2 * sl_cur + 8192, PAF(0), PAF(1), PAF(2), PAF(3)); }
#undef PKW
#undef PAF
#undef VFR
#undef PIN
#undef MX3
#undef GAPA
#undef GAPB
#undef EX
#undef VRD
#undef KRD
#undef STEP
#undef ENDW
    { auto rr = __builtin_amdgcn_permlane32_swap(__float_as_uint(l_reg), __float_as_uint(l_reg), false, false); l_reg = __uint_as_float(rr[0]) + __uint_as_float(rr[1]); }
    if (hi == 0) wsf[32 + r32] = l_reg; asm volatile("s_waitcnt lgkmcnt(0)" ::: "memory");
    float rli[16];
#pragma unroll
    for (int r = 0; r < 16; ++r) rli[r] = __builtin_amdgcn_rcpf(wsf[32 + crow(r, hi)]);
    hf* Ow = Ow0 + (long)(wid * QBLK) * DM;
    int lane2 = lane; asm volatile("" : "+v"(lane2));
    if (fuse) {
        asm volatile("s_waitcnt vmcnt(0)" ::: "memory");
        const hf* O1w = O1src + (long)(wid * QBLK) * DM; asm volatile("" : "+s"(O1w)); asm volatile("" : "+s"(Ow));
        u32x4 dvp[2][4]; float ssr[4] = {0.f, 0.f, 0.f, 0.f};
        hf* stg = (hf*)(shm + LDS_OST2) + wid * 2048;
#pragma unroll
        for (int hh2 = 0; hh2 < 2; ++hh2) {
            u32x4 x1r[4];
#pragma unroll
            for (int i = 0; i < 4; ++i) { const int row = i * 8 + (lane2 >> 3), ch = lane2 & 7; x1r[i] = *(const u32x4*)(O1w + (long)row * DM + 64 * hh2 + ch * 8); }
#pragma unroll
            for (int r = 0; r < 16; ++r) { const int orow = crow(r, hi);
#pragma unroll
                for (int d0 = 0; d0 < 2; ++d0) stg[orow * 64 + d0 * 32 + r32] = (hf)(o[2 * hh2 + d0][r] * rli[r]); }
            asm volatile("s_waitcnt lgkmcnt(0)" ::: "memory");
#pragma unroll
            for (int i = 0; i < 4; ++i) { const int row = i * 8 + (lane2 >> 3), ch = lane2 & 7; const u32x4 v2 = *(const u32x4*)(stg + row * 64 + ch * 8);
                float x1[8], x2[8]; unpack8(x1r[i], x1); unpack8(v2, x2);
#pragma unroll
                for (int j = 0; j < 8; ++j) { x1[j] -= lam * x2[j]; ssr[i] += x1[j] * x1[j]; }
                dvp[hh2][i].x = pk2h(x1[0], x1[1]); dvp[hh2][i].y = pk2h(x1[2], x1[3]); dvp[hh2][i].z = pk2h(x1[4], x1[5]); dvp[hh2][i].w = pk2h(x1[6], x1[7]); }
            asm volatile("s_waitcnt lgkmcnt(0)" ::: "memory");
        }
#pragma unroll
        for (int i = 0; i < 4; ++i) { float ss = ssr[i]; ss += sx(ss, 1, lane2); ss += sx(ss, 2, lane2); ss += sx(ss, 4, lane2); ssr[i] = (1.f - 0.35550907f) / sqrtf(ss * (1.f / 128.f) + 1e-5f); }
#pragma unroll
        for (int hh2 = 0; hh2 < 2; ++hh2) {
            const f32x4 g0 = *(const f32x4*)(subg + hh2 * 64 + (lane2 & 7) * 8), g1 = *(const f32x4*)(subg + hh2 * 64 + (lane2 & 7) * 8 + 4);
#pragma unroll
            for (int i = 0; i < 4; ++i) { const int row = i * 8 + (lane2 >> 3), ch = lane2 & 7; const float rs_ = ssr[i]; float dq[8]; unpack8(dvp[hh2][i], dq);
                u32x4 w; w.x = pk2h(dq[0] * rs_ * g0[0], dq[1] * rs_ * g0[1]); w.y = pk2h(dq[2] * rs_ * g0[2], dq[3] * rs_ * g0[3]);
                w.z = pk2h(dq[4] * rs_ * g1[0], dq[5] * rs_ * g1[1]); w.w = pk2h(dq[6] * rs_ * g1[2], dq[7] * rs_ * g1[3]);
                *(u32x4*)(Ow + (long)row * DM + 64 * hh2 + ch * 8) = w; } }
    } else
    { hf* stg = (hf*)(shm + LDS_OST2) + wid * 2048;
#pragma unroll
      for (int hh2 = 0; hh2 < 2; ++hh2) {
#pragma unroll
        for (int r = 0; r < 16; ++r) { const int orow = crow(r, hi);
#pragma unroll
          for (int d0 = 0; d0 < 2; ++d0) stg[orow * 64 + d0 * 32 + r32] = (hf)(o[2 * hh2 + d0][r] * rli[r]); }
        asm volatile("s_waitcnt lgkmcnt(0)" ::: "memory");
#pragma unroll
        for (int i = 0; i < 4; ++i) { const int row = i * 8 + (lane2 >> 3), ch = lane2 & 7; const u32x4 v = *(const u32x4*)(stg + row * 64 + ch * 8); *(u32x4*)(Ow + (long)row * DM + 64 * hh2 + ch * 8) = v; }
        asm volatile("s_waitcnt lgkmcnt(0)" ::: "memory");
      } }
    asm volatile("s_waitcnt lgkmcnt(0)\n\ts_barrier" ::: "memory");
#undef DMA_K
#undef QLD
#undef VRD2
#undef DMA_V
#undef START
#undef RESC
#undef ROT
}
#undef SBAR
#undef WAIT_BAR
}

DI void attn_phase(const Ctx& F, CArgs& a) {
    unsigned char* ws = a.ws;
    const hf* Q = (const hf*)(ws + WS_BIG); const hf* Kb = Q + (size_t)T * D; const hf* Vb = Kb + (size_t)NB * KVR * D;
    hf* OP = (hf*)(ws + WS_XIN); hf* ZN = (hf*)(ws + WS_Z);
    const float lam_init = 0.35550907f;
    const float l1 = wave_sum(a.in[I_LQ1][F.lane] * a.in[I_LK1][F.lane], F.lane), l2 = wave_sum(a.in[I_LQ2][F.lane] * a.in[I_LK2][F.lane], F.lane);
    const float lam_s = __int_as_float(__builtin_amdgcn_readfirstlane(__float_as_int(expf(l1) - expf(l2) + lam_init)));
    for (int i = 0;; ++i) {
        const long P = (long)(i >> 1) * F.G + F.vcu; if (P >= 512) break;
        const int r = i & 1, qb = (int)(P & 7), bh = (int)(P >> 3), b = bh >> 3, hh = bh & 7;
        const int qcol = hh * 128 + r * 64, vcol = hh * 128;
        const size_t orow0 = ((size_t)b * L + (size_t)qb * 256) * D + vcol;
        const hf* Qw0 = Q + ((size_t)b * L + (size_t)qb * 256) * D + qcol;
        const hf* Kh = Kb + (size_t)b * KVR * D + qcol; const hf* Vh = Vb + (size_t)b * KVR * D + vcol;
        attn_body::attn_unit2<8>(F.tid, Qw0, Kh, Vh, (r ? ZN : OP) + orow0, (char*)F.lds, r != 0, OP + orow0, lam_s, a.in[I_SUBG]);
    }
}

DI void attn_post_phase(const Ctx& F, CArgs& a) {
    unsigned char* ws = a.ws;
    const h16* O0 = (const h16*)(ws + WS_XIN); const h16* O1 = O0 + (size_t)T * D; h16* ON = (h16*)(ws + WS_Z);
    const float lam_init = 0.35550907f;
    const float l1 = wave_sum(a.in[I_LQ1][F.lane] * a.in[I_LK1][F.lane], F.lane), l2 = wave_sum(a.in[I_LQ2][F.lane] * a.in[I_LK2][F.lane], F.lane);
    const float lam = expf(l1) - expf(l2) + lam_init;
    float g[16];
#pragma unroll
    for (int i = 0; i < 16; ++i) g[i] = a.in[I_SUBG][(F.lane & 7) * 16 + i] * (1.f - lam_init);
    for (int row0 = F.gw; row0 < T; row0 += 4 * F.NGW) {
        u32x4 in[4][4];
#pragma unroll
        for (int q = 0; q < 4; ++q) { const int row = row0 + q * F.NGW; if (row < T) { const size_t off = (size_t)row * D + 16 * F.lane;
            in[q][0] = *(const u32x4*)(O0 + off); in[q][1] = *(const u32x4*)(O0 + off + 8); in[q][2] = *(const u32x4*)(O1 + off); in[q][3] = *(const u32x4*)(O1 + off + 8); } }
        u32x4 outw[4][2];
#pragma unroll
        for (int q = 0; q < 4; ++q) { const int row = row0 + q * F.NGW; if (row < T) {
            float x0[8], x1[8], y0[8], y1[8];
            unpack8(in[q][0], x0); unpack8(in[q][1], x1); unpack8(in[q][2], y0); unpack8(in[q][3], y1);
            float o[16]; float ss = 0.f;
#pragma unroll
            for (int i = 0; i < 8; ++i) { o[i] = x0[i] - lam * y0[i]; o[8 + i] = x1[i] - lam * y1[i]; }
#pragma unroll
            for (int i = 0; i < 16; ++i) ss += o[i] * o[i];
            ss += sx(ss, 1, F.lane); ss += sx(ss, 2, F.lane); ss += sx(ss, 4, F.lane);
            const float rstd = 1.0f / sqrtf(ss * (1.f / 128.f) + 1e-5f);
            u32x4 w0, w1;
            w0.x = pk2h(o[0] * rstd * g[0], o[1] * rstd * g[1]); w0.y = pk2h(o[2] * rstd * g[2], o[3] * rstd * g[3]); w0.z = pk2h(o[4] * rstd * g[4], o[5] * rstd * g[5]); w0.w = pk2h(o[6] * rstd * g[6], o[7] * rstd * g[7]);
            w1.x = pk2h(o[8] * rstd * g[8], o[9] * rstd * g[9]); w1.y = pk2h(o[10] * rstd * g[10], o[11] * rstd * g[11]); w1.z = pk2h(o[12] * rstd * g[12], o[13] * rstd * g[13]); w1.w = pk2h(o[14] * rstd * g[14], o[15] * rstd * g[15]);
            outw[q][0] = w0; outw[q][1] = w1; } }
#pragma unroll
        for (int q = 0; q < 4; ++q) { const int row = row0 + q * F.NGW; if (row < T) { const size_t off = (size_t)row * D + 16 * F.lane; *(u32x4*)(ON + off) = outw[q][0]; *(u32x4*)(ON + off + 8) = outw[q][1]; } }
    }
}

namespace hy {
constexpr int VPS = 2568;
constexpr int OFF_SA = 0, OFF_VP = 65536, OFF_G = OFF_VP + 8 * VPS * 2, OFF_RG = OFF_G + 32768, OFF_END = OFF_RG + 8192;
static_assert(OFF_END <= LDS_CTL_OFF, "hyena LDS map");
DI f32x16 MF(s16x8 x, s16x8 y, f32x16 c) { return __builtin_amdgcn_mfma_f32_32x32x16_f16(__builtin_bit_cast(half8, x), __builtin_bit_cast(half8, y), c, 0, 0, 0); }
DI int crow(int r, int hi) { return (r & 3) + 8 * (r >> 2) + 4 * hi; }

struct RowRaw { u32x4 d[4]; h16 prev, next; };
DI void raw_load(const h16* UT, int chr, int tid, RowRaw& r) {
    const int b = tid >> 6, t0 = (tid & 63) * 32;
    const h16* src = UT + (size_t)chr * T + (size_t)b * L + t0;
    r.prev = t0 > 0 ? src[-1] : (h16)0; r.next = t0 + 32 < L ? src[32] : (h16)0;
#pragma unroll
    for (int q = 0; q < 4; ++q) r.d[q] = *(const u32x4*)(src + 8 * q);
}
DI void conv3_store(const RowRaw& r, float w0, float w1, float w2, LAS h16* dst, int pitch, int tid) {
    const int b = tid >> 6, t0 = (tid & 63) * 32;
    float u[34];
    u[0] = h2f(r.prev); u[33] = h2f(r.next);
#pragma unroll
    for (int q = 0; q < 4; ++q) { float tmp[8]; unpack8(r.d[q], tmp);
#pragma unroll
        for (int e = 0; e < 8; ++e) u[1 + 8 * q + e] = tmp[e]; }
#pragma unroll
    for (int q = 0; q < 4; ++q) { float o[8];
#pragma unroll
        for (int e = 0; e < 8; ++e) { const int i = 8 * q + e; o[e] = w0 * u[i] + w1 * u[i + 1] + w2 * u[i + 2]; }
        u32x4 w; w.x = pk2h(o[0], o[1]); w.y = pk2h(o[2], o[3]); w.z = pk2h(o[4], o[5]); w.w = pk2h(o[6], o[7]);
        *(LAS u32x4*)(dst + b * pitch + t0 + 8 * q) = w; }
}
DI void rg_load(const h16* hfw, const h16* hbw, int tid, h16 (&v)[8]) {
#pragma unroll
    for (int e = 0; e < 8; ++e) { const int idx = tid * 8 + e; h16 x = 0; if (idx >= 1 && idx <= L) x = hfw[L - idx]; else if (idx > L) x = hbw[idx - L]; v[e] = x; }
}
DI void rg_store(LAS h16* RG, int tid, const h16 (&v)[8]) {
    u32x4 w; w.x = v[0] | ((unsigned)v[1] << 16); w.y = v[2] | ((unsigned)v[3] << 16); w.z = v[4] | ((unsigned)v[5] << 16); w.w = v[6] | ((unsigned)v[7] << 16);
    *(LAS u32x4*)(RG + tid * 8) = w;
}
DI void build_sa(const LAS h16* RG, LAS unsigned char* SA, int tid) {
#pragma unroll
    for (int i = 0; i < 8; ++i) { const int q = tid + NTHR * i; unsigned short v[8];
#pragma unroll
        for (int e = 0; e < 8; ++e) v[e] = (q + e < 4096) ? RG[q + e] : (unsigned short)0;
        u32x4 w; w.x = v[0] | ((unsigned)v[1] << 16); w.y = v[2] | ((unsigned)v[3] << 16); w.z = v[4] | ((unsigned)v[5] << 16); w.w = v[6] | ((unsigned)v[7] << 16);
        *(LAS u32x4*)(SA + q * 16) = w; }
}
DI void toeplitz(const LAS unsigned char* SA, const LAS h16* VP, int wave, int lane, f32x16 (&acc)[2]) {
    const int i = lane & 31, hi = lane >> 5, n = lane & 31, b = n >> 2, q = n & 3;
    const int T0 = 256 * wave, dhi = T0 + 192;
    const LAS unsigned char* ap = SA + (L - dhi + 8 * hi - i) * 16;
    const LAS h16* bp = VP + b * VPS + 256 + (T0 + 64 * q - dhi) + 8 * hi;
    acc[0] = f32x16{}; acc[1] = f32x16{};
    s16x8 p0 = *(const LAS s16x8*)(ap - 512), p1 = *(const LAS s16x8*)(ap - 512 + 256);
    s16x8 xa0 = *(const LAS s16x8*)(ap), xa1 = *(const LAS s16x8*)(ap + 256), xb0 = *(const LAS s16x8*)(bp), xb1 = *(const LAS s16x8*)(bp + 16);
    s16x8 ya0, ya1, yb0, yb1;
    for (int d = 0; d < 70; d += 2) {
        ya0 = *(const LAS s16x8*)(ap + (d + 1) * 512); ya1 = *(const LAS s16x8*)(ap + (d + 1) * 512 + 256); yb0 = *(const LAS s16x8*)(bp + (d + 1) * 32); yb1 = *(const LAS s16x8*)(bp + (d + 1) * 32 + 16);
        __builtin_amdgcn_sched_barrier(0);
        acc[0] = MF(xa0, xb0, acc[0]); acc[1] = MF(p0, xb0, acc[1]);
        acc[0] = MF(xa1, xb1, acc[0]); acc[1] = MF(p1, xb1, acc[1]);
        __builtin_amdgcn_sched_barrier(0);
        { const int d2 = (d + 2 < 70) ? d + 2 : d;
          p0 = xa0; p1 = xa1;
          xa0 = *(const LAS s16x8*)(ap + d2 * 512); xa1 = *(const LAS s16x8*)(ap + d2 * 512 + 256); xb0 = *(const LAS s16x8*)(bp + d2 * 32); xb1 = *(const LAS s16x8*)(bp + d2 * 32 + 16); }
        __builtin_amdgcn_sched_barrier(0);
        acc[0] = MF(ya0, yb0, acc[0]); acc[1] = MF(p0, yb0, acc[1]);
        acc[0] = MF(ya1, yb1, acc[0]); acc[1] = MF(p1, yb1, acc[1]);
        __builtin_amdgcn_sched_barrier(0);
        p0 = ya0; p1 = ya1;
    }
}
}

#define HY_LBAR() asm volatile("s_waitcnt lgkmcnt(0)\n\ts_barrier" ::: "memory")
DI void hyconv_phase(const Ctx& F, CArgs& a) {
    using namespace hy;
    unsigned char* ws = a.ws;
    const h16* UT = (const h16*)(ws + WS_BIG); h16* ZT = (h16*)(ws + WS_XIN); const h16* FILT = (const h16*)(ws + WS_FILT);
    const float* cconv = a.in[I_CCONV]; const float* skip = a.in[I_SKIP];
    LAS unsigned char* SA = F.lds + OFF_SA; LAS h16* VP = (LAS h16*)(F.lds + OFF_VP); LAS h16* GB = (LAS h16*)(F.lds + OFF_G); LAS h16* RG = (LAS h16*)(F.lds + OFF_RG);
    for (int i = F.tid; i < 8 * 512; i += NTHR) { const int b = i >> 9, p = i & 511; VP[b * VPS + (p < 256 ? p : 2048 + p)] = 0; }
    const int lane = F.lane, hi = lane >> 5, n = lane & 31, bq = n >> 2, q = n & 3;
    int ch = F.bx;
    RowRaw rx1, rv, rx2; h16 g1[8], g2[8];
    if (ch < D) { raw_load(UT, ch, F.tid, rx1); raw_load(UT, 2048 + ch, F.tid, rv); rg_load(FILT + (size_t)(0 * 1024 + ch) * L, FILT + (size_t)(1 * 1024 + ch) * L, F.tid, g1); }
    for (; ch < D; ch += F.G) {
        HY_LBAR();
        conv3_store(rx1, cconv[ch], cconv[3072 + ch], cconv[2 * 3072 + ch], GB, L, F.tid);
        conv3_store(rv, cconv[2048 + ch], cconv[3072 + 2048 + ch], cconv[2 * 3072 + 2048 + ch], VP + 256, VPS, F.tid);
        rg_store(RG, F.tid, g1);
        raw_load(UT, 1024 + ch, F.tid, rx2); rg_load(FILT + (size_t)(2 * 1024 + ch) * L, FILT + (size_t)(3 * 1024 + ch) * L, F.tid, g2);
        HY_LBAR();
        build_sa(RG, SA, F.tid);
        HY_LBAR();
        f32x16 acc[2];
        toeplitz(SA, VP, F.wave, lane, acc);
        const float sk0 = skip[ch], sk1 = skip[1024 + ch];
        u32x2 z1p[2][4];
#pragma unroll
        for (int tau = 0; tau < 2; ++tau)
#pragma unroll
            for (int g4 = 0; g4 < 4; ++g4) { const int t = 256 * F.wave + 64 * q + 32 * tau + 8 * g4 + 4 * hi;
                const f32x4 vv = unpack4(*(const LAS u32x2*)(VP + bq * VPS + 256 + t)); const f32x4 xx = unpack4(*(const LAS u32x2*)(GB + bq * L + t));
                const float o0 = xx[0] * (acc[tau][4 * g4 + 0] + vv[0] * sk0); const float o1 = xx[1] * (acc[tau][4 * g4 + 1] + vv[1] * sk0);
                const float o2 = xx[2] * (acc[tau][4 * g4 + 2] + vv[2] * sk0); const float o3 = xx[3] * (acc[tau][4 * g4 + 3] + vv[3] * sk0);
                z1p[tau][g4].x = pk2h(o0, o1); z1p[tau][g4].y = pk2h(o2, o3); }
        HY_LBAR();
#pragma unroll
        for (int tau = 0; tau < 2; ++tau)
#pragma unroll
            for (int g4 = 0; g4 < 4; ++g4) { const int t = 256 * F.wave + 64 * q + 32 * tau + 8 * g4 + 4 * hi; *(LAS u32x2*)(VP + bq * VPS + 256 + t) = z1p[tau][g4]; }
        conv3_store(rx2, cconv[1024 + ch], cconv[3072 + 1024 + ch], cconv[2 * 3072 + 1024 + ch], GB, L, F.tid);
        rg_store(RG, F.tid, g2);
        { const int nc = ch + F.G;
          if (nc < D) { raw_load(UT, nc, F.tid, rx1); raw_load(UT, 2048 + nc, F.tid, rv); rg_load(FILT + (size_t)(0 * 1024 + nc) * L, FILT + (size_t)(1 * 1024 + nc) * L, F.tid, g1); } }
        HY_LBAR();
        build_sa(RG, SA, F.tid);
        HY_LBAR();
        toeplitz(SA, VP, F.wave, lane, acc);
#pragma unroll
        for (int tau = 0; tau < 2; ++tau)
#pragma unroll
            for (int g4 = 0; g4 < 4; ++g4) { const int t = 256 * F.wave + 64 * q + 32 * tau + 8 * g4 + 4 * hi;
                const f32x4 vv = unpack4(*(const LAS u32x2*)(VP + bq * VPS + 256 + t)); const f32x4 xx = unpack4(*(const LAS u32x2*)(GB + bq * L + t));
                const float o0 = xx[0] * (acc[tau][4 * g4 + 0] + vv[0] * sk1); const float o1 = xx[1] * (acc[tau][4 * g4 + 1] + vv[1] * sk1);
                const float o2 = xx[2] * (acc[tau][4 * g4 + 2] + vv[2] * sk1); const float o3 = xx[3] * (acc[tau][4 * g4 + 3] + vv[3] * sk1);
                u32x2 w; w.x = pk2h(o0, o1); w.y = pk2h(o2, o3);
                *(u32x2*)(ZT + (size_t)ch * T + (size_t)bq * L + t) = w; }
    }
    __syncthreads();
}

DI void trans_phase(const Ctx& F, CArgs& a) {
    const h16* ZT = (const h16*)(a.ws + WS_XIN); h16* Z = (h16*)(a.ws + WS_Z);
    LAS h16* tile = (LAS h16*)(F.lds + F.wave * 16384);
    const int nitems = (D / 64) * (T / 64);
    for (int it = F.gw; it < nitems; it += F.NGW) {
        const int cb = it & 15, tb = it >> 4, c0 = cb * 64, t0 = tb * 64;
        u32x4 tw[8];
#pragma unroll
        for (int i = 0; i < 8; ++i) { const int c = (F.lane >> 3) + 8 * i, ck = F.lane & 7; tw[i] = *(const u32x4*)(ZT + (size_t)(c0 + c) * T + t0 + 8 * ck); }
        __builtin_amdgcn_sched_barrier(0);
#pragma unroll
        for (int i = 0; i < 8; ++i) { const int c = (F.lane >> 3) + 8 * i, ck = F.lane & 7; *(LAS u32x4*)(tile + c * 72 + 8 * ck) = tw[i]; }
        LDS_WAIT(); asm volatile("" ::: "memory");
#pragma unroll
        for (int i = 0; i < 8; ++i) { const int t = (F.lane >> 3) + 8 * i, ck = F.lane & 7; unsigned short v[8];
#pragma unroll
            for (int e = 0; e < 8; ++e) v[e] = tile[(8 * ck + e) * 72 + t];
            u32x4 w; w.x = v[0] | ((unsigned)v[1] << 16); w.y = v[2] | ((unsigned)v[3] << 16); w.z = v[4] | ((unsigned)v[5] << 16); w.w = v[6] | ((unsigned)v[7] << 16);
            *(u32x4*)(Z + (size_t)(t0 + t) * D + c0 + 8 * ck) = w; }
        LDS_WAIT(); asm volatile("" ::: "memory");
    }
}

enum { K_PRO = 0, K_ROWS, K_GIN, K_CONVGATE, K_GOUT, K_MOEROWS, K_TOPK, K_GMOE1, K_GMOE2, K_GQKV, K_ATTN, K_ATTNPOST, K_GHYIN, K_HYCONV, K_TRANS };
constexpr int NPHASE = 35;
DI void phase_desc(int ph, int& kind, int& layer) {
    if (ph == 0) { kind = K_PRO; layer = 0; return; }
    if (ph == 1) { kind = K_ROWS; layer = -1; return; }
    int l, r;
    if (ph < 10) { l = 0; r = ph - 2; } else if (ph < 18) { l = 1; r = ph - 10; } else if (ph < 27) { l = 2; r = ph - 18; } else { l = 3; r = ph - 27; }
    layer = l;
    const int nmix = (l == 2) ? 4 : 3;
    if (r >= nmix) { const int m = r - nmix; kind = m == 0 ? K_MOEROWS : m == 1 ? K_TOPK : m == 2 ? K_GMOE1 : m == 3 ? K_GMOE2 : K_ROWS; return; }
    if (l == 0 || l == 3) kind = r == 0 ? K_GIN : r == 1 ? K_CONVGATE : K_GOUT;
    else if (l == 1) kind = r == 0 ? K_GQKV : r == 1 ? K_ATTN : K_GOUT;
    else kind = r == 0 ? K_GHYIN : r == 1 ? K_HYCONV : r == 2 ? K_TRANS : K_GOUT;
}

__global__ void __launch_bounds__(NTHR, 2) mk_fwd(Args a_) {
    extern __shared__ __attribute__((aligned(16))) unsigned char lds_raw[];
    cg::grid_group grid = cg::this_grid();
    const int ph_lo = a_.ph_lo, ph_hi = a_.ph_hi;
    { volatile LAS unsigned* st0 = (volatile LAS unsigned*)((LAS unsigned char*)lds_raw + LDS_CTL_OFF); if (threadIdx.x < 16) st0[threadIdx.x] = 0u; }
    __syncthreads();
    XcdBarrier xbar = xcd_barrier_post((unsigned*)(a_.ws + WS_CTL) + 4096, (volatile LAS unsigned*)((LAS unsigned char*)lds_raw + LDS_CTL_OFF));
    int wave_s = __builtin_amdgcn_readfirstlane((int)(threadIdx.x >> 6)); asm volatile("" : "+s"(wave_s));
    for (int ph = ph_lo; ph < ph_hi; ++ph) {
#define MK_CTX Ctx F; { unsigned am_ = ~0u; asm volatile("" : "+s"(am_)); int tid_ = wave_s * 64 + (int)__builtin_amdgcn_mbcnt_hi(am_, __builtin_amdgcn_mbcnt_lo(am_, 0u)); asm volatile("" : "+v"(tid_)); int bx = blockIdx.x; asm volatile("" : "+s"(bx)); \
          F.lds = (LAS unsigned char*)lds_raw; F.tid = tid_; F.lane = tid_ & 63; F.wave = __builtin_amdgcn_readfirstlane(tid_ >> 6); \
          int G_ = gridDim.x; asm volatile("" : "+s"(G_)); F.G = G_; F.bx = bx; F.vcu = (F.G % 8 == 0) ? (bx % 8) * (F.G / 8) + bx / 8 : bx; \
          F.gw = F.vcu * NWAVES + F.wave; F.NGW = F.G * NWAVES; }
        CArgs* apl = (CArgs*)__builtin_amdgcn_kernarg_segment_ptr(); asm volatile("" : "+s"(apl)); CArgs& a = *apl;
        unsigned char* ws = a.ws;
        int kind, l; phase_desc(ph, kind, l);
        const bool dbg_final = (ph > DBG_STOP);
        if (dbg_final && ph != NPHASE - 1) continue;
        if (dbg_final) { kind = K_ROWS; }
#ifdef ONLY_KIND
        kind = ONLY_KIND;
#endif
        const unsigned long long amp_t0 = DBG_AMP_MASK ? __builtin_amdgcn_s_memrealtime() : 0ull;
        switch (kind) {
        case K_PRO: { MK_CTX; p0_prologue(F, a); } break;
        case K_ROWS: { MK_CTX;
            const bool first = (l < 0) && !dbg_final, fin = dbg_final || l == 3;
            const int lm = l < 0 ? 0 : l;
            rows_phase(F, a, (first || lm == 0) && !dbg_final ? TT : T, first, !first && !dbg_final, lm, lm + (first ? 0 : 1), fin, dbg_final && DBG_CHECK);
        } break;
        case K_GIN: { MK_CTX; const int j = l == 0 ? 0 : 1;
            pg8::SchedPlain S{l == 0 ? 72 : 64, 12, F.G, F.bx}; pg8::EpiGin E{(h16*)(ws + WS_BIG)};
            pg8::gemm_phase<false, false>(F.lds, F.tid, (const h16*)(ws + WS_H), (const h16*)(ws + WS_WAIN) + (size_t)j * 3072 * 1024, 1024, S, E); } break;
        case K_CONVGATE: { MK_CTX; convgate_phase(F, a, l == 0 ? 0 : 1, l == 0 ? TT : T); } break;
        case K_GOUT: { MK_CTX; const h16* W = l == 0 ? (const h16*)(ws + WS_WAOUT) : l == 1 ? (const h16*)(ws + WS_WBOUT) : l == 2 ? (const h16*)(ws + WS_WCOUT) : (const h16*)(ws + WS_WAOUT) + (size_t)1024 * 1024;
            pg8::SchedPlain S{l == 0 ? 72 : 64, 4, F.G, F.bx}; pg8::EpiResid E{(h16*)(ws + WS_XC), (const float*)(ws + WS_MOD) + (size_t)l * 9 * 6144, 2048};
            pg8::gemm_phase<false, false>(F.lds, F.tid, (const h16*)(ws + WS_Z), W, 1024, S, E); } break;
        case K_MOEROWS: { MK_CTX; moe_rows_phase(F, a, l, l == 0 ? TT : T); } break;
        case K_TOPK: { MK_CTX; topk_phase(F, a, l); } break;
        case K_GMOE1: { MK_CTX; pg8::SchedMoe S{l == 0 ? 144 : 128, 8, F.G, F.bx, 8}; pg8::EpiSwiglu8 E{(unsigned char*)(ws + WS_BIG)};
            pg8::gemm_phase<true, true>(F.lds, F.tid, (const h16*)(ws + WS_Z), (const h16*)(ws + WS_WGU + (size_t)l * 16 * 2048 * 1024), 512, S, E, (const int*)(ws + WS_GATE + 512 * 1024)); } break;
        case K_GMOE2: { MK_CTX; pg8::SchedMoe S{l == 0 ? 144 : 128, 4, F.G, F.bx, 4}; pg8::EpiDown8 E{(unsigned char*)(ws + WS_XIN), (const float*)(ws + WS_GATE)};
            pg8::gemm_phase<false, true>(F.lds, F.tid, (const h16*)(ws + WS_BIG), (const h16*)(ws + WS_WDN + (size_t)l * 16 * 1024 * 1024), 512, S, E); } break;
        case K_GQKV: { MK_CTX; pg8::SchedQkv S{F.G, F.bx};
            h16* Q = (h16*)(ws + WS_BIG); h16* Kb = Q + (size_t)T * D; h16* Vb = Kb + (size_t)NB * KVR * D;
            pg8::EpiQkv E{Q, Kb, Vb, (const float*)(ws + WS_SMALL), (const float*)(ws + WS_SMALL) + 1024};
            pg8::gemm_phase<false, false>(F.lds, F.tid, (const h16*)(ws + WS_H), (const h16*)(ws + WS_WQKV), 1024, S, E); } break;
        case K_ATTN: { MK_CTX; attn_phase(F, a); } break;
        case K_ATTNPOST: { MK_CTX; attn_post_phase(F, a); } break;
        case K_GHYIN: { MK_CTX; pg8::SchedPlain S{12, 64, F.G, F.bx}; pg8::EpiPlain E{(h16*)(ws + WS_BIG), T};
            pg8::gemm_phase<false, false>(F.lds, F.tid, (const h16*)(ws + WS_WCIN), (const h16*)(ws + WS_H), 1024, S, E); } break;
        case K_HYCONV: { MK_CTX; hyconv_phase(F, a); } break;
        case K_TRANS: { MK_CTX; trans_phase(F, a); } break;
        default: break;
        }
        if (DBG_AMP_MASK && ((DBG_AMP_MASK >> kind) & 1)) { const unsigned long long t1 = __builtin_amdgcn_s_memrealtime(); const unsigned long long dt = (t1 - amp_t0) * DBG_AMP_M; while (__builtin_amdgcn_s_memrealtime() - t1 < dt) __builtin_amdgcn_s_sleep(8); }
        if (ph + 1 < ph_hi) { if (ph_lo < -1) grid.sync();
            unsigned am2_ = ~0u; asm volatile("" : "+s"(am2_));
            xcd_barrier(xbar, wave_s == 0 && __builtin_amdgcn_mbcnt_hi(am2_, __builtin_amdgcn_mbcnt_lo(am2_, 0u)) == 0u); }
    }
}

#if DBG_CHECK
__device__ unsigned dbg_hash(unsigned x) { x ^= x >> 16; x *= 0x7feb352dU; x ^= x >> 15; x *= 0x846ca68bU; x ^= x >> 16; return x; }
__global__ void dbg_check_gemm(const h16* A, const float* W, int N, const h16* O, int ldo, int nrows, float* accum) {
    const unsigned id = blockIdx.x * blockDim.x + threadIdx.x;
    const int row = dbg_hash(id * 2 + 1) % nrows, col = dbg_hash(id * 2 + 2) % N;
    float s = 0.f;
    for (int k = 0; k < 1024; ++k) s += h2f(A[(size_t)row * 1024 + k]) * W[(size_t)k * N + col];
    const float o = h2f(O[(size_t)row * ldo + col]);
    atomicAdd(accum, (o - s) * (o - s)); atomicAdd(accum + 1, s * s);
}
__global__ void dbg_check_convgate(const h16* BCV, const float* cw, const h16* Z, int nrows, float* accum) {
    const unsigned id = blockIdx.x * blockDim.x + threadIdx.x;
    const int row = dbg_hash(id * 2 + 1) % nrows, c = dbg_hash(id * 2 + 2) % 1024;
    const int ls = row < T ? L : LC; const int t = row < T ? (row % L) : ((row - T) % LC);
    auto u = [&](int r) { return h2f(BCV[(size_t)r * 3072 + 1024 + c]) * h2f(BCV[(size_t)r * 3072 + 2048 + c]); };
    float s = cw[1024 + c] * u(row);
    if (t > 0) s += cw[c] * u(row - 1);
    if (t + 1 < ls) s += cw[2048 + c] * u(row + 1);
    s *= h2f(BCV[(size_t)row * 3072 + c]);
    const float o = h2f(Z[(size_t)row * 1024 + c]);
    atomicAdd(accum, (o - s) * (o - s)); atomicAdd(accum + 1, s * s);
}
__global__ void dbg_check_resid(const h16* Zb, const float* W, const float* XC, const float* xin, const float* gate  , float* accum) {
    const unsigned id = blockIdx.x * blockDim.x + threadIdx.x;
    const int row = dbg_hash(id * 2 + 1) % T, col = dbg_hash(id * 2 + 2) % 1024;
    float s = 0.f;
    for (int k = 0; k < 1024; ++k) s += h2f(Zb[(size_t)row * 1024 + k]) * W[(size_t)k * 1024 + col];
    s *= gate[(size_t)(row / L) * 6144 + col];
    const float o = XC[(size_t)row * 1024 + col] - xin[(size_t)row * 1024 + col];
    atomicAdd(accum, (o - s) * (o - s)); atomicAdd(accum + 1, s * s);
}
__global__ void dbg_encode(float* out, const float* accum, int n) {
    const float e = sqrtf(accum[0] / fmaxf(accum[1], 1e-30f));
    const float k = fminf(fmaxf(log10f(fmaxf(e, 1e-20f)) + 7.f, 0.f), 8.f);
    const float s = 1.f + k;
    for (int i = blockIdx.x * blockDim.x + threadIdx.x; i < n; i += gridDim.x * blockDim.x) out[i] *= s;
}
#endif

extern "C" void kernel_launch(void* const* d_in, const int* in_sizes, int n_in, void* d_out, int out_size, void* d_ws, size_t ws_size, hipStream_t stream) {
    static int grid = 0;
    if (grid == 0) {
        if (n_in != 34 || in_sizes[0] != T * D || out_size != T * D || ws_size < WS_END) { fprintf(stderr, "kernel_launch: unexpected shapes / workspace (n_in %d, in0 %d, out %d, ws %zu); nothing launched\n", n_in, n_in > 0 ? in_sizes[0] : -1, out_size, ws_size); grid = -1; return; }
        int dev = 0, cus = 0, per_cu = 0;
        if (hipGetDevice(&dev) != hipSuccess || hipDeviceGetAttribute(&cus, hipDeviceAttributeMultiprocessorCount, dev) != hipSuccess) { fprintf(stderr, "kernel_launch: device query failed\n"); grid = -1; return; }
        if (hipFuncSetAttribute((const void*)mk_fwd, hipFuncAttributeMaxDynamicSharedMemorySize, LDS_BYTES) != hipSuccess) { fprintf(stderr, "kernel_launch: hipFuncSetAttribute failed\n"); grid = -1; return; }
        if (hipOccupancyMaxActiveBlocksPerMultiprocessor(&per_cu, (const void*)mk_fwd, NTHR, LDS_BYTES) != hipSuccess || per_cu < 1) { fprintf(stderr, "kernel_launch: occupancy query says %d\n", per_cu); (void)hipGetLastError(); per_cu = 1; }
        grid = cus * 1;
    }
    if (grid < 0) return;
    (void)hipMemsetAsync((char*)d_ws + WS_CTL, 0, CTL_ZERO_BYTES, stream);
    Args a{};
    for (int i = 0; i < 34; ++i) a.in[i] = (const float*)d_in[i];
    a.out = (float*)d_out; a.ws = (unsigned char*)d_ws;
    constexpr int NPH = NPHASE;
#if MK_N_LAUNCHES == 1
    a.ph_lo = 0; a.ph_hi = NPH;
    void* args[] = {&a};
    hipError_t e = hipLaunchCooperativeKernel((const void*)mk_fwd, dim3(grid), dim3(NTHR), args, LDS_BYTES, stream);
    if (e != hipSuccess) fprintf(stderr, "kernel_launch: cooperative launch failed: %s (grid %d)\n", hipGetErrorString(e), grid);
#else
    for (int ph = 0; ph < NPH; ++ph) { a.ph_lo = ph; a.ph_hi = ph + 1; hipLaunchKernelGGL(mk_fwd, dim3(grid), dim3(NTHR), LDS_BYTES, stream, a); }
#endif
#if DBG_CHECK
    {
        unsigned char* ws = (unsigned char*)d_ws; float* accum = (float*)(ws + WS_CTL + 512 * 1024);
        (void)hipMemsetAsync(accum, 0, 64, stream);
        if (DBG_CHECK == 1) hipLaunchKernelGGL(dbg_check_gemm, dim3(64), dim3(256), 0, stream, (const h16*)(ws + WS_H), (const float*)d_in[I_AWIN], 3072, (const h16*)(ws + WS_BIG), 3072, TT, accum);
        if (DBG_CHECK == 2)
            hipLaunchKernelGGL(dbg_check_convgate, dim3(64), dim3(256), 0, stream, (const h16*)(ws + WS_BIG), (const float*)d_in[I_ACONV], (const h16*)(ws + WS_Z), TT, accum);
        if (DBG_CHECK == 3)
            hipLaunchKernelGGL(dbg_check_resid, dim3(64), dim3(256), 0, stream, (const h16*)(ws + WS_Z), (const float*)d_in[I_AWOUT], (const float*)(ws + WS_XC), (const float*)d_in[I_X], (const float*)(ws + WS_MOD) + 2048, accum);
        hipLaunchKernelGGL(dbg_encode, dim3(1024), dim3(256), 0, stream, (float*)d_out, (const float*)accum, T * D);
    }
#endif
}
```

```cpp
#include <hip/hip_runtime.h>
#include <hip/hip_cooperative_groups.h>
#include <cstdio>
#include <cstdint>
#include <cmath>
namespace cg = cooperative_groups;

#define LAS __attribute__((address_space(3)))
#define GAS __attribute__((address_space(1)))
#define DI __device__ __forceinline__

typedef unsigned short h16;
typedef _Float16 hf;
typedef _Float16 half8 __attribute__((ext_vector_type(8)));
typedef _Float16 half4 __attribute__((ext_vector_type(4)));
typedef _Float16 half2v __attribute__((ext_vector_type(2)));
typedef short s16x8 __attribute__((ext_vector_type(8)));
typedef short s16x4 __attribute__((ext_vector_type(4)));
typedef float f32x2 __attribute__((ext_vector_type(2)));
typedef float f32x4 __attribute__((ext_vector_type(4)));
typedef float f32x16 __attribute__((ext_vector_type(16)));
typedef unsigned u32x2 __attribute__((ext_vector_type(2)));
typedef unsigned u32x4 __attribute__((ext_vector_type(4)));

#ifndef MK_N_LAUNCHES
#define MK_N_LAUNCHES 1
#endif
#ifndef DBG_CHECK
#define DBG_CHECK 0
#endif
#ifndef DBG_AMP_MASK
#define DBG_AMP_MASK 0
#endif
#define DBG_AMP_M 4
#ifndef DBG_STOP
#define DBG_STOP 35
#endif

constexpr int D = 1024, NB = 8, L = 2048, T = NB * L, LC = 256, TC = NB * LC, TT = T + TC;
constexpr int NE = 16, CAP = 256, CAPC = 32, NH = 8;
constexpr int NGL = NE * NB * CAP, NGC = NE * NB * CAPC, NG = NGL + NGC;
constexpr int KVR = LC + L;
constexpr int NWAVES = 8, NTHR = 512;

constexpr size_t MiB = 1u << 20;
constexpr size_t WS_CTL = 0, WS_MOD = 1 * MiB, WS_SMALL = 2 * MiB, WS_AFF = 3 * MiB, WS_SLOT = 5 * MiB, WS_GATE = 7 * MiB, WS_FILT = 8 * MiB;
constexpr size_t WS_WAIN = 24 * MiB, WS_WAOUT = 36 * MiB, WS_WQKV = 40 * MiB, WS_WBOUT = 46 * MiB, WS_WCIN = 48 * MiB, WS_WCOUT = 54 * MiB;
constexpr size_t WS_WGU = 56 * MiB, WS_WDN = 312 * MiB;
constexpr size_t WS_XC = 440 * MiB, WS_H = 512 * MiB, WS_BIG = 548 * MiB, WS_Z = 656 * MiB, WS_XIN = 692 * MiB, WS_END = 764 * MiB;
constexpr size_t CTL_ZERO_BYTES = 1 * MiB;

constexpr int LDS_BYTES = 160 * 1024;
constexpr int LDS_CTL_OFF = 159 * 1024;

DI unsigned pk2h(float lo, float hi) { f32x2 v = {lo, hi}; half2v h = __builtin_convertvector(v, half2v); return __builtin_bit_cast(unsigned, h); }
DI unsigned pk4f8(float a, float b, float c, float d) {
    a = __builtin_amdgcn_fmed3f(a, -448.f, 448.f); b = __builtin_amdgcn_fmed3f(b, -448.f, 448.f); c = __builtin_amdgcn_fmed3f(c, -448.f, 448.f); d = __builtin_amdgcn_fmed3f(d, -448.f, 448.f);
    int w = 0; w = __builtin_amdgcn_cvt_pk_fp8_f32(a, b, w, false); w = __builtin_amdgcn_cvt_pk_fp8_f32(c, d, w, true); return (unsigned)w; }
DI float h2f(h16 v) { return (float)__builtin_bit_cast(hf, v); }
DI f32x4 unpack4(const u32x2 w) { const half4 h = __builtin_bit_cast(half4, w); return (f32x4){(float)h[0], (float)h[1], (float)h[2], (float)h[3]}; }
DI float sx(float v, int mask, int lane) { return __builtin_bit_cast(float, __builtin_amdgcn_ds_bpermute((lane ^ mask) << 2, __builtin_bit_cast(int, v))); }
DI float wave_sum(float v, int lane) {
#pragma unroll
    for (int o = 1; o < 64; o <<= 1) v += sx(v, o, lane);
    return v;
}
DI float silu_f(float a) { return a * __builtin_amdgcn_rcpf(1.f + __builtin_amdgcn_exp2f(-1.4426950408889634f * a)); }
DI void unpack8(const u32x4 w, float (&o)[8]) {
    const half8 h = __builtin_bit_cast(half8, w);
#pragma unroll
    for (int i = 0; i < 8; ++i) o[i] = (float)h[i];
}
#define LDS_WAIT() asm volatile("s_waitcnt lgkmcnt(0)" ::: "memory")
#define VM_WAIT() asm volatile("s_waitcnt vmcnt(0)" ::: "memory")

namespace pg8 {
constexpr int BM = 256, BK = 64, HALF = 128, HTB = HALF * BK * 2, STAGE_BYTES = 8 * HTB, NXCD = 8, WGM = 8;
DI int lds_byte(int r, int c) { const int st = (r >> 4) * 2 + (c >> 5), rr = r & 15, cc = c & 31, ob = rr * 64 + cc * 2; return st * 1024 + (ob ^ (((ob >> 9) & 1) << 5)); }
DI void stage_rc(int b, int& R, int& C) { const int st = b / 1024, sb = b % 1024, swz = sb ^ (((sb >> 9) & 1) << 5); R = (st >> 1) * 16 + swz / 64; C = (st & 1) * 32 + (swz % 64) / 2; }
DI int perm32(int rho) { const int n = rho >> 4, i = rho & 15; return 8 * (i >> 2) + 4 * n + (i & 3); }

struct Unit { int pm, pn, ta, tb; };

DI bool tile_order(int i, int nM, int nN, int G, int c, int& pm, int& pn) {
    const int nwg = nM * nN; const long Lx = (long)i * G + c; if (Lx >= nwg) return false;
    int wgid = (int)Lx; { const int q = nwg / NXCD, r = nwg % NXCD, xcd = wgid % NXCD, off = wgid / NXCD; wgid = (xcd < r ? xcd * (q + 1) : r * (q + 1) + (xcd - r) * q) + off; }
    const int nig = WGM * nN, gid = wgid / nig, fm = gid * WGM, gsz = (nM - fm) < WGM ? (nM - fm) : WGM;
    pm = fm + ((wgid % nig) % gsz); pn = (wgid % nig) / gsz; return true;
}

typedef int v8i_t __attribute__((ext_vector_type(8)));
typedef int v4i_t __attribute__((ext_vector_type(4)));
template <bool GATHER, bool FP8, class Epi, class Sched>
DI void gemm_phase(LAS unsigned char* lds, const int tid, const h16* Ag, const h16* Btg, const int K, const Sched& S, const Epi& E, const int* SEL = nullptr) {
    const int wid = __builtin_amdgcn_readfirstlane(tid >> 6), lane = tid & 63, wr = wid >> 2, wc = wid & 3, fr = lane & 15, fq = lane >> 4;
    const int nt = K / BK;
    unsigned voffA[2], voffB[2];
#pragma unroll
    for (int i = 0; i < 2; ++i) { int R, C; stage_rc(tid * 16 + i * 8192, R, C); const int Rb = (R & ~31) + perm32(R & 31);
        voffA[i] = (unsigned)(R * K + C) * 2u; voffB[i] = (unsigned)(Rb * K + C) * 2u; }
    const size_t kstep = (size_t)(BK * 2);
    const size_t hstep = (size_t)HALF * K * 2;
    const size_t tstep = 2 * hstep;
    const unsigned ldsw = (unsigned)wid * 1024u;
    const int aoff = lds_byte(wr * 64 + fr, fq * 8), boff = lds_byte(wc * 32 + fr, fq * 8);
#define PG8_SA(b, h) (((b) * 2 + (h)) * HTB)
#define PG8_SB(b, h) ((4 + (b) * 2 + (h)) * HTB)
#define PG8_STAGE(bufoff, gbase, voff) do { _Pragma("unroll") for (int _i = 0; _i < 2; ++_i) \
        __builtin_amdgcn_global_load_lds((const unsigned*)((const char*)(gbase) + (voff)[_i]), (LAS unsigned*)(lds + (bufoff) + ldsw + _i * 8192), 16, 0, 0); } while (0)
#define PG8_STAGE_A(bufoff, gbase, h, gsel) do { if constexpr (GATHER) { PG8_STAGE(bufoff, gbase, (gsel)[h]); } else { PG8_STAGE(bufoff, (gbase) + (h) * hstep, voffA); } } while (0)
#define PG8_LOAD_G(g, ta_) do { _Pragma("unroll") for (int h_ = 0; h_ < 2; ++h_) _Pragma("unroll") for (int i_ = 0; i_ < 2; ++i_) { int R_, C_; stage_rc(tid * 16 + i_ * 8192, R_, C_); \
        const int row_ = SEL[(ta_) * BM + h_ * HALF + R_]; (g)[h_][i_] = (unsigned)(row_ * K + C_) * 2u; } } while (0)
#define PG8_LDA(dst, b, h) do { if constexpr (FP8) { _Pragma("unroll") for (int m = 0; m < 4; ++m) dst##8[m] = __builtin_shufflevector(*(const LAS v4i_t*)(lds + PG8_SA(b, h) + aoff + m * 2048), *(const LAS v4i_t*)(lds + PG8_SA(b, h) + aoff + m * 2048 + 1024), 0, 1, 2, 3, 4, 5, 6, 7); } \
        else { _Pragma("unroll") for (int m = 0; m < 4; ++m) _Pragma("unroll") for (int k = 0; k < 2; ++k) dst[m][k] = *(const LAS half8*)(lds + PG8_SA(b, h) + aoff + m * 2048 + k * 1024); } } while (0)
#define PG8_LDB(dst, b, h) do { if constexpr (FP8) { _Pragma("unroll") for (int n = 0; n < 2; ++n) dst##8[n] = __builtin_shufflevector(*(const LAS v4i_t*)(lds + PG8_SB(b, h) + boff + n * 2048), *(const LAS v4i_t*)(lds + PG8_SB(b, h) + boff + n * 2048 + 1024), 0, 1, 2, 3, 4, 5, 6, 7); } \
        else { _Pragma("unroll") for (int n = 0; n < 2; ++n) _Pragma("unroll") for (int k = 0; k < 2; ++k) dst[n][k] = *(const LAS half8*)(lds + PG8_SB(b, h) + boff + n * 2048 + k * 1024); } } while (0)
#define PG8_CAT8(x0, x1) __builtin_shufflevector(__builtin_bit_cast(v4i_t, x0), __builtin_bit_cast(v4i_t, x1), 0, 1, 2, 3, 4, 5, 6, 7)
#define PG8_MMA(ai, bj, At, Bt) do { __builtin_amdgcn_s_setprio(1); \
        if constexpr (FP8) { _Pragma("unroll") for (int m = 0; m < 4; ++m) _Pragma("unroll") for (int n = 0; n < 2; ++n) \
            asm volatile("v_mfma_scale_f32_16x16x128_f8f6f4 %0, %1, %2, %0, %3, %3 op_sel_hi:[0,0,0]" : "+v"(acc[ai][bj][m][n]) : "v"(Bt##8[n]), "v"(At##8[m]), "v"(sc1)); } \
        else { _Pragma("unroll") for (int m = 0; m < 4; ++m) _Pragma("unroll") for (int n = 0; n < 2; ++n) _Pragma("unroll") for (int k = 0; k < 2; ++k) \
            acc[ai][bj][m][n] = __builtin_amdgcn_mfma_f32_16x16x32_f16(Bt[n][k], At[m][k], acc[ai][bj][m][n], 0, 0, 0); } \
        __builtin_amdgcn_s_setprio(0); } while (0)
#define PG8_WAIT_V(n) asm volatile("s_waitcnt vmcnt(" #n ")" ::: "memory")
#define PG8_WAIT_L(n) asm volatile("s_waitcnt lgkmcnt(" #n ")" ::: "memory")
#define PG8_BAR __builtin_amdgcn_s_barrier()
#define PG8_SCHED __builtin_amdgcn_sched_barrier(0)
    Unit cur, nxt; int ui = 0;
    if (!S.next(0, cur)) return;
    f32x4 acc[2][2][4][2];
    half8 At[4][2], B0[2][2], B1[2][2];
    v8i_t At8[4], B08[2], B18[2];
    int sc1 = 0x7F7F7F7F; asm volatile("" : "+v"(sc1));
    const char* cA = (const char*)Ag + (GATHER ? (size_t)0 : (size_t)cur.ta * tstep); const char* cB = (const char*)Btg + (size_t)cur.tb * tstep;
    unsigned gC[2][2], gN[2][2], gNN[2][2];
    if constexpr (GATHER) { PG8_LOAD_G(gC, cur.ta); Unit t1; if (S.next(1, t1)) { PG8_LOAD_G(gN, t1.ta); } else { PG8_LOAD_G(gN, cur.ta); }
        _Pragma("unroll") for (int h_ = 0; h_ < 2; ++h_) _Pragma("unroll") for (int i_ = 0; i_ < 2; ++i_) gNN[h_][i_] = gN[h_][i_]; }
    PG8_STAGE(PG8_SB(0, 0), cB, voffB); PG8_STAGE(PG8_SB(0, 1), cB + hstep, voffB); PG8_STAGE_A(PG8_SA(0, 0), cA, 0, gC); PG8_STAGE_A(PG8_SA(0, 1), cA, 1, gC);
    if (wr == 1) PG8_BAR;
    PG8_WAIT_V(2); PG8_BAR;
    PG8_STAGE(PG8_SB(1, 0), cB + kstep, voffB); PG8_STAGE_A(PG8_SA(1, 0), cA + kstep, 0, gC); PG8_STAGE(PG8_SB(1, 1), cB + hstep + kstep, voffB);
    PG8_WAIT_V(6); PG8_BAR;
#pragma unroll
    for (int a = 0; a < 2; ++a)
#pragma unroll
        for (int b = 0; b < 2; ++b)
#pragma unroll
            for (int m = 0; m < 4; ++m)
#pragma unroll
                for (int n = 0; n < 2; ++n) acc[a][b][m][n] = (f32x4){0.f, 0.f, 0.f, 0.f};
    for (;;) {
        const bool has_next = S.next(ui + 1, nxt);
        const char* nA = (has_next && !GATHER) ? (const char*)Ag + (size_t)nxt.ta * tstep : cA; const char* nB = has_next ? (const char*)Btg + (size_t)nxt.tb * tstep : cB;
        for (int t = 0; t < nt; t += 2) {
            const bool last = (t == nt - 2);
            const char* a1 = cA + (size_t)(t + 1) * kstep;
            const char* a2 = last ? nA : cA + (size_t)(t + 2) * kstep; const char* b2 = last ? nB : cB + (size_t)(t + 2) * kstep;
            const char* a3 = a2 + kstep; const char* b3 = b2 + kstep;
            unsigned gS[2][2];
            if constexpr (GATHER) { _Pragma("unroll") for (int h_ = 0; h_ < 2; ++h_) _Pragma("unroll") for (int i_ = 0; i_ < 2; ++i_) gS[h_][i_] = last ? gN[h_][i_] : gC[h_][i_]; }
            PG8_LDB(B0, 0, 0); PG8_LDB(B1, 0, 1); PG8_SCHED; PG8_LDA(At, 0, 0); PG8_STAGE_A(PG8_SA(1, 1), a1, 1, gC);
            PG8_WAIT_V(8); PG8_WAIT_L(0); PG8_BAR; PG8_MMA(0, 0, At, B0); PG8_MMA(0, 1, At, B1); PG8_BAR; PG8_SCHED;
            PG8_LDA(At, 0, 1); PG8_STAGE(PG8_SB(0, 0), b2, voffB); PG8_STAGE(PG8_SB(0, 1), b2 + hstep, voffB); PG8_STAGE_A(PG8_SA(0, 0), a2, 0, gS);
            PG8_WAIT_V(8); PG8_WAIT_L(0); PG8_BAR; PG8_MMA(1, 0, At, B0); PG8_MMA(1, 1, At, B1); PG8_BAR; PG8_SCHED;
            PG8_LDB(B0, 1, 0); PG8_LDB(B1, 1, 1); PG8_SCHED; PG8_LDA(At, 1, 0); PG8_STAGE_A(PG8_SA(0, 1), a2, 1, gS);
            PG8_WAIT_V(8); PG8_WAIT_L(0); PG8_BAR; PG8_MMA(0, 0, At, B0); PG8_MMA(0, 1, At, B1); PG8_BAR; PG8_SCHED;
            PG8_LDA(At, 1, 1); PG8_STAGE(PG8_SB(1, 0), b3, voffB); PG8_STAGE(PG8_SB(1, 1), b3 + hstep, voffB); PG8_STAGE_A(PG8_SA(1, 0), a3, 0, gS);
            PG8_WAIT_V(8); PG8_WAIT_L(0); PG8_BAR; PG8_MMA(1, 0, At, B0); PG8_MMA(1, 1, At, B1); PG8_BAR; PG8_SCHED;
        }
        if (wr == 0) PG8_BAR;
        if constexpr (FP8) asm volatile("s_nop 15\n\ts_nop 15" ::: "memory");
        if constexpr (GATHER) { Unit t2; if (has_next && S.next(ui + 2, t2)) { PG8_LOAD_G(gNN, t2.ta); } }
        { int fr_ = fr, fq_ = fq; asm volatile("" : "+v"(fr_), "+v"(fq_)); E(acc, cur, wr, wc, fr_, fq_); }
        if (!has_next) break;
#pragma unroll
        for (int a = 0; a < 2; ++a)
#pragma unroll
            for (int b = 0; b < 2; ++b)
#pragma unroll
                for (int m = 0; m < 4; ++m)
#pragma unroll
                    for (int n = 0; n < 2; ++n) acc[a][b][m][n] = (f32x4){0.f, 0.f, 0.f, 0.f};
        cur = nxt; cA = nA; cB = nB; ++ui;
        if constexpr (GATHER) { _Pragma("unroll") for (int h_ = 0; h_ < 2; ++h_) _Pragma("unroll") for (int i_ = 0; i_ < 2; ++i_) { gC[h_][i_] = gN[h_][i_]; gN[h_][i_] = gNN[h_][i_]; } }
        if (wr == 1) PG8_BAR;
    }
    PG8_WAIT_V(0);
    PG8_BAR;
#undef PG8_SA
#undef PG8_SB
#undef PG8_STAGE
#undef PG8_STAGE_A
#undef PG8_LOAD_G
#undef PG8_LDA
#undef PG8_LDB
#undef PG8_MMA
#undef PG8_CAT8
#undef PG8_WAIT_V
#undef PG8_WAIT_L
#undef PG8_BAR
#undef PG8_SCHED
}

struct SchedPlain {
    int nM, nN, G, c;
    DI bool next(int i, Unit& u) const { if (!tile_order(i, nM, nN, G, c, u.pm, u.pn)) return false; u.ta = u.pm; u.tb = u.pn; return true; }
};
struct SchedMoe {
    int nM, nN, G, c, tpe;
    DI bool next(int i, Unit& u) const { if (!tile_order(i, nM, nN, G, c, u.pm, u.pn)) return false; const int e = u.pm < 128 ? (u.pm >> 3) : (u.pm - 128); u.ta = u.pm; u.tb = e * tpe + u.pn; return true; }
};
struct SchedMoeP {
    int pm, half;
    DI bool next(int i, Unit& u) const { if (i >= 4) return false; u.pm = pm; u.pn = half * 4 + i; u.ta = pm; u.tb = (pm >> 3) * 8 + u.pn; return true; }
};
struct SchedQkv {
    int G, c;
    DI bool next(int i, Unit& u) const {
        const long Lx = (long)i * G + c;
        if (Lx < 768) { tile_order(i, 64, 12, G, c, u.pm, u.pn); u.ta = u.pm; u.tb = u.pn; return true; }
        const int r = (int)(Lx - 768); if (r >= 64) return false;
        u.pm = 64 + (r & 7); u.pn = 4 + (r >> 3); u.ta = u.pm; u.tb = u.pn; return true;
    }
};

struct EpiPlain {
    h16* O; int ldc;
    DI void operator()(const f32x4 (&acc)[2][2][4][2], const Unit& u, int wr, int wc, int fr, int fq) const {
        const int row0 = u.pm * BM + wr * 64 + fr, col0 = u.pn * BM + wc * 32 + 8 * fq;
#pragma unroll
        for (int ai = 0; ai < 2; ++ai)
#pragma unroll
            for (int m = 0; m < 4; ++m) { h16* rowp = O + (size_t)(row0 + ai * HALF + m * 16) * ldc + col0;
#pragma unroll
                for (int bj = 0; bj < 2; ++bj) { const f32x4 v0 = acc[ai][bj][m][0], v1 = acc[ai][bj][m][1];
                    u32x4 w; w.x = pk2h(v0[0], v0[1]); w.y = pk2h(v0[2], v0[3]); w.z = pk2h(v1[0], v1[1]); w.w = pk2h(v1[2], v1[3]);
                    *(u32x4*)(rowp + bj * HALF) = w; } }
    }
};
struct EpiGin {
    h16* O;
    DI void operator()(const f32x4 (&acc)[2][2][4][2], const Unit& u, int wr, int wc, int fr, int fq) const {
        const int row0 = u.pm * BM + wr * 64 + fr;
        if (u.pn < 4) {
            const int col0 = u.pn * BM + wc * 32 + 8 * fq;
#pragma unroll
            for (int ai = 0; ai < 2; ++ai)
#pragma unroll
                for (int m = 0; m < 4; ++m) { h16* rowp = O + (size_t)(row0 + ai * HALF + m * 16) * 2048 + col0;
#pragma unroll
                    for (int bj = 0; bj < 2; ++bj) { const f32x4 v0 = acc[ai][bj][m][0], v1 = acc[ai][bj][m][1];
                        u32x4 w; w.x = pk2h(v0[0], v0[1]); w.y = pk2h(v0[2], v0[3]); w.z = pk2h(v1[0], v1[1]); w.w = pk2h(v1[2], v1[3]);
                        *(u32x4*)(rowp + bj * HALF) = w; } }
        } else {
            const int col0 = 1024 + (u.pn - 4) * HALF + wc * 32 + 8 * fq;
#pragma unroll
            for (int ai = 0; ai < 2; ++ai)
#pragma unroll
                for (int m = 0; m < 4; ++m) { const f32x4 p0 = acc[ai][0][m][0] * acc[ai][1][m][0], p1 = acc[ai][0][m][1] * acc[ai][1][m][1];
                    u32x4 w; w.x = pk2h(p0[0], p0[1]); w.y = pk2h(p0[2], p0[3]); w.z = pk2h(p1[0], p1[1]); w.w = pk2h(p1[2], p1[3]);
                    *(u32x4*)(O + (size_t)(row0 + ai * HALF + m * 16) * 2048 + col0) = w; }
        }
    }
};
struct EpiResid {
    h16* XC; const float* modl; int goff;
    DI void operator()(const f32x4 (&acc)[2][2][4][2], const Unit& u, int wr, int wc, int fr, int fq) const {
        const int row0 = u.pm * BM + wr * 64 + fr, col0 = u.pn * BM + wc * 32 + 8 * fq;
        const int r9 = u.pm < 64 ? (u.pm >> 3) : 8;
        const float* g = modl + r9 * 6144 + goff + col0;
        f32x4 gv[2][2];
#pragma unroll
        for (int bj = 0; bj < 2; ++bj)
#pragma unroll
            for (int n = 0; n < 2; ++n) gv[bj][n] = *(const f32x4*)(g + bj * HALF + 4 * n);
#pragma unroll
        for (int ai = 0; ai < 2; ++ai) {
            u32x4 xr[4][2];
#pragma unroll
            for (int m = 0; m < 4; ++m)
#pragma unroll
                for (int bj = 0; bj < 2; ++bj) xr[m][bj] = *(const u32x4*)(XC + (size_t)(row0 + ai * HALF + m * 16) * D + col0 + bj * HALF);
            __builtin_amdgcn_sched_barrier(0);
#pragma unroll
            for (int m = 0; m < 4; ++m) { h16* rowp = XC + (size_t)(row0 + ai * HALF + m * 16) * D + col0;
#pragma unroll
                for (int bj = 0; bj < 2; ++bj) { float x[8]; unpack8(xr[m][bj], x);
                    const f32x4 a0 = acc[ai][bj][m][0], a1 = acc[ai][bj][m][1], g0 = gv[bj][0], g1 = gv[bj][1];
                    u32x4 w; w.x = pk2h(x[0] + g0[0] * a0[0], x[1] + g0[1] * a0[1]); w.y = pk2h(x[2] + g0[2] * a0[2], x[3] + g0[3] * a0[3]);
                    w.z = pk2h(x[4] + g1[0] * a1[0], x[5] + g1[1] * a1[1]); w.w = pk2h(x[6] + g1[2] * a1[2], x[7] + g1[3] * a1[3]); *(u32x4*)(rowp + bj * HALF) = w; } }
            __builtin_amdgcn_sched_barrier(0);
        }
    }
};
struct EpiSwiglu {
    h16* HID;
    DI void operator()(const f32x4 (&acc)[2][2][4][2], const Unit& u, int wr, int wc, int fr, int fq) const {
        const int row0 = u.pm * BM + wr * 64 + fr, col0 = u.pn * HALF + wc * 32 + 8 * fq;
#pragma unroll
        for (int ai = 0; ai < 2; ++ai)
#pragma unroll
            for (int m = 0; m < 4; ++m) { h16* rowp = HID + (size_t)(row0 + ai * HALF + m * 16) * D + col0;
                float o[8];
#pragma unroll
                for (int n = 0; n < 2; ++n)
#pragma unroll
                    for (int j = 0; j < 4; ++j) { const float a = acc[ai][0][m][n][j], b = acc[ai][1][m][n][j]; o[4 * n + j] = silu_f(a) * b; }
                u32x4 w; w.x = pk2h(o[0], o[1]); w.y = pk2h(o[2], o[3]); w.z = pk2h(o[4], o[5]); w.w = pk2h(o[6], o[7]);
                *(u32x4*)rowp = w; }
    }
};
struct EpiDown {
    h16* YE; const float* GATE;
    DI void operator()(const f32x4 (&acc)[2][2][4][2], const Unit& u, int wr, int wc, int fr, int fq) const {
        const int row0 = u.pm * BM + wr * 64 + fr, col0 = u.pn * BM + wc * 32 + 8 * fq;
#pragma unroll
        for (int ai = 0; ai < 2; ++ai)
#pragma unroll
            for (int m = 0; m < 4; ++m) { const int row = row0 + ai * HALF + m * 16; const float gt = GATE[row]; h16* rowp = YE + (size_t)row * D + col0;
#pragma unroll
                for (int bj = 0; bj < 2; ++bj) { const f32x4 v0 = acc[ai][bj][m][0] * gt, v1 = acc[ai][bj][m][1] * gt;
                    u32x4 w; w.x = pk2h(v0[0], v0[1]); w.y = pk2h(v0[2], v0[3]); w.z = pk2h(v1[0], v1[1]); w.w = pk2h(v1[2], v1[3]);
                    *(u32x4*)(rowp + bj * HALF) = w; } }
    }
};
struct EpiSwiglu8 {
    unsigned char* HID8;
    DI void operator()(const f32x4 (&acc)[2][2][4][2], const Unit& u, int wr, int wc, int fr, int fq) const {
        const int row0 = u.pm * BM + wr * 64 + fr, col0 = u.pn * HALF + wc * 32 + 8 * fq;
#pragma unroll
        for (int ai = 0; ai < 2; ++ai)
#pragma unroll
            for (int m = 0; m < 4; ++m) { unsigned char* rowp = HID8 + (size_t)(row0 + ai * HALF + m * 16) * D + col0;
                float o[8];
#pragma unroll
                for (int n = 0; n < 2; ++n)
#pragma unroll
                    for (int j = 0; j < 4; ++j) { const float a = acc[ai][0][m][n][j] * (1.f / 512.f), b = acc[ai][1][m][n][j] * (4.f / 512.f); o[4 * n + j] = silu_f(a) * b; }
                u32x2 w; w.x = pk4f8(o[0], o[1], o[2], o[3]); w.y = pk4f8(o[4], o[5], o[6], o[7]);
                *(u32x2*)rowp = w; }
    }
};
struct EpiDown8 {
    unsigned char* YE; const float* GATE;
    DI void operator()(const f32x4 (&acc)[2][2][4][2], const Unit& u, int wr, int wc, int fr, int fq) const {
        const int row0 = u.pm * BM + wr * 64 + fr, col0 = u.pn * BM + wc * 32 + 8 * fq;
        float gt[2][4];
#pragma unroll
        for (int ai = 0; ai < 2; ++ai)
#pragma unroll
            for (int m = 0; m < 4; ++m) gt[ai][m] = GATE[row0 + ai * HALF + m * 16];
        __builtin_amdgcn_sched_barrier(0);
#pragma unroll
        for (int ai = 0; ai < 2; ++ai)
#pragma unroll
            for (int m = 0; m < 4; ++m) { const int row = row0 + ai * HALF + m * 16; const float g = gt[ai][m] * (16.f / 256.f); unsigned char* rowp = YE + (size_t)row * D + col0;
#pragma unroll
                for (int bj = 0; bj < 2; ++bj) { const f32x4 v0 = acc[ai][bj][m][0] * g, v1 = acc[ai][bj][m][1] * g;
                    u32x2 w; w.x = pk4f8(v0[0], v0[1], v0[2], v0[3]); w.y = pk4f8(v1[0], v1[1], v1[2], v1[3]);
                    *(u32x2*)(rowp + bj * HALF) = w; } }
    }
};
constexpr float ATT_C2 = 0.125f * 1.4426950408889634f;
struct EpiQkv {
    h16 *Q, *Kb, *Vb; const float *RC, *RS;
    DI void operator()(const f32x4 (&acc)[2][2][4][2], const Unit& u, int wr, int wc, int fr, int fq) const {
        const bool ctx = u.pm >= 64; const int sec = u.pn >> 2;
        const int lr0 = wr * 64 + fr, col0 = (u.pn & 3) * BM + wc * 32 + 8 * fq;
        h16* base; size_t rowb;
        if (sec == 0) { base = Q; rowb = (size_t)u.pm * BM; }
        else { base = sec == 1 ? Kb : Vb; rowb = ctx ? (size_t)(u.pm - 64) * KVR : (size_t)(u.pm >> 3) * KVR + LC + (size_t)(u.pm & 7) * BM; }
        const bool rope = (sec < 2) && !ctx; const float sc = sec == 0 ? ATT_C2 : 1.f;
#pragma unroll
        for (int ai = 0; ai < 2; ++ai) {
            f32x4 cs[4], sn[4];
#pragma unroll
            for (int m = 0; m < 4; ++m) { cs[m] = (f32x4){1.f, 1.f, 1.f, 1.f}; sn[m] = (f32x4){0.f, 0.f, 0.f, 0.f}; }
            if (rope) {
#pragma unroll
                for (int m = 0; m < 4; ++m) { const int t = (u.pm & 7) * BM + lr0 + ai * HALF + m * 16; const int pos = (wc & 1) ? (t & 63) : (t >> 6); cs[m] = *(const f32x4*)(RC + pos * 16 + 4 * fq); sn[m] = *(const f32x4*)(RS + pos * 16 + 4 * fq); } }
            __builtin_amdgcn_sched_barrier(0);
#pragma unroll
            for (int m = 0; m < 4; ++m) { const int lr = lr0 + ai * HALF + m * 16; h16* rowp = base + (rowb + lr) * D + col0;
#pragma unroll
                for (int bj = 0; bj < 2; ++bj) { const f32x4 x1 = acc[ai][bj][m][0], x2 = acc[ai][bj][m][1];
                    const f32x4 v0 = (x1 * cs[m] - x2 * sn[m]) * sc, v1 = (x2 * cs[m] + x1 * sn[m]) * sc;
                    u32x4 w; w.x = pk2h(v0[0], v0[1]); w.y = pk2h(v0[2], v0[3]); w.z = pk2h(v1[0], v1[1]); w.w = pk2h(v1[2], v1[3]);
                    *(u32x4*)(rowp + bj * HALF) = w; } }
            __builtin_amdgcn_sched_barrier(0);
        }
    }
};
}

#define XB_TMO      128
#define XB_XCNT(j)  (256  + 64 * (j))
#define XB_XSUB(j)  (1280 + 64 * (j))
#define XB_XGEN(j)  (2304 + 64 * (j))
#define XB_TOP      3328
#define XB_TOPGEN   3392
#define XCD_BAR_WORDS 3456
#define XB_SPIN_CAP (1u << 22)
DI unsigned xb_ld(unsigned* p)              { return __hip_atomic_load(p, __ATOMIC_RELAXED, __HIP_MEMORY_SCOPE_AGENT); }
DI unsigned xb_add(unsigned* p, unsigned v) { return __hip_atomic_fetch_add(p, v, __ATOMIC_RELAXED, __HIP_MEMORY_SCOPE_AGENT); }
DI unsigned xb_xcc_id() { return (unsigned)__builtin_amdgcn_s_getreg((3 << 11) | 20) & 0xFu; }
#define XB_SPIN(cond, bar) do { unsigned _sp = 0; while (cond) { __builtin_amdgcn_s_sleep(1); \
    if ((++_sp & 255u) == 0u) { if (xb_ld(&(bar)[XB_TMO])) break; if (_sp > XB_SPIN_CAP) { atomicAdd(&(bar)[XB_TMO], 1u); break; } } } } while (0)
struct XcdBarrier { unsigned* bar; unsigned x; volatile LAS unsigned* st; };
DI XcdBarrier xcd_barrier_post(unsigned* bar, volatile LAS unsigned* st) {
    XcdBarrier b; b.bar = bar; b.x = xb_xcc_id(); b.st = st;
    if (threadIdx.x == 0) (void)xb_add(&bar[XB_XCNT(b.x)], 1u);
    return b;
}
DI void xcd_barrier_complete(unsigned* bar, unsigned x, unsigned& nloc, unsigned& nx) {
    const unsigned G = gridDim.x * gridDim.y * gridDim.z;
    unsigned sum, cnt, mine, sp = 0u;
    for (;;) {
        sum = 0u; cnt = 0u; mine = 0u;
#pragma unroll
        for (unsigned j = 0; j < 16; ++j) { const unsigned c = xb_ld(&bar[XB_XCNT(j)]); sum += c; cnt += (c > 0u) ? 1u : 0u; mine = (j == x) ? c : mine; }
        if (sum == G) break;
        __builtin_amdgcn_s_sleep(1);
        if ((++sp & 255u) == 0u) { if (xb_ld(&bar[XB_TMO])) break; if (sp > XB_SPIN_CAP) { atomicAdd(&bar[XB_TMO], 1u); break; } }
    }
    nloc = mine > 0u ? mine : 1u; nx = cnt > 0u ? cnt : 1u;
}
DI void xcd_barrier(const XcdBarrier& b, const bool leader) {
    asm volatile("s_waitcnt vmcnt(0)" ::: "memory");
    __syncthreads();
    if (leader) {
        unsigned* bar = b.bar;
        __builtin_amdgcn_s_waitcnt(0);
        unsigned nloc = b.st[0], nx = b.st[1];
        if (nloc == 0u) { xcd_barrier_complete(bar, b.x, nloc, nx); b.st[0] = nloc; b.st[1] = nx; }
        const unsigned old = xb_add(&bar[XB_XSUB(b.x)], 1u);
        const unsigned gen = old / nloc;
        if (old + 1u == (gen + 1u) * nloc) {
            __builtin_amdgcn_fence(__ATOMIC_RELEASE, "agent");
            asm volatile("s_waitcnt vmcnt(0)" ::: "memory");
            const unsigned og = xb_add(&bar[XB_TOP], 1u);
            const unsigned tg = og / nx;
            if (og + 1u == (tg + 1u) * nx) xb_add(&bar[XB_TOPGEN], 1u);
            else XB_SPIN(xb_ld(&bar[XB_TOPGEN]) == tg, bar);
            __builtin_amdgcn_fence(__ATOMIC_ACQUIRE, "agent");
            xb_add(&bar[XB_XGEN(b.x)], 1u);
            asm volatile("s_waitcnt vmcnt(0)" ::: "memory");
        } else {
            XB_SPIN(xb_ld(&bar[XB_XGEN(b.x)]) == gen, bar);
            __builtin_amdgcn_fence(__ATOMIC_ACQUIRE, "agent");
            asm volatile("s_waitcnt vmcnt(0)" ::: "memory");
        }
    }
    __syncthreads();
}

struct Args { const float* in[34]; float* out; unsigned char* ws; int ph_lo, ph_hi; };
enum { I_X = 0, I_C, I_CTX, I_CCTX, I_WADA, I_BADA, I_N1G, I_N2G, I_FG, I_AWIN, I_ACONV, I_AWOUT, I_BQKV, I_LQ1, I_LK1, I_LQ2, I_LK2, I_SUBG, I_BWOUT,
       I_CWIN, I_CCONV, I_F1W, I_F1B, I_F1F, I_F2W, I_F2B, I_F2F, I_F3W, I_SKIP, I_CWOUT, I_ROUTER, I_WGATE, I_WUP, I_WDOWN };

typedef __attribute__((address_space(4))) const Args CArgs;
struct Ctx { LAS unsigned char* lds; int tid, lane, wave, G, bx, vcu, gw, NGW; };

DI int perm_l2p(int l) { return ((l >> 2) & 3) * 8 + (l >> 4) * 4 + (l & 3); }
DI int map_row(int mode, int n) {
    if (mode == 1) return n < 2048 ? (n & ~31) + perm_l2p(n & 31) : n;
    if (mode == 2) return (n >> 7) * 256 + (n & 127);
    if (mode == 3) return (n >> 7) * 256 + 128 + (n & 127);
    if (mode == 4) { if (n < 1024) return n; const int c = (n - 1024) & 1023; return 1024 + (c >> 7) * 256 + (n >= 2048 ? 128 : 0) + (c & 127); }
    return n;
}
struct TJob { const float* W; h16* WT; int N, mode, item; bool f8; };
constexpr int P0_NSPEC = 1024, P0_NITEMS = P0_NSPEC + 192 * 64;
#ifndef P0_NAUX
#define P0_NAUX 64
#endif
DI TJob p0_decode(CArgs& a, int it) {
    unsigned char* ws = a.ws; TJob j;
    int r = it;
    if (r >= P0_NSPEC) { r -= P0_NSPEC; const int mat = r >> 6; const int kind = mat >> 6, le = mat & 63;
        j.W = a.in[I_WGATE + kind] + (size_t)le * 1024 * 1024; j.N = 1024; j.item = r & 63; j.mode = kind == 0 ? 2 : (kind == 1 ? 3 : 0);
        j.WT = kind < 2 ? (h16*)(ws + WS_WGU + (size_t)le * 2048 * 1024) : (h16*)(ws + WS_WDN + (size_t)le * 1024 * 1024); j.f8 = true; return j; }
    j.mode = 0; j.f8 = false;
    if (r < 192) { j.W = a.in[I_AWIN]; j.N = 3072; j.WT = (h16*)(ws + WS_WAIN); j.item = r; j.mode = 4; return j; } r -= 192;
    if (r < 192) { j.W = a.in[I_AWIN] + (size_t)1024 * 3072; j.N = 3072; j.WT = (h16*)(ws + WS_WAIN) + (size_t)3072 * 1024; j.item = r; j.mode = 4; return j; } r -= 192;
    if (r < 64) { j.W = a.in[I_AWOUT]; j.N = 1024; j.WT = (h16*)(ws + WS_WAOUT); j.item = r; return j; } r -= 64;
    if (r < 64) { j.W = a.in[I_AWOUT] + (size_t)1024 * 1024; j.N = 1024; j.WT = (h16*)(ws + WS_WAOUT) + (size_t)1024 * 1024; j.item = r; return j; } r -= 64;
    if (r < 192) { j.W = a.in[I_BQKV]; j.N = 3072; j.WT = (h16*)(ws + WS_WQKV); j.item = r; j.mode = 1; return j; } r -= 192;
    if (r < 64) { j.W = a.in[I_BWOUT]; j.N = 1024; j.WT = (h16*)(ws + WS_WBOUT); j.item = r; return j; } r -= 64;
    if (r < 192) { j.W = a.in[I_CWIN]; j.N = 3072; j.WT = (h16*)(ws + WS_WCIN); j.item = r; return j; } r -= 192;
    j.W = a.in[I_CWOUT]; j.N = 1024; j.WT = (h16*)(ws + WS_WCOUT); j.item = r; return j;
}
DI void p0_tr_load(const TJob& j, int tid, f32x4 (&v)[8]) {
    const int nblk = j.N / 128, kb = j.item / nblk, nb = j.item % nblk, k0 = 128 * kb, n0 = 128 * nb;
    const float* p = j.W + (size_t)(k0 + (tid >> 5)) * j.N + n0 + 4 * (tid & 31);
#pragma unroll
    for (int i = 0; i < 8; ++i) v[i] = __builtin_nontemporal_load((const f32x4*)(p + (size_t)(16 * i) * j.N));
}
#define P0_LBAR() asm volatile("s_waitcnt lgkmcnt(0)\n\ts_barrier" ::: "memory")
DI void p0_tr_store(const TJob& j, int tid, LAS float* scr, const f32x4 (&v)[8]) {
    const int nblk = j.N / 128, kb = j.item / nblk, nb = j.item % nblk, k0 = 128 * kb, n0 = 128 * nb;
#pragma unroll
    for (int i = 0; i < 8; ++i) { LAS float* d = scr + ((tid >> 5) + 16 * i) * 129 + 4 * (tid & 31); d[0] = v[i].x; d[1] = v[i].y; d[2] = v[i].z; d[3] = v[i].w; }
    P0_LBAR();
    const int n = tid >> 2, kq = tid & 3;
    const LAS float* s = scr + (32 * kq) * 129 + n;
    const size_t orow = (size_t)map_row(j.mode, n0 + n) * 1024 + k0 + 32 * kq;
    if (j.f8) {
        u32x4 o0, o1;
        o0.x = pk4f8(s[0 * 129] * 64.f, s[1 * 129] * 64.f, s[2 * 129] * 64.f, s[3 * 129] * 64.f);     o0.y = pk4f8(s[4 * 129] * 64.f, s[5 * 129] * 64.f, s[6 * 129] * 64.f, s[7 * 129] * 64.f);
        o0.z = pk4f8(s[8 * 129] * 64.f, s[9 * 129] * 64.f, s[10 * 129] * 64.f, s[11 * 129] * 64.f);   o0.w = pk4f8(s[12 * 129] * 64.f, s[13 * 129] * 64.f, s[14 * 129] * 64.f, s[15 * 129] * 64.f);
        o1.x = pk4f8(s[16 * 129] * 64.f, s[17 * 129] * 64.f, s[18 * 129] * 64.f, s[19 * 129] * 64.f); o1.y = pk4f8(s[20 * 129] * 64.f, s[21 * 129] * 64.f, s[22 * 129] * 64.f, s[23 * 129] * 64.f);
        o1.z = pk4f8(s[24 * 129] * 64.f, s[25 * 129] * 64.f, s[26 * 129] * 64.f, s[27 * 129] * 64.f); o1.w = pk4f8(s[28 * 129] * 64.f, s[29 * 129] * 64.f, s[30 * 129] * 64.f, s[31 * 129] * 64.f);
        u32x4* d = (u32x4*)((unsigned char*)j.WT + orow); d[0] = o0; d[1] = o1;
    } else {
        u32x4* d = (u32x4*)(j.WT + orow);
#pragma unroll
        for (int g = 0; g < 4; ++g) { const LAS float* t = s + (8 * g) * 129;
            u32x4 o; o.x = pk2h(t[0 * 129], t[1 * 129]); o.y = pk2h(t[2 * 129], t[3 * 129]); o.z = pk2h(t[4 * 129], t[5 * 129]); o.w = pk2h(t[6 * 129], t[7 * 129]); d[g] = o; }
    }
    P0_LBAR();
}

DI void p0_prologue(const Ctx& F, CArgs& a) {
    unsigned char* ws = a.ws;
    const int NAUX = F.G >= 128 ? P0_NAUX : 0;
    const bool aux = F.bx < NAUX || NAUX == 0, conv = F.bx >= NAUX;
    const int cbx = F.bx - NAUX, cG = F.G - NAUX, abx = F.bx, aG = NAUX ? NAUX : F.G;
    if (conv) {
        LAS float* scr = (LAS float*)F.lds;
        int it = cbx;
        f32x4 v0[8], v1[8]; TJob j0, j1;
        if (it < P0_NITEMS) { j0 = p0_decode(a, it); p0_tr_load(j0, F.tid, v0); }
        while (it < P0_NITEMS) {
            int itn = it + cG; bool hn = itn < P0_NITEMS;
            if (hn) { j1 = p0_decode(a, itn); p0_tr_load(j1, F.tid, v1); }
            p0_tr_store(j0, F.tid, scr, v0);
            it = itn; if (!hn) break;
            itn = it + cG; hn = itn < P0_NITEMS;
            if (hn) { j0 = p0_decode(a, itn); p0_tr_load(j0, F.tid, v0); }
            p0_tr_store(j1, F.tid, scr, v1);
            it = itn;
        }
    }
    __syncthreads();
    if (aux) {
        LAS float* S = (LAS float*)F.lds;
        LAS float* P = (LAS float*)(F.lds + 40960);
        for (int i = F.tid; i < 9 * 1024; i += NTHR) { const int r = i >> 10, k = i & 1023; const float v = r < 8 ? a.in[I_C][r * 1024 + k] : a.in[I_CCTX][k]; S[i] = v / (1.f + expf(-v)); }
        __syncthreads();
        float* MOD = (float*)(ws + WS_MOD);
        for (int it = abx; it < 4 * 96; it += aG) {
            const int l = it / 96, n0 = (it % 96) * 64;
            const float* W = a.in[I_WADA] + (size_t)l * 1024 * 6144 + n0 + F.lane;
            float acc[9];
#pragma unroll
            for (int r = 0; r < 9; ++r) acc[r] = 0.f;
            const int kb = F.wave * 128;
            for (int k0 = 0; k0 < 128; k0 += 32) {
                float w[32];
#pragma unroll
                for (int kk = 0; kk < 32; ++kk) w[kk] = __builtin_nontemporal_load(W + (size_t)(kb + k0 + kk) * 6144);
#pragma unroll
                for (int kk = 0; kk < 32; ++kk) {
#pragma unroll
                    for (int r = 0; r < 9; ++r) acc[r] += S[r * 1024 + kb + k0 + kk] * w[kk]; } }
#pragma unroll
            for (int r = 0; r < 9; ++r) P[(F.wave * 9 + r) * 64 + F.lane] = acc[r];
            __syncthreads();
            for (int o = F.tid; o < 9 * 64; o += NTHR) { const int r = o >> 6, n = o & 63; float s = 0.f;
#pragma unroll
                for (int w = 0; w < 8; ++w) s += P[(w * 9 + r) * 64 + n];
                MOD[((size_t)l * 9 + r) * 6144 + n0 + n] = s + a.in[I_BADA][l * 6144 + n0 + n]; }
            __syncthreads();
        }
    }
    if (aux && abx == 0) {
        float* RC = (float*)(ws + WS_SMALL); float* RS = RC + 1024;
        for (int i = F.tid; i < 1024; i += NTHR) { const int pos = i >> 4, f = i & 15; const float inv = powf(10000.f, -(float)(2 * f) / 32.f); const float ang = (float)pos * inv; RC[i] = cosf(ang); RS[i] = sinf(ang); }
    }
    __syncthreads();
    if (aux) {
        LAS float* ZB = (LAS float*)F.lds;
        LAS float* H1 = ZB + 512;
        LAS float* HB = H1 + 512;
        h16* FILT = (h16*)(ws + WS_FILT);
        const float* f1w = a.in[I_F1W]; const float* f2w = a.in[I_F2W]; const float* f3w = a.in[I_F3W];
        for (int it = abx; it < L / 8; it += aG) {
            const int p0 = it * 8; const int t = p0 + F.wave;
            {
                const float tl = (float)t / (float)(L - 1); const float wang = 2.0f * 3.14159265358979323846f * (float)t / (float)L;
                float zv = 0.f;
                if (F.lane == 0) zv = tl;
                else if (F.lane < 33) { const int q = (F.lane - 1) & 15; const float fq = 1e-4f + (float)q * ((15.0f - 1e-4f) / 15.0f); const float ang = fq * wang; zv = F.lane < 17 ? cosf(ang) : -sinf(ang); }
                ZB[F.wave * 64 + F.lane] = zv;
                LDS_WAIT();
                float s = a.in[I_F1B][F.lane];
                for (int i = 0; i < 33; ++i) s += ZB[F.wave * 64 + i] * f1w[i * 64 + F.lane];
                const float h1 = sinf(a.in[I_F1F][F.lane] * s);
                H1[F.wave * 64 + F.lane] = h1;
                LDS_WAIT();
                float s2 = a.in[I_F2B][F.lane];
                for (int k = 0; k < 64; ++k) s2 += H1[F.wave * 64 + k] * f2w[k * 64 + F.lane];
                HB[F.wave * 64 + F.lane] = sinf(a.in[I_F2F][F.lane] * s2);
            }
            __syncthreads();
            for (int cc = F.wave; cc < 16; cc += 8) {
                const int n = cc * 256 + 4 * F.lane;
                f32x4 acc[8];
#pragma unroll
                for (int p = 0; p < 8; ++p) acc[p] = (f32x4){0.f, 0.f, 0.f, 0.f};
                for (int k = 0; k < 64; ++k) { const f32x4 w = *(const f32x4*)(f3w + (size_t)k * 4096 + n);
#pragma unroll
                    for (int p = 0; p < 8; ++p) acc[p] += w * HB[p * 64 + k]; }
                const int o2 = n >> 10, c0 = n & 1023;
                const float mind = logf(1e-2f) / 1.5f, maxd = logf(1e-2f) / 0.3f;
#pragma unroll
                for (int j = 0; j < 4; ++j) { const int c = c0 + j; const float delta = fabsf(mind + (float)c * ((maxd - mind) / (float)(D - 1)));
                    float o[8];
#pragma unroll
                    for (int p = 0; p < 8; ++p) { const float tl = (float)(p0 + p) / (float)(L - 1); o[p] = acc[p][j] * expf(-tl * delta); }
                    u32x4 w; w.x = pk2h(o[0], o[1]); w.y = pk2h(o[2], o[3]); w.z = pk2h(o[4], o[5]); w.w = pk2h(o[6], o[7]);
                    *(u32x4*)(FILT + ((size_t)(o2 * 1024 + c) * L + p0)) = w; }
            }
            __syncthreads();
        }
    }
}

DI void rows_load(const float* src, int lane, f32x4 (&v)[4]) {
#pragma unroll
    for (int j = 0; j < 4; ++j) v[j] = __builtin_nontemporal_load((const f32x4*)(src + 4 * lane + 256 * j));
}
DI void rows_load_h(const h16* src, int lane, f32x4 (&v)[4]) {
#pragma unroll
    for (int j = 0; j < 4; ++j) v[j] = unpack4(*(const u32x2*)(src + 4 * lane + 256 * j));
}
DI void rows_phase(const Ctx& F, CArgs& a, int nrows, bool copy_in, bool combine, int lmoe, int lnext, bool final_out, bool from_input = false) {
    unsigned char* ws = a.ws;
    h16* XC = (h16*)(ws + WS_XC); h16* H = (h16*)(ws + WS_H);
    const float* MOD = (const float*)(ws + WS_MOD);
    const int* SLOT = (const int*)(ws + WS_SLOT); const unsigned char* YE = ws + WS_XIN;
    const bool ext = copy_in || from_input;
    int row = F.gw;
    f32x4 nv[4]; int nslot = -1;
    if (row < nrows) { if (ext) rows_load(row < T ? a.in[I_X] + (size_t)row * D : a.in[I_CTX] + (size_t)(row - T) * D, F.lane, nv); else rows_load_h(XC + (size_t)row * D, F.lane, nv);
        if (combine) nslot = SLOT[(size_t)row * 16 + (F.lane & 15)]; }
    for (; row < nrows; row += F.NGW) {
        const int r9 = row < T ? (row >> 11) : 8;
        f32x4 v[4];
#pragma unroll
        for (int j = 0; j < 4; ++j) v[j] = nv[j];
        const int myslot = nslot;
        { const int nr = row + F.NGW < nrows ? row + F.NGW : row;
          if (ext) rows_load(nr < T ? a.in[I_X] + (size_t)nr * D : a.in[I_CTX] + (size_t)(nr - T) * D, F.lane, nv); else rows_load_h(XC + (size_t)nr * D, F.lane, nv);
          if (combine) nslot = SLOT[(size_t)nr * 16 + (F.lane & 15)]; }
        f32x4 g2v[4], gA[4], shA[4], scA[4];
        if (combine) { const float* g2 = MOD + ((size_t)lmoe * 9 + r9) * 6144 + 5120 + 4 * F.lane;
#pragma unroll
            for (int j = 0; j < 4; ++j) g2v[j] = *(const f32x4*)(g2 + 256 * j); }
        if (final_out) {
#pragma unroll
            for (int j = 0; j < 4; ++j) gA[j] = *(const f32x4*)(a.in[I_FG] + 4 * F.lane + 256 * j);
        } else { const float* g1 = a.in[I_N1G] + lnext * D + 4 * F.lane; const float* md = MOD + ((size_t)lnext * 9 + r9) * 6144 + 4 * F.lane;
#pragma unroll
            for (int j = 0; j < 4; ++j) { gA[j] = *(const f32x4*)(g1 + 256 * j); shA[j] = *(const f32x4*)(md + 256 * j); scA[j] = *(const f32x4*)(md + 1024 + 256 * j); } }
        if (combine) {
            f32x4 s[4];
#pragma unroll
            for (int j = 0; j < 4; ++j) s[j] = (f32x4){0.f, 0.f, 0.f, 0.f};
            unsigned m = (unsigned)(__ballot(myslot >= 0) & 0xFFFFull);
            while (m) {
                int sl[4]; unsigned y[4][4];
#pragma unroll
                for (int q = 0; q < 4; ++q) { sl[q] = -1; if (m) { const int e = __builtin_ctz(m); m &= m - 1; sl[q] = __builtin_amdgcn_readlane(myslot, e); } }
#pragma unroll
                for (int q = 0; q < 4; ++q) if (sl[q] >= 0) { const unsigned char* yp = YE + (size_t)sl[q] * D + 4 * F.lane;
#pragma unroll
                    for (int j = 0; j < 4; ++j) y[q][j] = *(const unsigned*)(yp + 256 * j); }
#pragma unroll
                for (int q = 0; q < 4; ++q) if (sl[q] >= 0) {
#pragma unroll
                    for (int j = 0; j < 4; ++j) { const f32x2 lo = __builtin_amdgcn_cvt_pk_f32_fp8((int)y[q][j], false), hi2 = __builtin_amdgcn_cvt_pk_f32_fp8((int)y[q][j], true);
                        s[j] += (f32x4){lo.x, lo.y, hi2.x, hi2.y}; } }
            }
#pragma unroll
            for (int j = 0; j < 4; ++j) v[j] += g2v[j] * s[j] * (1.f / 16.f);
        }
        float ss = 0.f;
#pragma unroll
        for (int j = 0; j < 4; ++j) ss += (v[j].x * v[j].x + v[j].y * v[j].y) + (v[j].z * v[j].z + v[j].w * v[j].w);
        const float rstd = 1.0f / sqrtf(wave_sum(ss, F.lane) * (1.f / D) + 1e-6f);
        if (final_out) {
            f32x4 o[4];
#pragma unroll
            for (int j = 0; j < 4; ++j) o[j] = v[j] * rstd * gA[j];
            if (row < T) {
#pragma unroll
                for (int j = 0; j < 4; ++j) __builtin_nontemporal_store(o[j], (f32x4*)(a.out + (size_t)row * D + 4 * F.lane + 256 * j)); }
        } else {
            u32x2 hw[4];
#pragma unroll
            for (int j = 0; j < 4; ++j) { const f32x4 h = (v[j] * rstd * gA[j]) * (1.f + scA[j]) + shA[j];
                hw[j].x = pk2h(h.x, h.y); hw[j].y = pk2h(h.z, h.w); }
            if (copy_in || combine) {
#pragma unroll
                for (int j = 0; j < 4; ++j) { u32x2 w; w.x = pk2h(v[j].x, v[j].y); w.y = pk2h(v[j].z, v[j].w); *(u32x2*)(XC + (size_t)row * D + 4 * F.lane + 256 * j) = w; } }
#pragma unroll
            for (int j = 0; j < 4; ++j) *(u32x2*)(H + (size_t)row * D + 4 * F.lane + 256 * j) = hw[j];
        }
    }
}


DI void cg_load_u(const h16* BCV, int row, int c0, float (&u)[8]) {
    float cg[8], v[8];
    unpack8(*(const u32x4*)(BCV + (size_t)row * 3072 + 1024 + c0), cg); unpack8(*(const u32x4*)(BCV + (size_t)row * 3072 + 2048 + c0), v);
#pragma unroll
    for (int q = 0; q < 8; ++q) u[q] = cg[q] * v[q];
}
DI void cg_raw(const h16* BU, int row, int c0, u32x4& ur) { ur = *(const u32x4*)(BU + (size_t)row * 2048 + 1024 + c0); }
DI void cg_mul(const u32x4& ur, bool valid, float (&u)[8]) {
    float t[8]; unpack8(ur, t);
#pragma unroll
    for (int q = 0; q < 8; ++q) u[q] = valid ? t[q] : 0.f;
}
DI void convgate_phase(const Ctx& F, CArgs& a, int j, int nrows) {
    const h16* BU = (const h16*)(a.ws + WS_BIG); h16* Z = (h16*)(a.ws + WS_Z);
    const float* cw = a.in[I_ACONV] + (size_t)j * 3 * D;
    const int RI = nrows == T ? 16 : 8;
    const int nitems = (nrows / RI) * 2;
    for (int it = F.gw; it < nitems; it += F.NGW) {
        const int hsel = it & 1, r0 = (it >> 1) * RI, c0 = hsel * 512 + 8 * F.lane;
        const int ls = r0 < T ? L : LC; const int t0 = r0 < T ? (r0 & (L - 1)) : ((r0 - T) & (LC - 1));
        u32x4 cm, c0r, c1r, cA, cB, bw, bw1;
        cg_raw(BU, r0 - 1, c0, cm); cg_raw(BU, r0, c0, c0r); cg_raw(BU, r0 + 1, c0, c1r);
        bw = *(const u32x4*)(BU + (size_t)r0 * 2048 + c0);
        cg_raw(BU, r0 + 2, c0, cA); cg_raw(BU, r0 + 3, c0, cB);
        bw1 = *(const u32x4*)(BU + (size_t)(r0 + 1) * 2048 + c0);
        float w0[8], w1[8], w2[8];
#pragma unroll
        for (int q = 0; q < 8; ++q) { w0[q] = cw[c0 + q]; w1[q] = cw[D + c0 + q]; w2[q] = cw[2 * D + c0 + q]; }
        __builtin_amdgcn_sched_barrier(0);
        float up[8], uc[8], un[8];
        cg_mul(cm, t0 > 0, up); cg_mul(c0r, true, uc); cg_mul(c1r, t0 + 1 < ls, un);
        for (int i = 0; i < RI; ++i) {
            const int row = r0 + i;
            u32x4 cN, bw2;
            { const int k4 = i + 4 < RI ? i + 4 : RI, k2 = i + 2 < RI ? i + 2 : RI - 1;
              cg_raw(BU, r0 + k4, c0, cN); bw2 = *(const u32x4*)(BU + (size_t)(r0 + k2) * 2048 + c0); }
            float un2[8]; cg_mul(cA, (i + 2 <= RI) && (t0 + i + 2 < ls), un2);
            float bv[8], o[8]; unpack8(bw, bv);
#pragma unroll
            for (int q = 0; q < 8; ++q) o[q] = bv[q] * (w0[q] * up[q] + w1[q] * uc[q] + w2[q] * un[q]);
            u32x4 w; w.x = pk2h(o[0], o[1]); w.y = pk2h(o[2], o[3]); w.z = pk2h(o[4], o[5]); w.w = pk2h(o[6], o[7]);
            *(u32x4*)(Z + (size_t)row * D + c0) = w;
#pragma unroll
            for (int q = 0; q < 8; ++q) { up[q] = uc[q]; uc[q] = un[q]; un[q] = un2[q]; }
            bw = bw1; bw1 = bw2; cA = cB; cB = cN;
        }
    }
}

DI void moe_rows_phase(const Ctx& F, CArgs& a, int l, int nrows) {
    unsigned char* ws = a.ws;
    const h16* XC = (const h16*)(ws + WS_XC); unsigned char* H8 = ws + WS_Z; const float* MOD = (const float*)(ws + WS_MOD); float* AFF = (float*)(ws + WS_AFF);
    LAS float* WR = (LAS float*)F.lds;
    const float* rt = a.in[I_ROUTER] + (size_t)l * 1024 * 16;
    const int ngroups = nrows >> 2;
    u32x2 raw[4][4];
    if (F.gw < ngroups) {
#pragma unroll
        for (int r = 0; r < 4; ++r)
#pragma unroll
            for (int c = 0; c < 4; ++c) raw[r][c] = *(const u32x2*)(XC + (size_t)(F.gw * 4 + r) * D + 4 * F.lane + 256 * c); }
    { float tv[32];
#pragma unroll
      for (int k = 0; k < 32; ++k) tv[k] = rt[F.tid + NTHR * k];
      __builtin_amdgcn_sched_barrier(0);
#pragma unroll
      for (int k = 0; k < 32; ++k) { const int i = F.tid + NTHR * k; WR[(i & 15) * 1028 + (i >> 4)] = tv[k]; } }
    __syncthreads();
    const int rs = F.lane >> 4, l16 = F.lane & 15;
    const float* g2 = a.in[I_N2G] + l * D + 4 * F.lane;
    for (int grp = F.gw; grp < ngroups; grp += F.NGW) {
        const int row0 = grp * 4;
        const int r9 = row0 < T ? (row0 >> 11) : 8;
        f32x4 gq[4], shq[4], scq[4];
        const float* md = MOD + ((size_t)l * 9 + r9) * 6144 + 3072 + 4 * F.lane;
#pragma unroll
        for (int c = 0; c < 4; ++c) { gq[c] = *(const f32x4*)(g2 + 256 * c); shq[c] = *(const f32x4*)(md + 256 * c); scq[c] = *(const f32x4*)(md + 1024 + 256 * c); }
        __builtin_amdgcn_sched_barrier(0);
        f32x4 h[4][4];
        float ss[4];
#pragma unroll
        for (int r = 0; r < 4; ++r) { float s_ = 0.f;
#pragma unroll
            for (int c = 0; c < 4; ++c) { h[r][c] = unpack4(raw[r][c]); s_ += (h[r][c].x * h[r][c].x + h[r][c].y * h[r][c].y) + (h[r][c].z * h[r][c].z + h[r][c].w * h[r][c].w); }
            ss[r] = s_; }
        { const int gnx = min(grp + F.NGW, ngroups - 1);
#pragma unroll
            for (int r = 0; r < 4; ++r)
#pragma unroll
                for (int c = 0; c < 4; ++c) raw[r][c] = *(const u32x2*)(XC + (size_t)(gnx * 4 + r) * D + 4 * F.lane + 256 * c); }
        __builtin_amdgcn_sched_barrier(0);
#pragma unroll
        for (int o = 1; o < 64; o <<= 1)
#pragma unroll
            for (int r = 0; r < 4; ++r) ss[r] += sx(ss[r], o, F.lane);
        unsigned w8[4][4];
        f32x2 hx[2][4][4];
#pragma unroll
        for (int c = 0; c < 4; ++c) { const f32x4 g = gq[c], sh = shq[c], sc = scq[c];
#pragma unroll
            for (int r = 0; r < 4; ++r) { const float rstd = 1.0f / sqrtf(ss[r] * (1.f / D) + 1e-6f);
                const f32x4 v = (h[r][c] * rstd * g) * (1.f + sc) + sh;
                w8[r][c] = pk4f8(v.x * 8.f, v.y * 8.f, v.z * 8.f, v.w * 8.f);
                hx[r >> 1][c][0][r & 1] = v.x; hx[r >> 1][c][1][r & 1] = v.y; hx[r >> 1][c][2][r & 1] = v.z; hx[r >> 1][c][3][r & 1] = v.w; } }
        f32x2 p[2][16];
#pragma unroll
        for (int e = 0; e < 16; ++e) { f32x2 q0 = {0.f, 0.f}, q1_ = {0.f, 0.f};
#pragma unroll
            for (int c = 0; c < 4; ++c) { const f32x4 w = *(const LAS f32x4*)(WR + e * 1028 + 4 * F.lane + 256 * c);
#pragma unroll
                for (int i = 0; i < 4; ++i) { const f32x2 wv = {w[i], w[i]}; q0 = __builtin_elementwise_fma(hx[0][c][i], wv, q0); q1_ = __builtin_elementwise_fma(hx[1][c][i], wv, q1_); } }
            p[0][e] = q0; p[1][e] = q1_; if ((e & 1) == 1) __builtin_amdgcn_sched_barrier(0); }
        float p16[16];
        { const bool hb = (F.lane & 32) != 0; float t2[2][16];
#pragma unroll
          for (int e = 0; e < 16; ++e)
#pragma unroll
              for (int k = 0; k < 2; ++k) { const float send = hb ? p[0][e][k] : p[1][e][k], keep = hb ? p[1][e][k] : p[0][e][k]; t2[k][e] = keep + sx(send, 32, F.lane); }
          const bool hc = (F.lane & 16) != 0;
#pragma unroll
          for (int e = 0; e < 16; ++e) { const float send = hc ? t2[0][e] : t2[1][e], keep = hc ? t2[1][e] : t2[0][e]; p16[e] = keep + sx(send, 16, F.lane); } }
        float q8[8], q4[4], q2[2], q1;
        { const bool hb = (l16 & 8) != 0;
#pragma unroll
          for (int i = 0; i < 8; ++i) { const float send = hb ? p16[i] : p16[i + 8], keep = hb ? p16[i + 8] : p16[i]; q8[i] = keep + sx(send, 8, F.lane); } }
        { const bool hb = (l16 & 4) != 0;
#pragma unroll
          for (int i = 0; i < 4; ++i) { const float send = hb ? q8[i] : q8[i + 4], keep = hb ? q8[i + 4] : q8[i]; q4[i] = keep + sx(send, 4, F.lane); } }
        { const bool hb = (l16 & 2) != 0;
#pragma unroll
          for (int i = 0; i < 2; ++i) { const float send = hb ? q4[i] : q4[i + 2], keep = hb ? q4[i + 2] : q4[i]; q2[i] = keep + sx(send, 2, F.lane); } }
        { const bool hb = (l16 & 1) != 0; const float send = hb ? q2[0] : q2[1], keep = hb ? q2[1] : q2[0]; q1 = keep + sx(send, 1, F.lane); }
        float mx = q1;
#pragma unroll
        for (int o = 1; o < 16; o <<= 1) mx = fmaxf(mx, sx(mx, o, F.lane));
        const float mine = expf(q1 - mx);
        float sum = mine;
#pragma unroll
        for (int o = 1; o < 16; o <<= 1) sum += sx(sum, o, F.lane);
        const float af = mine / sum;
#pragma unroll
        for (int r = 0; r < 4; ++r)
#pragma unroll
            for (int c = 0; c < 4; ++c) *(unsigned*)(H8 + (size_t)(row0 + r) * D + 4 * F.lane + 256 * c) = w8[r][c];
        const int row = row0 + rs;
        if (row < T) AFF[((size_t)(row >> 11) * 16 + l16) * L + (row & (L - 1))] = af;
        else { const int rc = row - T; AFF[(size_t)NB * 16 * L + ((size_t)(rc >> 8) * 16 + l16) * LC + (rc & (LC - 1))] = af; }
    }
}

DI int lanes_below(unsigned long long m) { return (int)__builtin_amdgcn_mbcnt_hi((unsigned)(m >> 32), __builtin_amdgcn_mbcnt_lo((unsigned)m, 0u)); }
DI void topk_unit(const Ctx& F, CArgs& a, const int it) {
    unsigned char* ws = a.ws;
    const float* AFF = (const float*)(ws + WS_AFF); int* SLOT = (int*)(ws + WS_SLOT); float* GATE = (float*)(ws + WS_GATE);
    int* SEL = (int*)(ws + WS_GATE + 512 * 1024);
    volatile LAS int* CNT = (volatile LAS int*)F.lds;
    {
        const bool ctx = it >= 128; const int id = it & 127, e = id >> 3, b = id & 7;
        const int N = ctx ? LC : L, cap = ctx ? CAPC : CAP;
        const float* src = ctx ? AFF + (size_t)NB * 16 * L + ((size_t)b * 16 + e) * LC : AFF + ((size_t)b * 16 + e) * L;
        unsigned kb[4];
        { f32x4 v = {0.f, 0.f, 0.f, 0.f}; if (4 * F.tid < N) v = *(const f32x4*)(src + 4 * F.tid);
          kb[0] = __float_as_uint(v.x); kb[1] = __float_as_uint(v.y); kb[2] = __float_as_uint(v.z); kb[3] = __float_as_uint(v.w); }
        unsigned cur = 0u; int par = 0;
        for (int bit = 30; bit >= 0; --bit) {
            const unsigned cand = cur | (1u << bit);
            int c = 0;
#pragma unroll
            for (int q = 0; q < 4; ++q) c += __builtin_popcountll(__ballot(kb[q] >= cand));
            if (F.lane == 0) CNT[par * 8 + F.wave] = c;
            __syncthreads();
            int tot = 0;
#pragma unroll
            for (int w = 0; w < 8; ++w) tot += CNT[par * 8 + w];
            if (tot >= cap) cur = cand;
            par ^= 1;
        }
        unsigned long long mg[4], me[4]; int cg = 0, ce = 0;
#pragma unroll
        for (int q = 0; q < 4; ++q) { mg[q] = __ballot(kb[q] > cur); me[q] = __ballot(kb[q] == cur); cg += __builtin_popcountll(mg[q]); ce += __builtin_popcountll(me[q]); }
        __syncthreads();
        if (F.lane == 0) { CNT[16 + F.wave] = cg; CNT[24 + F.wave] = ce; }
        __syncthreads();
        int n_gt = 0, eq_before_wave = 0;
#pragma unroll
        for (int w = 0; w < 8; ++w) { const int g_ = CNT[16 + w], e_ = CNT[24 + w]; n_gt += g_; eq_before_wave += (w < F.wave) ? e_ : 0; }
        const int need_eq = cap - n_gt;
        int eqb = eq_before_wave;
#pragma unroll
        for (int q = 0; q < 4; ++q) eqb += lanes_below(me[q]);
        bool sel[4]; int eq_run = eqb;
#pragma unroll
        for (int q = 0; q < 4; ++q) { const bool isg = kb[q] > cur, ise = kb[q] == cur; sel[q] = isg || (ise && eq_run < need_eq); eq_run += ise ? 1 : 0; }
        unsigned long long ms[4]; int cs = 0;
#pragma unroll
        for (int q = 0; q < 4; ++q) { ms[q] = __ballot(sel[q]); cs += __builtin_popcountll(ms[q]); }
        __syncthreads();
        if (F.lane == 0) CNT[16 + F.wave] = cs;
        __syncthreads();
        int slot = 0;
#pragma unroll
        for (int w = 0; w < 8; ++w) slot += (w < F.wave) ? CNT[16 + w] : 0;
#pragma unroll
        for (int q = 0; q < 4; ++q) slot += lanes_below(ms[q]);
        const int gbase = ctx ? NGL + id * CAPC : id * CAP, rowbase = ctx ? T + b * LC : b * L;
        if (4 * F.tid < N) {
#pragma unroll
            for (int q = 0; q < 4; ++q) { const int row = rowbase + 4 * F.tid + q;
                if (sel[q]) { const int g = gbase + slot; SLOT[(size_t)row * 16 + e] = g; GATE[g] = __uint_as_float(kb[q]); SEL[g] = row; ++slot; }
                else SLOT[(size_t)row * 16 + e] = -1; }
        }
        __syncthreads();
    }
}
DI void topk_phase(const Ctx& F, CArgs& a, int l) {
    const int nitems = 128 + (l == 0 ? 128 : 0);
    for (int it = F.bx; it < nitems; it += F.G) topk_unit(F, a, it);
}

namespace attn_body {
constexpr int DM = 1024, NW = 8, QBLK = 32, QB = 256, KVBLK = 64, NT = KVR / KVBLK;
DI int crow(int r, int hi) { return (r & 3) + 8 * (r >> 2) + 4 * hi; }
#define SBAR() __builtin_amdgcn_sched_barrier(0)
constexpr int NSLOT = 3, SLOTB = 8192;
constexpr int LDS_K = 0, LDS_V = NSLOT * SLOTB, LDS_WS = 2 * NSLOT * SLOTB, LDS_OST = LDS_WS + NW * 64 * 4, LDS_BYTES_A = LDS_OST + NW * 4096;
DI void glds16(const void* gsrc, unsigned lds_dst) { unsigned keep;
    asm volatile("s_mov_b32 %0, m0\n\ts_mov_b32 m0, %2\n\ts_nop 0\n\tglobal_load_lds_dwordx4 %1, off\n\ts_mov_b32 m0, %0" : "=&s"(keep) : "v"(gsrc), "s"(lds_dst) : "memory"); }
DI float max3f(float a, float b, float c) { float r; asm("v_max3_f32 %0, %1, %2, %3" : "=v"(r) : "v"(a), "v"(b), "v"(c)); return r; }
DI float max2f(float a, float b) { float r; asm("v_max_f32_e32 %0, %1, %2" : "=v"(r) : "v"(a), "v"(b)); return r; }
DI float fadd_s(float a, float b) { float r; asm("v_add_f32_e32 %0, %1, %2" : "=v"(r) : "v"(a), "v"(b)); return r; }
DI float fsub_s(float a, float b) { float r; asm("v_sub_f32_e32 %0, %1, %2" : "=v"(r) : "v"(a), "v"(b)); return r; }
DI unsigned cvtpk_s(float lo, float hi) { return pk2h(lo, hi); }
DI f32x16 MF(s16x8 x, s16x8 y, f32x16 c) { return __builtin_amdgcn_mfma_f32_32x32x16_f16(__builtin_bit_cast(half8, x), __builtin_bit_cast(half8, y), c, 0, 0, 0); }
#define WAIT_BAR(N) asm volatile("s_waitcnt vmcnt(" #N ") lgkmcnt(0)\n\ts_barrier" ::: "memory")
DI void qkt(f32x16& p0, f32x16& p1, const char* Kslot, const s16x8* qr, const f32x16& negm, int r32, int hi) {
    const char* kb = Kslot + hi * 1024 + r32 * 16;
#pragma unroll
    for (int d0 = 0; d0 < 4; ++d0) {
        const s16x8 b0 = *reinterpret_cast<const s16x8*>(kb + d0 * 2048);
        const s16x8 b1 = *reinterpret_cast<const s16x8*>(kb + d0 * 2048 + 512);
        if (d0 == 0) { p0 = MF(b0, qr[0], negm); p1 = MF(b1, qr[0], negm); }
        else { p0 = MF(b0, qr[d0], p0); p1 = MF(b1, qr[d0], p1); } }
}
typedef __attribute__((address_space(3))) const char* lds_cptr;
typedef short v4i16_t __attribute__((ext_vector_type(4)));
DI void kload8(s16x8* kf, lds_cptr kp) {
    kf[0] = *(const LAS s16x8*)(kp);        kf[1] = *(const LAS s16x8*)(kp + 512);
    kf[2] = *(const LAS s16x8*)(kp + 2048); kf[3] = *(const LAS s16x8*)(kp + 2560);
    kf[4] = *(const LAS s16x8*)(kp + 4096); kf[5] = *(const LAS s16x8*)(kp + 4608);
    kf[6] = *(const LAS s16x8*)(kp + 6144); kf[7] = *(const LAS s16x8*)(kp + 6656);
}
DI void kload2(s16x8* kf, lds_cptr kp, int j) { kf[2 * j] = *(const LAS s16x8*)(kp + j * 2048); kf[2 * j + 1] = *(const LAS s16x8*)(kp + j * 2048 + 512); }
DI s16x4 vtr(lds_cptr p) { return __builtin_bit_cast(s16x4, __builtin_amdgcn_ds_read_tr16_b64_v4i16((LAS v4i16_t*)p)); }
DI float rowmax(const f32x16& p0, const f32x16& p1) {
    float a = max3f(p0[0], p0[1], p1[0]), b = max3f(p0[2], p0[3], p1[1]); a = max3f(a, p1[2], p1[3]);
#pragma unroll
    for (int r = 4; r < 16; r += 4) { a = max3f(a, p0[r], p0[r + 1]); b = max3f(b, p0[r + 2], p0[r + 3]); a = max3f(a, p1[r], p1[r + 1]); b = max3f(b, p1[r + 2], p1[r + 3]); }
    const float m = max2f(a, b);
    auto rr = __builtin_amdgcn_permlane32_swap(__float_as_uint(m), __float_as_uint(m), false, false);
    return max2f(__uint_as_float(rr[0]), __uint_as_float(rr[1]));
}
DI void pv(f32x16* o, int vb, s16x8 pa0, s16x8 pa1, s16x8 pa2, s16x8 pa3) {
#pragma unroll
    for (int d0 = 0; d0 < 2; ++d0) { s16x4 lo[4], hi[4];
#pragma unroll
        for (int ks = 0; ks < 4; ++ks) {
            asm volatile("ds_read_b64_tr_b16 %0,%1 offset:%c2" : "=&v"(lo[ks]) : "v"(vb), "i"(d0 * 4096 + ks * 1024) : "memory");
            asm volatile("ds_read_b64_tr_b16 %0,%1 offset:%c2" : "=&v"(hi[ks]) : "v"(vb), "i"(d0 * 4096 + ks * 1024 + 512) : "memory"); }
        asm volatile("s_waitcnt lgkmcnt(0)" ::: "memory"); SBAR();
#define PK(k) (s16x8){lo[k][0], lo[k][1], lo[k][2], lo[k][3], hi[k][0], hi[k][1], hi[k][2], hi[k][3]}
        o[d0] = MF(pa0, PK(0), o[d0]);
        o[d0] = MF(pa1, PK(1), o[d0]);
        o[d0] = MF(pa2, PK(2), o[d0]);
        o[d0] = MF(pa3, PK(3), o[d0]);
#undef PK
    }
}
template <int THRL> DI void attn_unit2(const int tid, const hf* Qw0, const hf* __restrict__ Kh, const hf* __restrict__ Vh, hf* Ow0, char* shm,
                                        const bool fuse = false, const hf* O1src = nullptr, const float lam = 0.f, const float* subg = nullptr) {
    const int lane = tid & 63, r32 = lane & 31, hi = lane >> 5; const int wid = __builtin_amdgcn_readfirstlane(tid >> 6);
    const hf* Qw = Qw0 + (long)(wid * QBLK) * DM;
    const unsigned lds0 = (unsigned)(uintptr_t)shm;
    constexpr int LDS_V2 = NSLOT * SLOTB, LDS_WS2 = LDS_V2 + NSLOT * 2 * SLOTB, LDS_OST2 = LDS_WS2 + NW * 64 * 4;
    float* wsf = (float*)(shm + LDS_WS2) + wid * 64;
    const hf* ksrc = Kh + (long)lane * DM + wid * 8;
    const hf* vsrc = Vh + (long)(16 * (wid & 3) + (lane >> 2)) * DM + (wid >> 2) * 32 + (lane & 3) * 8;
    const unsigned kdst = lds0 + LDS_K + wid * 1024, vdst = lds0 + LDS_V2 + wid * 1024;
#define DMA_K(t, slot) glds16(ksrc + (long)(t) * KVBLK * DM, (unsigned)__builtin_amdgcn_readfirstlane(kdst + (slot)))
#define DMA_V(t, slot) do { glds16(vsrc + (long)(t) * KVBLK * DM, (unsigned)__builtin_amdgcn_readfirstlane(vdst + 2 * (slot))); glds16(vsrc + (long)(t) * KVBLK * DM + 64, (unsigned)__builtin_amdgcn_readfirstlane(vdst + 2 * (slot) + 8192)); } while (0)
    const int vb0 = (int)(lds0 + LDS_V2) + ((lane >> 4) & 1) * 32 + (lane & 3) * 8 + (4 * hi + ((lane & 15) >> 2)) * 64;
    const char* Kbase = shm + LDS_K; s16x8 kf[8];
    const lds_cptr shm3 = (lds_cptr)shm; const lds_cptr kp0 = shm3 + LDS_K + hi * 1024 + r32 * 16; const lds_cptr vp0 = shm3 + LDS_V2 + ((lane >> 4) & 1) * 32 + (lane & 3) * 8 + (4 * hi + ((lane & 15) >> 2)) * 64;
    DMA_K(0, 0); DMA_V(0, 0); DMA_K(1, SLOTB);
    constexpr int LDS_Q2 = LDS_OST2 + NW * 4096;
    const lds_cptr qp0 = shm3 + LDS_Q2 + wid * 4096 + lane * 16;
    s16x8 qr[4];
#pragma unroll
    for (int d0 = 0; d0 < 4; ++d0) { qr[d0] = *reinterpret_cast<const s16x8*>(&Qw[(long)r32 * DM + d0 * 16 + hi * 8]); *(LAS s16x8*)((LAS char*)qp0 + d0 * 1024) = qr[d0]; }
#define QLD(d0) (*(const LAS s16x8*)(qp0 + (d0) * 1024))
    float mhat = 0.f, l_reg = 0.f; f32x16 o[4]; o[0] = f32x16{}; o[1] = f32x16{}; o[2] = f32x16{}; o[3] = f32x16{}; const f32x16 zero16 = f32x16{};
    bool resc = false;
#define START(P0, P1) do { const float rm = rowmax(P0, P1); resc = false; \
    { const float dl = rm; mhat = fadd_s(mhat, dl); \
      _Pragma("unroll") for (int r = 0; r < 16; ++r) { P0[r] = fsub_s(P0[r], dl); P1[r] = fsub_s(P1[r], dl); } } \
    _Pragma("unroll") for (int r = 0; r < 16; ++r) P0[r] = __builtin_amdgcn_exp2f(P0[r]); } while (0)
#define RESC() do { if (resc) { asm volatile("s_waitcnt lgkmcnt(0)" ::: "memory"); \
      _Pragma("unroll") for (int d_ = 0; d_ < 4; ++d_) _Pragma("unroll") for (int r = 0; r < 16; ++r) o[d_][r] *= wsf[crow(r, hi)]; } } while (0)
    f32x16 pA0, pA1, pB0, pB1;
    int sl_prev = 0, sl_cur = 0, sl_next = SLOTB;
#define ROT() do { sl_prev = sl_cur; sl_cur = sl_next; sl_next = (sl_next == (NSLOT - 1) * SLOTB) ? 0 : sl_next + SLOTB; } while (0)
    DMA_K(2, 2 * SLOTB);
    WAIT_BAR(3);
    qkt(pA0, pA1, Kbase, qr, zero16, r32, hi); asm volatile("s_nop 15\n\ts_nop 7" : "+v"(pA0), "+v"(pA1));
    START(pA0, pA1);
    _Pragma("unroll") for (int r = 0; r < 16; ++r) pA1[r] = __builtin_amdgcn_exp2f(pA1[r]);
    WAIT_BAR(0);
    DMA_K(3, 0); DMA_V(1, SLOTB);
    ROT();
    kload8(kf, kp0 + sl_cur);
    WAIT_BAR(3);
    s16x4 vlo[8], vhi[8]; u32x4 pw0, pw1, pw2, pw3;
    s16x8 qa_ = QLD(0), qb_ = QLD(1);
#define PKW(P, B) cvtpk_s(P[B], P[B + 1])
#define PAF(k) __builtin_bit_cast(s16x8, pw##k)
#define VFR(i) (s16x8){vlo[i][0], vlo[i][1], vlo[i][2], vlo[i][3], vhi[i][0], vhi[i][1], vhi[i][2], vhi[i][3]}
#define PIN(x) asm volatile("" : "+v"(x))
#define MX3(a, b, c) __builtin_fmaxf(__builtin_fmaxf((a), (b)), (c))
#define GAPA(MFX, A0, A1, A2, A3, W0, W1, PW) do { MFX; sacc += A0; sacc += A1; sacc += A2; sacc += A3; PIN(sacc); W0; W1; PIN(PW); SBAR(); } while (0)
#define EX(v) __builtin_amdgcn_exp2f(v)
#define GAPB(MFX, X, B) do { MFX; X[B] = EX(X[B]); X[B + 1] = EX(X[B + 1]); PIN(X); SBAR(); } while (0)
#define VRD(i) do { vlo[i] = vtr(vp_ + (((i) >> 2) * 4096 + ((i) & 3) * 1024)); vhi[i] = vtr(vp_ + (((i) >> 2) * 4096 + ((i) & 3) * 1024 + 512)); } while (0)
#define VRD2(i) do { vlo[i] = vtr(vp_ + (8192 + ((i) >> 2) * 4096 + ((i) & 3) * 1024)); vhi[i] = vtr(vp_ + (8192 + ((i) >> 2) * 4096 + ((i) & 3) * 1024 + 512)); } while (0)
#define KRD(G, j) do { if (G) { kload2(kf, kp0 + sl_next, j); SBAR(); } } while (0)
#define STEP(C0, C1, P0, P1, t, GK, GV, GL) do { SBAR(); \
    const lds_cptr vp_ = vp0 + 2 * sl_prev; \
    VRD(0); SBAR(); float sacc = (P0[0] + P0[1]); \
    GAPA(C0 = MF(kf[0], qa_, zero16), P0[2], P0[3], P0[4], P0[5],     pw0[0] = PKW(P0, 0), pw0[1] = PKW(P0, 2), pw0); \
    VRD(4); SBAR(); GAPA(C1 = MF(kf[1], qa_, zero16), P0[6], P0[7], P0[8], P0[9],     pw0[2] = PKW(P0, 4), pw0[3] = PKW(P0, 6), pw0); \
    qa_ = QLD(2); VRD(1); SBAR(); GAPA(C0 = MF(kf[2], qb_, C0),   P0[10], P0[11], P0[12], P0[13], pw1[0] = PKW(P0, 8), pw1[1] = PKW(P0, 10), pw1); \
    VRD(5); SBAR(); GAPA(C1 = MF(kf[3], qb_, C1),   P0[14], P0[15], P1[0], P1[1],   pw1[2] = PKW(P0, 12), pw1[3] = PKW(P0, 14), pw1); \
    qb_ = QLD(3); VRD(2); SBAR(); GAPA(C0 = MF(kf[4], qa_, C0),   P1[2], P1[3], P1[4], P1[5],     pw2[0] = PKW(P1, 0), pw2[1] = PKW(P1, 2), pw2); \
    VRD(6); SBAR(); GAPA(C1 = MF(kf[5], qa_, C1),   P1[6], P1[7], P1[8], P1[9],     pw2[2] = PKW(P1, 4), pw2[3] = PKW(P1, 6), pw2); \
    VRD(3); SBAR(); GAPA(C0 = MF(kf[6], qb_, C0),   P1[10], P1[11], P1[12], P1[13], pw3[0] = PKW(P1, 8), pw3[1] = PKW(P1, 10), pw3); \
    VRD(7); SBAR(); GAPA(C1 = MF(kf[7], qb_, C1),   P1[14], P1[15], 0.f, 0.f,       pw3[2] = PKW(P1, 12), pw3[3] = PKW(P1, 14), pw3); \
    l_reg += sacc; \
    if (GK) { DMA_K((t) + 3, sl_cur); } if (GV) { DMA_V((t) + 1, sl_next); } \
    { float a = MX3(C0[0], C0[1], C1[0]), b = MX3(C0[2], C0[3], C1[1]); a = MX3(a, C1[2], C1[3]); \
      _Pragma("unroll") for (int r = 4; r < 16; r += 4) { a = MX3(a, C0[r], C0[r + 1]); b = MX3(b, C0[r + 2], C0[r + 3]); a = MX3(a, C1[r], C1[r + 1]); b = MX3(b, C1[r + 2], C1[r + 3]); } \
      float rm = __builtin_fmaxf(a, b); { auto rr = __builtin_amdgcn_permlane32_swap(__float_as_uint(rm), __float_as_uint(rm), false, false); rm = __builtin_fmaxf(__uint_as_float(rr[0]), __uint_as_float(rr[1])); } \
      rm -= mhat;                                                       \
      resc = false; \
      if (__builtin_expect(__any(rm > (float)THRL), 0)) { const float dl = __builtin_fmaxf(rm, 0.f); mhat += dl; \
        const float f = __builtin_amdgcn_exp2f(-dl); l_reg *= f; if (hi == 0) wsf[r32] = f; resc = true; } \
      _Pragma("unroll") for (int r = 0; r < 16; ++r) { C0[r] -= mhat; C1[r] -= mhat; } } \
    SBAR(); \
    GAPB(o[0] = MF(PAF(0), VFR(0), o[0]), C0, 0); \
    GAPB(o[1] = MF(PAF(0), VFR(4), o[1]), C0, 2); \
    KRD(GL, 0); GAPB(o[0] = MF(PAF(1), VFR(1), o[0]), C0, 4); \
    VRD2(0); VRD2(4); SBAR(); \
    KRD(GL, 1); GAPB(o[1] = MF(PAF(1), VFR(5), o[1]), C0, 6); \
    KRD(GL, 2); GAPB(o[0] = MF(PAF(2), VFR(2), o[0]), C0, 8); \
    VRD2(1); VRD2(5); SBAR(); \
    KRD(GL, 3); GAPB(o[1] = MF(PAF(2), VFR(6), o[1]), C0, 10); \
    GAPB(o[0] = MF(PAF(3), VFR(3), o[0]), C0, 12); \
    VRD2(2); VRD2(6); SBAR(); \
    GAPB(o[1] = MF(PAF(3), VFR(7), o[1]), C0, 14); \
    VRD2(3); VRD2(7); SBAR(); \
    GAPB(o[2] = MF(PAF(0), VFR(0), o[2]), C1, 0); \
    GAPB(o[3] = MF(PAF(0), VFR(4), o[3]), C1, 2); \
    GAPB(o[2] = MF(PAF(1), VFR(1), o[2]), C1, 4); \
    GAPB(o[3] = MF(PAF(1), VFR(5), o[3]), C1, 6); \
    qa_ = QLD(0); qb_ = QLD(1); SBAR(); \
    GAPB(o[2] = MF(PAF(2), VFR(2), o[2]), C1, 8); \
    GAPB(o[3] = MF(PAF(2), VFR(6), o[3]), C1, 10); \
    GAPB(o[2] = MF(PAF(3), VFR(3), o[2]), C1, 12); \
    GAPB(o[3] = MF(PAF(3), VFR(7), o[3]), C1, 14); \
    } while (0)
    int t = 1;
    for (; t + 5 < NT; t += 2) {
        STEP(pB0, pB1, pA0, pA1, t, true, true, true);     WAIT_BAR(3); RESC(); ROT();
        STEP(pA0, pA1, pB0, pB1, t + 1, true, true, true); WAIT_BAR(3); RESC(); ROT();
    }
#define ENDW(tt) do { if ((tt) + 3 < NT) { WAIT_BAR(3); } else if ((tt) + 2 < NT) { WAIT_BAR(2); } else { WAIT_BAR(0); } } while (0)
    for (; t + 1 < NT; t += 2) {
        STEP(pB0, pB1, pA0, pA1, t, (t + 3 < NT), (t + 1 < NT), (t + 1 < NT));         ENDW(t);     RESC(); ROT();
        STEP(pA0, pA1, pB0, pB1, t + 1, (t + 4 < NT), (t + 2 < NT), (t + 2 < NT));     ENDW(t + 1); RESC(); ROT();
    }
    STEP(pB0, pB1, pA0, pA1, NT - 1, false, false, false); RESC();
    { float sacc = pB0[0] + pB0[1]; _Pragma("unroll") for (int r = 2; r < 16; ++r) sacc += pB0[r]; _Pragma("unroll") for (int r = 0; r < 16; ++r) sacc += pB1[r]; l_reg += sacc;
      pw0 = (u32x4){PKW(pB0, 0), PKW(pB0, 2), PKW(pB0, 4), PKW(pB0, 6)}; pw1 = (u32x4){PKW(pB0, 8), PKW(pB0, 10), PKW(pB0, 12), PKW(pB0, 14)}; pw2 = (u32x4){PKW(pB1, 0), PKW(pB1, 2), PKW(pB1, 4), PKW(pB1, 6)}; pw3 = (u32x4){PKW(pB1, 8), PKW(pB1, 10), PKW(pB1, 12), PKW(pB1, 14)};
      SBAR(); pv(o, vb0 + 2 * sl_cur, PAF(0), PAF(1), PAF(2), PAF(3)); pv(o + 2, vb0 + 2 * sl_cur + 8192, PAF(0), PAF(1), PAF(2), PAF(3)); }
#undef PKW
#undef PAF
#undef VFR
#undef PIN
#undef MX3
#undef GAPA
#undef GAPB
#undef EX
#undef VRD
#undef KRD
#undef STEP
#undef ENDW
    { auto rr = __builtin_amdgcn_permlane32_swap(__float_as_uint(l_reg), __float_as_uint(l_reg), false, false); l_reg = __uint_as_float(rr[0]) + __uint_as_float(rr[1]); }
    if (hi == 0) wsf[32 + r32] = l_reg; asm volatile("s_waitcnt lgkmcnt(0)" ::: "memory");
    float rli[16];
#pragma unroll
    for (int r = 0; r < 16; ++r) rli[r] = __builtin_amdgcn_rcpf(wsf[32 + crow(r, hi)]);
    hf* Ow = Ow0 + (long)(wid * QBLK) * DM;
    int lane2 = lane; asm volatile("" : "+v"(lane2));
    if (fuse) {
        asm volatile("s_waitcnt vmcnt(0)" ::: "memory");
        const hf* O1w = O1src + (long)(wid * QBLK) * DM; asm volatile("" : "+s"(O1w)); asm volatile("" : "+s"(Ow));
        u32x4 dvp[2][4]; float ssr[4] = {0.f, 0.f, 0.f, 0.f};
        hf* stg = (hf*)(shm + LDS_OST2) + wid * 2048;
#pragma unroll
        for (int hh2 = 0; hh2 < 2; ++hh2) {
            u32x4 x1r[4];
#pragma unroll
            for (int i = 0; i < 4; ++i) { const int row = i * 8 + (lane2 >> 3), ch = lane2 & 7; x1r[i] = *(const u32x4*)(O1w + (long)row * DM + 64 * hh2 + ch * 8); }
#pragma unroll
            for (int r = 0; r < 16; ++r) { const int orow = crow(r, hi);
#pragma unroll
                for (int d0 = 0; d0 < 2; ++d0) stg[orow * 64 + d0 * 32 + r32] = (hf)(o[2 * hh2 + d0][r] * rli[r]); }
            asm volatile("s_waitcnt lgkmcnt(0)" ::: "memory");
#pragma unroll
            for (int i = 0; i < 4; ++i) { const int row = i * 8 + (lane2 >> 3), ch = lane2 & 7; const u32x4 v2 = *(const u32x4*)(stg + row * 64 + ch * 8);
                float x1[8], x2[8]; unpack8(x1r[i], x1); unpack8(v2, x2);
#pragma unroll
                for (int j = 0; j < 8; ++j) { x1[j] -= lam * x2[j]; ssr[i] += x1[j] * x1[j]; }
                dvp[hh2][i].x = pk2h(x1[0], x1[1]); dvp[hh2][i].y = pk2h(x1[2], x1[3]); dvp[hh2][i].z = pk2h(x1[4], x1[5]); dvp[hh2][i].w = pk2h(x1[6], x1[7]); }
            asm volatile("s_waitcnt lgkmcnt(0)" ::: "memory");
        }
#pragma unroll
        for (int i = 0; i < 4; ++i) { float ss = ssr[i]; ss += sx(ss, 1, lane2); ss += sx(ss, 2, lane2); ss += sx(ss, 4, lane2); ssr[i] = (1.f - 0.35550907f) / sqrtf(ss * (1.f / 128.f) + 1e-5f); }
#pragma unroll
        for (int hh2 = 0; hh2 < 2; ++hh2) {
            const f32x4 g0 = *(const f32x4*)(subg + hh2 * 64 + (lane2 & 7) * 8), g1 = *(const f32x4*)(subg + hh2 * 64 + (lane2 & 7) * 8 + 4);
#pragma unroll
            for (int i = 0; i < 4; ++i) { const int row = i * 8 + (lane2 >> 3), ch = lane2 & 7; const float rs_ = ssr[i]; float dq[8]; unpack8(dvp[hh2][i], dq);
                u32x4 w; w.x = pk2h(dq[0] * rs_ * g0[0], dq[1] * rs_ * g0[1]); w.y = pk2h(dq[2] * rs_ * g0[2], dq[3] * rs_ * g0[3]);
                w.z = pk2h(dq[4] * rs_ * g1[0], dq[5] * rs_ * g1[1]); w.w = pk2h(dq[6] * rs_ * g1[2], dq[7] * rs_ * g1[3]);
                *(u32x4*)(Ow + (long)row * DM + 64 * hh2 + ch * 8) = w; } }
    } else
    { hf* stg = (hf*)(shm + LDS_OST2) + wid * 2048;
#pragma unroll
      for (int hh2 = 0; hh2 < 2; ++hh2) {
#pragma unroll
        for (int r = 0; r < 16; ++r) { const int orow = crow(r, hi);
#pragma unroll
          for (int d0 = 0; d0 < 2; ++d0) stg[orow * 64 + d0 * 32 + r32] = (hf)(o[2 * hh2 + d0][r] * rli[r]); }
        asm volatile("s_waitcnt lgkmcnt(0)" ::: "memory");
#pragma unroll
        for (int i = 0; i < 4; ++i) { const int row = i * 8 + (lane2 >> 3), ch = lane2 & 7; const u32x4 v = *(const u32x4*)(stg + row * 64 + ch * 8); *(u32x4*)(Ow + (long)row * DM + 64 * hh2 + ch * 8) = v; }
        asm volatile("s_waitcnt lgkmcnt(0)" ::: "memory");
      } }
    asm volatile("s_waitcnt lgkmcnt(0)\n\ts_barrier" ::: "memory");
#undef DMA_K
#undef QLD
#undef VRD2
#undef DMA_V
#undef START
#undef RESC
#undef ROT
}
#undef SBAR
#undef WAIT_BAR
}

DI void attn_phase(const Ctx& F, CArgs& a) {
    unsigned char* ws = a.ws;
    const hf* Q = (const hf*)(ws + WS_BIG); const hf* Kb = Q + (size_t)T * D; const hf* Vb = Kb + (size_t)NB * KVR * D;
    hf* OP = (hf*)(ws + WS_XIN); hf* ZN = (hf*)(ws + WS_Z);
    const float lam_init = 0.35550907f;
    const float l1 = wave_sum(a.in[I_LQ1][F.lane] * a.in[I_LK1][F.lane], F.lane), l2 = wave_sum(a.in[I_LQ2][F.lane] * a.in[I_LK2][F.lane], F.lane);
    const float lam_s = __int_as_float(__builtin_amdgcn_readfirstlane(__float_as_int(expf(l1) - expf(l2) + lam_init)));
    for (int i = 0;; ++i) {
        const long P = (long)(i >> 1) * F.G + F.vcu; if (P >= 512) break;
        const int r = i & 1, qb = (int)(P & 7), bh = (int)(P >> 3), b = bh >> 3, hh = bh & 7;
        const int qcol = hh * 128 + r * 64, vcol = hh * 128;
        const size_t orow0 = ((size_t)b * L + (size_t)qb * 256) * D + vcol;
        const hf* Qw0 = Q + ((size_t)b * L + (size_t)qb * 256) * D + qcol;
        const hf* Kh = Kb + (size_t)b * KVR * D + qcol; const hf* Vh = Vb + (size_t)b * KVR * D + vcol;
        attn_body::attn_unit2<8>(F.tid, Qw0, Kh, Vh, (r ? ZN : OP) + orow0, (char*)F.lds, r != 0, OP + orow0, lam_s, a.in[I_SUBG]);
    }
}

DI void attn_post_phase(const Ctx& F, CArgs& a) {
    unsigned char* ws = a.ws;
    const h16* O0 = (const h16*)(ws + WS_XIN); const h16* O1 = O0 + (size_t)T * D; h16* ON = (h16*)(ws + WS_Z);
    const float lam_init = 0.35550907f;
    const float l1 = wave_sum(a.in[I_LQ1][F.lane] * a.in[I_LK1][F.lane], F.lane), l2 = wave_sum(a.in[I_LQ2][F.lane] * a.in[I_LK2][F.lane], F.lane);
    const float lam = expf(l1) - expf(l2) + lam_init;
    float g[16];
#pragma unroll
    for (int i = 0; i < 16; ++i) g[i] = a.in[I_SUBG][(F.lane & 7) * 16 + i] * (1.f - lam_init);
    for (int row0 = F.gw; row0 < T; row0 += 4 * F.NGW) {
        u32x4 in[4][4];
#pragma unroll
        for (int q = 0; q < 4; ++q) { const int row = row0 + q * F.NGW; if (row < T) { const size_t off = (size_t)row * D + 16 * F.lane;
            in[q][0] = *(const u32x4*)(O0 + off); in[q][1] = *(const u32x4*)(O0 + off + 8); in[q][2] = *(const u32x4*)(O1 + off); in[q][3] = *(const u32x4*)(O1 + off + 8); } }
        u32x4 outw[4][2];
#pragma unroll
        for (int q = 0; q < 4; ++q) { const int row = row0 + q * F.NGW; if (row < T) {
            float x0[8], x1[8], y0[8], y1[8];
            unpack8(in[q][0], x0); unpack8(in[q][1], x1); unpack8(in[q][2], y0); unpack8(in[q][3], y1);
            float o[16]; float ss = 0.f;
#pragma unroll
            for (int i = 0; i < 8; ++i) { o[i] = x0[i] - lam * y0[i]; o[8 + i] = x1[i] - lam * y1[i]; }
#pragma unroll
            for (int i = 0; i < 16; ++i) ss += o[i] * o[i];
            ss += sx(ss, 1, F.lane); ss += sx(ss, 2, F.lane); ss += sx(ss, 4, F.lane);
            const float rstd = 1.0f / sqrtf(ss * (1.f / 128.f) + 1e-5f);
            u32x4 w0, w1;
            w0.x = pk2h(o[0] * rstd * g[0], o[1] * rstd * g[1]); w0.y = pk2h(o[2] * rstd * g[2], o[3] * rstd * g[3]); w0.z = pk2h(o[4] * rstd * g[4], o[5] * rstd * g[5]); w0.w = pk2h(o[6] * rstd * g[6], o[7] * rstd * g[7]);
            w1.x = pk2h(o[8] * rstd * g[8], o[9] * rstd * g[9]); w1.y = pk2h(o[10] * rstd * g[10], o[11] * rstd * g[11]); w1.z = pk2h(o[12] * rstd * g[12], o[13] * rstd * g[13]); w1.w = pk2h(o[14] * rstd * g[14], o[15] * rstd * g[15]);
            outw[q][0] = w0; outw[q][1] = w1; } }
#pragma unroll
        for (int q = 0; q < 4; ++q) { const int row = row0 + q * F.NGW; if (row < T) { const size_t off = (size_t)row * D + 16 * F.lane; *(u32x4*)(ON + off) = outw[q][0]; *(u32x4*)(ON + off + 8) = outw[q][1]; } }
    }
}

namespace hy {
constexpr int VPS = 2568;
constexpr int OFF_SA = 0, OFF_VP = 65536, OFF_G = OFF_VP + 8 * VPS * 2, OFF_RG = OFF_G + 32768, OFF_END = OFF_RG + 8192;
static_assert(OFF_END <= LDS_CTL_OFF, "hyena LDS map");
DI f32x16 MF(s16x8 x, s16x8 y, f32x16 c) { return __builtin_amdgcn_mfma_f32_32x32x16_f16(__builtin_bit_cast(half8, x), __builtin_bit_cast(half8, y), c, 0, 0, 0); }
DI int crow(int r, int hi) { return (r & 3) + 8 * (r >> 2) + 4 * hi; }

struct RowRaw { u32x4 d[4]; h16 prev, next; };
DI void raw_load(const h16* UT, int chr, int tid, RowRaw& r) {
    const int b = tid >> 6, t0 = (tid & 63) * 32;
    const h16* src = UT + (size_t)chr * T + (size_t)b * L + t0;
    r.prev = t0 > 0 ? src[-1] : (h16)0; r.next = t0 + 32 < L ? src[32] : (h16)0;
#pragma unroll
    for (int q = 0; q < 4; ++q) r.d[q] = *(const u32x4*)(src + 8 * q);
}
DI void conv3_store(const RowRaw& r, float w0, float w1, float w2, LAS h16* dst, int pitch, int tid) {
    const int b = tid >> 6, t0 = (tid & 63) * 32;
    float u[34];
    u[0] = h2f(r.prev); u[33] = h2f(r.next);
#pragma unroll
    for (int q = 0; q < 4; ++q) { float tmp[8]; unpack8(r.d[q], tmp);
#pragma unroll
        for (int e = 0; e < 8; ++e) u[1 + 8 * q + e] = tmp[e]; }
#pragma unroll
    for (int q = 0; q < 4; ++q) { float o[8];
#pragma unroll
        for (int e = 0; e < 8; ++e) { const int i = 8 * q + e; o[e] = w0 * u[i] + w1 * u[i + 1] + w2 * u[i + 2]; }
        u32x4 w; w.x = pk2h(o[0], o[1]); w.y = pk2h(o[2], o[3]); w.z = pk2h(o[4], o[5]); w.w = pk2h(o[6], o[7]);
        *(LAS u32x4*)(dst + b * pitch + t0 + 8 * q) = w; }
}
DI void rg_load(const h16* hfw, const h16* hbw, int tid, h16 (&v)[8]) {
#pragma unroll
    for (int e = 0; e < 8; ++e) { const int idx = tid * 8 + e; h16 x = 0; if (idx >= 1 && idx <= L) x = hfw[L - idx]; else if (idx > L) x = hbw[idx - L]; v[e] = x; }
}
DI void rg_store(LAS h16* RG, int tid, const h16 (&v)[8]) {
    u32x4 w; w.x = v[0] | ((unsigned)v[1] << 16); w.y = v[2] | ((unsigned)v[3] << 16); w.z = v[4] | ((unsigned)v[5] << 16); w.w = v[6] | ((unsigned)v[7] << 16);
    *(LAS u32x4*)(RG + tid * 8) = w;
}
DI void build_sa(const LAS h16* RG, LAS unsigned char* SA, int tid) {
#pragma unroll
    for (int i = 0; i < 8; ++i) { const int q = tid + NTHR * i; unsigned short v[8];
#pragma unroll
        for (int e = 0; e < 8; ++e) v[e] = (q + e < 4096) ? RG[q + e] : (unsigned short)0;
        u32x4 w; w.x = v[0] | ((unsigned)v[1] << 16); w.y = v[2] | ((unsigned)v[3] << 16); w.z = v[4] | ((unsigned)v[5] << 16); w.w = v[6] | ((unsigned)v[7] << 16);
        *(LAS u32x4*)(SA + q * 16) = w; }
}
DI void toeplitz(const LAS unsigned char* SA, const LAS h16* VP, int wave, int lane, f32x16 (&acc)[2]) {
    const int i = lane & 31, hi = lane >> 5, n = lane & 31, b = n >> 2, q = n & 3;
    const int T0 = 256 * wave, dhi = T0 + 192;
    const LAS unsigned char* ap = SA + (L - dhi + 8 * hi - i) * 16;
    const LAS h16* bp = VP + b * VPS + 256 + (T0 + 64 * q - dhi) + 8 * hi;
    acc[0] = f32x16{}; acc[1] = f32x16{};
    s16x8 p0 = *(const LAS s16x8*)(ap - 512), p1 = *(const LAS s16x8*)(ap - 512 + 256);
    s16x8 xa0 = *(const LAS s16x8*)(ap), xa1 = *(const LAS s16x8*)(ap + 256), xb0 = *(const LAS s16x8*)(bp), xb1 = *(const LAS s16x8*)(bp + 16);
    s16x8 ya0, ya1, yb0, yb1;
    for (int d = 0; d < 70; d += 2) {
        ya0 = *(const LAS s16x8*)(ap + (d + 1) * 512); ya1 = *(const LAS s16x8*)(ap + (d + 1) * 512 + 256); yb0 = *(const LAS s16x8*)(bp + (d + 1) * 32); yb1 = *(const LAS s16x8*)(bp + (d + 1) * 32 + 16);
        __builtin_amdgcn_sched_barrier(0);
        acc[0] = MF(xa0, xb0, acc[0]); acc[1] = MF(p0, xb0, acc[1]);
        acc[0] = MF(xa1, xb1, acc[0]); acc[1] = MF(p1, xb1, acc[1]);
        __builtin_amdgcn_sched_barrier(0);
        { const int d2 = (d + 2 < 70) ? d + 2 : d;
          p0 = xa0; p1 = xa1;
          xa0 = *(const LAS s16x8*)(ap + d2 * 512); xa1 = *(const LAS s16x8*)(ap + d2 * 512 + 256); xb0 = *(const LAS s16x8*)(bp + d2 * 32); xb1 = *(const LAS s16x8*)(bp + d2 * 32 + 16); }
        __builtin_amdgcn_sched_barrier(0);
        acc[0] = MF(ya0, yb0, acc[0]); acc[1] = MF(p0, yb0, acc[1]);
        acc[0] = MF(ya1, yb1, acc[0]); acc[1] = MF(p1, yb1, acc[1]);
        __builtin_amdgcn_sched_barrier(0);
        p0 = ya0; p1 = ya1;
    }
}
}

#define HY_LBAR() asm volatile("s_waitcnt lgkmcnt(0)\n\ts_barrier" ::: "memory")
DI void hyconv_phase(const Ctx& F, CArgs& a) {
    using namespace hy;
    unsigned char* ws = a.ws;
    const h16* UT = (const h16*)(ws + WS_BIG); h16* ZT = (h16*)(ws + WS_XIN); const h16* FILT = (const h16*)(ws + WS_FILT);
    const float* cconv = a.in[I_CCONV]; const float* skip = a.in[I_SKIP];
    LAS unsigned char* SA = F.lds + OFF_SA; LAS h16* VP = (LAS h16*)(F.lds + OFF_VP); LAS h16* GB = (LAS h16*)(F.lds + OFF_G); LAS h16* RG = (LAS h16*)(F.lds + OFF_RG);
    for (int i = F.tid; i < 8 * 512; i += NTHR) { const int b = i >> 9, p = i & 511; VP[b * VPS + (p < 256 ? p : 2048 + p)] = 0; }
    const int lane = F.lane, hi = lane >> 5, n = lane & 31, bq = n >> 2, q = n & 3;
    int ch = F.bx;
    RowRaw rx1, rv, rx2; h16 g1[8], g2[8];
    if (ch < D) { raw_load(UT, ch, F.tid, rx1); raw_load(UT, 2048 + ch, F.tid, rv); rg_load(FILT + (size_t)(0 * 1024 + ch) * L, FILT + (size_t)(1 * 1024 + ch) * L, F.tid, g1); }
    for (; ch < D; ch += F.G) {
        HY_LBAR();
        conv3_store(rx1, cconv[ch], cconv[3072 + ch], cconv[2 * 3072 + ch], GB, L, F.tid);
        conv3_store(rv, cconv[2048 + ch], cconv[3072 + 2048 + ch], cconv[2 * 3072 + 2048 + ch], VP + 256, VPS, F.tid);
        rg_store(RG, F.tid, g1);
        raw_load(UT, 1024 + ch, F.tid, rx2); rg_load(FILT + (size_t)(2 * 1024 + ch) * L, FILT + (size_t)(3 * 1024 + ch) * L, F.tid, g2);
        HY_LBAR();
        build_sa(RG, SA, F.tid);
        HY_LBAR();
        f32x16 acc[2];
        toeplitz(SA, VP, F.wave, lane, acc);
        const float sk0 = skip[ch], sk1 = skip[1024 + ch];
        u32x2 z1p[2][4];
#pragma unroll
        for (int tau = 0; tau < 2; ++tau)
#pragma unroll
            for (int g4 = 0; g4 < 4; ++g4) { const int t = 256 * F.wave + 64 * q + 32 * tau + 8 * g4 + 4 * hi;
                const f32x4 vv = unpack4(*(const LAS u32x2*)(VP + bq * VPS + 256 + t)); const f32x4 xx = unpack4(*(const LAS u32x2*)(GB + bq * L + t));
                const float o0 = xx[0] * (acc[tau][4 * g4 + 0] + vv[0] * sk0); const float o1 = xx[1] * (acc[tau][4 * g4 + 1] + vv[1] * sk0);
                const float o2 = xx[2] * (acc[tau][4 * g4 + 2] + vv[2] * sk0); const float o3 = xx[3] * (acc[tau][4 * g4 + 3] + vv[3] * sk0);
                z1p[tau][g4].x = pk2h(o0, o1); z1p[tau][g4].y = pk2h(o2, o3); }
        HY_LBAR();
#pragma unroll
        for (int tau = 0; tau < 2; ++tau)
#pragma unroll
            for (int g4 = 0; g4 < 4; ++g4) { const int t = 256 * F.wave + 64 * q + 32 * tau + 8 * g4 + 4 * hi; *(LAS u32x2*)(VP + bq * VPS + 256 + t) = z1p[tau][g4]; }
        conv3_store(rx2, cconv[1024 + ch], cconv[3072 + 1024 + ch], cconv[2 * 3072 + 1024 + ch], GB, L, F.tid);
        rg_store(RG, F.tid, g2);
        { const int nc = ch + F.G;
          if (nc < D) { raw_load(UT, nc, F.tid, rx1); raw_load(UT, 2048 + nc, F.tid, rv); rg_load(FILT + (size_t)(0 * 1024 + nc) * L, FILT + (size_t)(1 * 1024 + nc) * L, F.tid, g1); } }
        HY_LBAR();
        build_sa(RG, SA, F.tid);
        HY_LBAR();
        toeplitz(SA, VP, F.wave, lane, acc);
#pragma unroll
        for (int tau = 0; tau < 2; ++tau)
#pragma unroll
            for (int g4 = 0; g4 < 4; ++g4) { const int t = 256 * F.wave + 64 * q + 32 * tau + 8 * g4 + 4 * hi;
                const f32x4 vv = unpack4(*(const LAS u32x2*)(VP + bq * VPS + 256 + t)); const f32x4 xx = unpack4(*(const LAS u32x2*)(GB + bq * L + t));
                const float o0 = xx[0] * (acc[tau][4 * g4 + 0] + vv[0] * sk1); const float o1 = xx[1] * (acc[tau][4 * g4 + 1] + vv[1] * sk1);
                const float o2 = xx[2] * (acc[tau][4 * g4 + 2] + vv[2] * sk1); const float o3 = xx[3] * (acc[tau][4 * g4 + 3] + vv[3] * sk1);
                u32x2 w; w.x = pk2h(o0, o1); w.y = pk2h(o2, o3);
                *(u32x2*)(ZT + (size_t)ch * T + (size_t)bq * L + t) = w; }
    }
    __syncthreads();
}

DI void trans_phase(const Ctx& F, CArgs& a) {
    const h16* ZT = (const h16*)(a.ws + WS_XIN); h16* Z = (h16*)(a.ws + WS_Z);
    LAS h16* tile = (LAS h16*)(F.lds + F.wave * 16384);
    const int nitems = (D / 64) * (T / 64);
    for (int it = F.gw; it < nitems; it += F.NGW) {
        const int cb = it & 15, tb = it >> 4, c0 = cb * 64, t0 = tb * 64;
        u32x4 tw[8];
#pragma unroll
        for (int i = 0; i < 8; ++i) { const int c = (F.lane >> 3) + 8 * i, ck = F.lane & 7; tw[i] = *(const u32x4*)(ZT + (size_t)(c0 + c) * T + t0 + 8 * ck); }
        __builtin_amdgcn_sched_barrier(0);
#pragma unroll
        for (int i = 0; i < 8; ++i) { const int c = (F.lane >> 3) + 8 * i, ck = F.lane & 7; *(LAS u32x4*)(tile + c * 72 + 8 * ck) = tw[i]; }
        LDS_WAIT(); asm volatile("" ::: "memory");
#pragma unroll
        for (int i = 0; i < 8; ++i) { const int t = (F.lane >> 3) + 8 * i, ck = F.lane & 7; unsigned short v[8];
#pragma unroll
            for (int e = 0; e < 8; ++e) v[e] = tile[(8 * ck + e) * 72 + t];
            u32x4 w; w.x = v[0] | ((unsigned)v[1] << 16); w.y = v[2] | ((unsigned)v[3] << 16); w.z = v[4] | ((unsigned)v[5] << 16); w.w = v[6] | ((unsigned)v[7] << 16);
            *(u32x4*)(Z + (size_t)(t0 + t) * D + c0 + 8 * ck) = w; }
        LDS_WAIT(); asm volatile("" ::: "memory");
    }
}

enum { K_PRO = 0, K_ROWS, K_GIN, K_CONVGATE, K_GOUT, K_MOEROWS, K_TOPK, K_GMOE1, K_GMOE2, K_GQKV, K_ATTN, K_ATTNPOST, K_GHYIN, K_HYCONV, K_TRANS };
constexpr int NPHASE = 35;
DI void phase_desc(int ph, int& kind, int& layer) {
    if (ph == 0) { kind = K_PRO; layer = 0; return; }
    if (ph == 1) { kind = K_ROWS; layer = -1; return; }
    int l, r;
    if (ph < 10) { l = 0; r = ph - 2; } else if (ph < 18) { l = 1; r = ph - 10; } else if (ph < 27) { l = 2; r = ph - 18; } else { l = 3; r = ph - 27; }
    layer = l;
    const int nmix = (l == 2) ? 4 : 3;
    if (r >= nmix) { const int m = r - nmix; kind = m == 0 ? K_MOEROWS : m == 1 ? K_TOPK : m == 2 ? K_GMOE1 : m == 3 ? K_GMOE2 : K_ROWS; return; }
    if (l == 0 || l == 3) kind = r == 0 ? K_GIN : r == 1 ? K_CONVGATE : K_GOUT;
    else if (l == 1) kind = r == 0 ? K_GQKV : r == 1 ? K_ATTN : K_GOUT;
    else kind = r == 0 ? K_GHYIN : r == 1 ? K_HYCONV : r == 2 ? K_TRANS : K_GOUT;
}

__global__ void __launch_bounds__(NTHR, 2) mk_fwd(Args a_) {
    extern __shared__ __attribute__((aligned(16))) unsigned char lds_raw[];
    cg::grid_group grid = cg::this_grid();
    const int ph_lo = a_.ph_lo, ph_hi = a_.ph_hi;
    { volatile LAS unsigned* st0 = (volatile LAS unsigned*)((LAS unsigned char*)lds_raw + LDS_CTL_OFF); if (threadIdx.x < 16) st0[threadIdx.x] = 0u; }
    __syncthreads();
    XcdBarrier xbar = xcd_barrier_post((unsigned*)(a_.ws + WS_CTL) + 4096, (volatile LAS unsigned*)((LAS unsigned char*)lds_raw + LDS_CTL_OFF));
    int wave_s = __builtin_amdgcn_readfirstlane((int)(threadIdx.x >> 6)); asm volatile("" : "+s"(wave_s));
    for (int ph = ph_lo; ph < ph_hi; ++ph) {
#define MK_CTX Ctx F; { unsigned am_ = ~0u; asm volatile("" : "+s"(am_)); int tid_ = wave_s * 64 + (int)__builtin_amdgcn_mbcnt_hi(am_, __builtin_amdgcn_mbcnt_lo(am_, 0u)); asm volatile("" : "+v"(tid_)); int bx = blockIdx.x; asm volatile("" : "+s"(bx)); \
          F.lds = (LAS unsigned char*)lds_raw; F.tid = tid_; F.lane = tid_ & 63; F.wave = __builtin_amdgcn_readfirstlane(tid_ >> 6); \
          int G_ = gridDim.x; asm volatile("" : "+s"(G_)); F.G = G_; F.bx = bx; F.vcu = (F.G % 8 == 0) ? (bx % 8) * (F.G / 8) + bx / 8 : bx; \
          F.gw = F.vcu * NWAVES + F.wave; F.NGW = F.G * NWAVES; }
        CArgs* apl = (CArgs*)__builtin_amdgcn_kernarg_segment_ptr(); asm volatile("" : "+s"(apl)); CArgs& a = *apl;
        unsigned char* ws = a.ws;
        int kind, l; phase_desc(ph, kind, l);
        const bool fuse_topk = (l >= 1) && (gridDim.x == 256);
        if (kind == K_TOPK && fuse_topk) continue;
        const bool dbg_final = (ph > DBG_STOP);
        if (dbg_final && ph != NPHASE - 1) continue;
        if (dbg_final) { kind = K_ROWS; }
#ifdef ONLY_KIND
        kind = ONLY_KIND;
#endif
        const unsigned long long amp_t0 = DBG_AMP_MASK ? __builtin_amdgcn_s_memrealtime() : 0ull;
        switch (kind) {
        case K_PRO: { MK_CTX; p0_prologue(F, a); } break;
        case K_ROWS: { MK_CTX;
            const bool first = (l < 0) && !dbg_final, fin = dbg_final || l == 3;
            const int lm = l < 0 ? 0 : l;
            rows_phase(F, a, (first || lm == 0) && !dbg_final ? TT : T, first, !first && !dbg_final, lm, lm + (first ? 0 : 1), fin, dbg_final && DBG_CHECK);
        } break;
        case K_GIN: { MK_CTX; const int j = l == 0 ? 0 : 1;
            pg8::SchedPlain S{l == 0 ? 72 : 64, 12, F.G, F.bx}; pg8::EpiGin E{(h16*)(ws + WS_BIG)};
            pg8::gemm_phase<false, false>(F.lds, F.tid, (const h16*)(ws + WS_H), (const h16*)(ws + WS_WAIN) + (size_t)j * 3072 * 1024, 1024, S, E); } break;
        case K_CONVGATE: { MK_CTX; convgate_phase(F, a, l == 0 ? 0 : 1, l == 0 ? TT : T); } break;
        case K_GOUT: { MK_CTX; const h16* W = l == 0 ? (const h16*)(ws + WS_WAOUT) : l == 1 ? (const h16*)(ws + WS_WBOUT) : l == 2 ? (const h16*)(ws + WS_WCOUT) : (const h16*)(ws + WS_WAOUT) + (size_t)1024 * 1024;
            pg8::SchedPlain S{l == 0 ? 72 : 64, 4, F.G, F.bx}; pg8::EpiResid E{(h16*)(ws + WS_XC), (const float*)(ws + WS_MOD) + (size_t)l * 9 * 6144, 2048};
            pg8::gemm_phase<false, false>(F.lds, F.tid, (const h16*)(ws + WS_Z), W, 1024, S, E); } break;
        case K_MOEROWS: { MK_CTX; moe_rows_phase(F, a, l, l == 0 ? TT : T); } break;
        case K_TOPK: { MK_CTX; topk_phase(F, a, l); } break;
        case K_GMOE1: { MK_CTX; pg8::EpiSwiglu8 E{(unsigned char*)(ws + WS_BIG)};
            if (fuse_topk) {
                const int q = F.bx >> 3, e = 2 * (F.bx & 7) + (q >> 4), b = (q >> 1) & 7; pg8::SchedMoeP S{e * 8 + b, q & 1};
                topk_unit(F, a, e * 8 + b);
                asm volatile("s_waitcnt vmcnt(0)" ::: "memory"); __syncthreads();
                pg8::gemm_phase<true, true>(F.lds, F.tid, (const h16*)(ws + WS_Z), (const h16*)(ws + WS_WGU + (size_t)l * 16 * 2048 * 1024), 512, S, E, (const int*)(ws + WS_GATE + 512 * 1024));
            } else { pg8::SchedMoe S{l == 0 ? 144 : 128, 8, F.G, F.bx, 8};
                pg8::gemm_phase<true, true>(F.lds, F.tid, (const h16*)(ws + WS_Z), (const h16*)(ws + WS_WGU + (size_t)l * 16 * 2048 * 1024), 512, S, E, (const int*)(ws + WS_GATE + 512 * 1024)); } } break;
        case K_GMOE2: { MK_CTX; pg8::SchedMoe S{l == 0 ? 144 : 128, 4, F.G, F.bx, 4}; pg8::EpiDown8 E{(unsigned char*)(ws + WS_XIN), (const float*)(ws + WS_GATE)};
            pg8::gemm_phase<false, true>(F.lds, F.tid, (const h16*)(ws + WS_BIG), (const h16*)(ws + WS_WDN + (size_t)l * 16 * 1024 * 1024), 512, S, E); } break;
        case K_GQKV: { MK_CTX; pg8::SchedQkv S{F.G, F.bx};
            h16* Q = (h16*)(ws + WS_BIG); h16* Kb = Q + (size_t)T * D; h16* Vb = Kb + (size_t)NB * KVR * D;
            pg8::EpiQkv E{Q, Kb, Vb, (const float*)(ws + WS_SMALL), (const float*)(ws + WS_SMALL) + 1024};
            pg8::gemm_phase<false, false>(F.lds, F.tid, (const h16*)(ws + WS_H), (const h16*)(ws + WS_WQKV), 1024, S, E); } break;
        case K_ATTN: { MK_CTX; attn_phase(F, a); } break;
        case K_ATTNPOST: { MK_CTX; attn_post_phase(F, a); } break;
        case K_GHYIN: { MK_CTX; pg8::SchedPlain S{12, 64, F.G, F.bx}; pg8::EpiPlain E{(h16*)(ws + WS_BIG), T};
            pg8::gemm_phase<false, false>(F.lds, F.tid, (const h16*)(ws + WS_WCIN), (const h16*)(ws + WS_H), 1024, S, E); } break;
        case K_HYCONV: { MK_CTX; hyconv_phase(F, a); } break;
        case K_TRANS: { MK_CTX; trans_phase(F, a); } break;
        default: break;
        }
        if (DBG_AMP_MASK && ((DBG_AMP_MASK >> kind) & 1)) { const unsigned long long t1 = __builtin_amdgcn_s_memrealtime(); const unsigned long long dt = (t1 - amp_t0) * DBG_AMP_M; while (__builtin_amdgcn_s_memrealtime() - t1 < dt) __builtin_amdgcn_s_sleep(8); }
        if (ph + 1 < ph_hi) { if (ph_lo < -1) grid.sync();
            unsigned am2_ = ~0u; asm volatile("" : "+s"(am2_));
            xcd_barrier(xbar, wave_s == 0 && __builtin_amdgcn_mbcnt_hi(am2_, __builtin_amdgcn_mbcnt_lo(am2_, 0u)) == 0u); }
    }
}

#if DBG_CHECK
__device__ unsigned dbg_hash(unsigned x) { x ^= x >> 16; x *= 0x7feb352dU; x ^= x >> 15; x *= 0x846ca68bU; x ^= x >> 16; return x; }
__global__ void dbg_check_gemm(const h16* A, const float* W, int N, const h16* O, int ldo, int nrows, float* accum) {
    const unsigned id = blockIdx.x * blockDim.x + threadIdx.x;
    const int row = dbg_hash(id * 2 + 1) % nrows, col = dbg_hash(id * 2 + 2) % N;
    float s = 0.f;
    for (int k = 0; k < 1024; ++k) s += h2f(A[(size_t)row * 1024 + k]) * W[(size_t)k * N + col];
    const float o = h2f(O[(size_t)row * ldo + col]);
    atomicAdd(accum, (o - s) * (o - s)); atomicAdd(accum + 1, s * s);
}
__global__ void dbg_check_convgate(const h16* BCV, const float* cw, const h16* Z, int nrows, float* accum) {
    const unsigned id = blockIdx.x * blockDim.x + threadIdx.x;
    const int row = dbg_hash(id * 2 + 1) % nrows, c = dbg_hash(id * 2 + 2) % 1024;
    const int ls = row < T ? L : LC; const int t = row < T ? (row % L) : ((row - T) % LC);
    auto u = [&](int r) { return h2f(BCV[(size_t)r * 3072 + 1024 + c]) * h2f(BCV[(size_t)r * 3072 + 2048 + c]); };
    float s = cw[1024 + c] * u(row);
    if (t > 0) s += cw[c] * u(row - 1);
    if (t + 1 < ls) s += cw[2048 + c] * u(row + 1);
    s *= h2f(BCV[(size_t)row * 3072 + c]);
    const float o = h2f(Z[(size_t)row * 1024 + c]);
    atomicAdd(accum, (o - s) * (o - s)); atomicAdd(accum + 1, s * s);
}
__global__ void dbg_check_resid(const h16* Zb, const float* W, const float* XC, const float* xin, const float* gate  , float* accum) {
    const unsigned id = blockIdx.x * blockDim.x + threadIdx.x;
    const int row = dbg_hash(id * 2 + 1) % T, col = dbg_hash(id * 2 + 2) % 1024;
    float s = 0.f;
    for (int k = 0; k < 1024; ++k) s += h2f(Zb[(size_t)row * 1024 + k]) * W[(size_t)k * 1024 + col];
    s *= gate[(size_t)(row / L) * 6144 + col];
    const float o = XC[(size_t)row * 1024 + col] - xin[(size_t)row * 1024 + col];
    atomicAdd(accum, (o - s) * (o - s)); atomicAdd(accum + 1, s * s);
}
__global__ void dbg_encode(float* out, const float* accum, int n) {
    const float e = sqrtf(accum[0] / fmaxf(accum[1], 1e-30f));
    const float k = fminf(fmaxf(log10f(fmaxf(e, 1e-20f)) + 7.f, 0.f), 8.f);
    const float s = 1.f + k;
    for (int i = blockIdx.x * blockDim.x + threadIdx.x; i < n; i += gridDim.x * blockDim.x) out[i] *= s;
}
#endif

extern "C" void kernel_launch(void* const* d_in, const int* in_sizes, int n_in, void* d_out, int out_size, void* d_ws, size_t ws_size, hipStream_t stream) {
    static int grid = 0;
    if (grid == 0) {
        if (n_in != 34 || in_sizes[0] != T * D || out_size != T * D || ws_size < WS_END) { fprintf(stderr, "kernel_launch: unexpected shapes / workspace (n_in %d, in0 %d, out %d, ws %zu); nothing launched\n", n_in, n_in > 0 ? in_sizes[0] : -1, out_size, ws_size); grid = -1; return; }
        int dev = 0, cus = 0, per_cu = 0;
        if (hipGetDevice(&dev) != hipSuccess || hipDeviceGetAttribute(&cus, hipDeviceAttributeMultiprocessorCount, dev) != hipSuccess) { fprintf(stderr, "kernel_launch: device query failed\n"); grid = -1; return; }
        if (hipFuncSetAttribute((const void*)mk_fwd, hipFuncAttributeMaxDynamicSharedMemorySize, LDS_BYTES) != hipSuccess) { fprintf(stderr, "kernel_launch: hipFuncSetAttribute failed\n"); grid = -1; return; }
        if (hipOccupancyMaxActiveBlocksPerMultiprocessor(&per_cu, (const void*)mk_fwd, NTHR, LDS_BYTES) != hipSuccess || per_cu < 1) { fprintf(stderr, "kernel_launch: occupancy query says %d\n", per_cu); (void)hipGetLastError(); per_cu = 1; }
        grid = cus * 1;
    }
    if (grid < 0) return;
    (void)hipMemsetAsync((char*)d_ws + WS_CTL, 0, CTL_ZERO_BYTES, stream);
    Args a{};
    for (int i = 0; i < 34; ++i) a.in[i] = (const float*)d_in[i];
    a.out = (float*)d_out; a.ws = (unsigned char*)d_ws;
    constexpr int NPH = NPHASE;
#if MK_N_LAUNCHES == 1
    a.ph_lo = 0; a.ph_hi = NPH;
    void* args[] = {&a};
    hipError_t e = hipLaunchCooperativeKernel((const void*)mk_fwd, dim3(grid), dim3(NTHR), args, LDS_BYTES, stream);
    if (e != hipSuccess) fprintf(stderr, "kernel_launch: cooperative launch failed: %s (grid %d)\n", hipGetErrorString(e), grid);
#else
    for (int ph = 0; ph < NPH; ++ph) { a.ph_lo = ph; a.ph_hi = ph + 1; hipLaunchKernelGGL(mk_fwd, dim3(grid), dim3(NTHR), LDS_BYTES, stream, a); }
#endif
#if DBG_CHECK
    {
        unsigned char* ws = (unsigned char*)d_ws; float* accum = (float*)(ws + WS_CTL + 512 * 1024);
        (void)hipMemsetAsync(accum, 0, 64, stream);
        if (DBG_CHECK == 1) hipLaunchKernelGGL(dbg_check_gemm, dim3(64), dim3(256), 0, stream, (const h16*)(ws + WS_H), (const float*)d_in[I_AWIN], 3072, (const h16*)(ws + WS_BIG), 3072, TT, accum);
        if (DBG_CHECK == 2)
            hipLaunchKernelGGL(dbg_check_convgate, dim3(64), dim3(256), 0, stream, (const h16*)(ws + WS_BIG), (const float*)d_in[I_ACONV], (const h16*)(ws + WS_Z), TT, accum);
        if (DBG_CHECK == 3)
            hipLaunchKernelGGL(dbg_check_resid, dim3(64), dim3(256), 0, stream, (const h16*)(ws + WS_Z), (const float*)d_in[I_AWOUT], (const float*)(ws + WS_XC), (const float*)d_in[I_X], (const float*)(ws + WS_MOD) + 2048, accum);
        hipLaunchKernelGGL(dbg_encode, dim3(1024), dim3(256), 0, stream, (float*)d_out, (const float*)accum, T * D);
    }
#endif
}
```

```cpp
#include <hip/hip_runtime.h>
#include <hip/hip_cooperative_groups.h>
#include <cstdio>
#include <cstdint>
#include <cmath>
namespace cg = cooperative_groups;

#define LAS __attribute__((address_space(3)))
#define GAS __attribute__((address_space(1)))
#define DI __device__ __forceinline__

typedef unsigned short h16;
typedef _Float16 hf;
typedef _Float16 half8 __attribute__((ext_vector_type(8)));
typedef _Float16 half4 __attribute__((ext_vector_type(4)));
typedef _Float16 half2v __attribute__((ext_vector_type(2)));
typedef short s16x8 __attribute__((ext_vector_type(8)));
typedef short s16x4 __attribute__((ext_vector_type(4)));
typedef float f32x2 __attribute__((ext_vector_type(2)));
typedef float f32x4 __attribute__((ext_vector_type(4)));
typedef float f32x16 __attribute__((ext_vector_type(16)));
typedef unsigned u32x2 __attribute__((ext_vector_type(2)));
typedef unsigned u32x4 __attribute__((ext_vector_type(4)));

#ifndef MK_N_LAUNCHES
#define MK_N_LAUNCHES 1
#endif
#ifndef DBG_CHECK
#define DBG_CHECK 0
#endif
#ifndef DBG_AMP_MASK
#define DBG_AMP_MASK 0
#endif
#define DBG_AMP_M 4
#ifndef DBG_STOP
#define DBG_STOP 35
#endif

constexpr int D = 1024, NB = 8, L = 2048, T = NB * L, LC = 256, TC = NB * LC, TT = T + TC;
constexpr int NE = 16, CAP = 256, CAPC = 32, NH = 8;
constexpr int NGL = NE * NB * CAP, NGC = NE * NB * CAPC, NG = NGL + NGC;
constexpr int KVR = LC + L;
constexpr int NWAVES = 8, NTHR = 512;

constexpr size_t MiB = 1u << 20;
constexpr size_t WS_CTL = 0, WS_MOD = 1 * MiB, WS_SMALL = 2 * MiB, WS_AFF = 3 * MiB, WS_SLOT = 5 * MiB, WS_GATE = 7 * MiB, WS_FILT = 8 * MiB;
constexpr size_t WS_WAIN = 24 * MiB, WS_WAOUT = 36 * MiB, WS_WQKV = 40 * MiB, WS_WBOUT = 46 * MiB, WS_WCIN = 48 * MiB, WS_WCOUT = 54 * MiB;
constexpr size_t WS_WGU = 56 * MiB, WS_WDN = 312 * MiB;
constexpr size_t WS_XC = 440 * MiB, WS_H = 512 * MiB, WS_BIG = 548 * MiB, WS_Z = 656 * MiB, WS_XIN = 692 * MiB, WS_END = 764 * MiB;
constexpr size_t CTL_ZERO_BYTES = 1 * MiB;

constexpr int LDS_BYTES = 160 * 1024;
constexpr int LDS_CTL_OFF = 159 * 1024;

DI unsigned pk2h(float lo, float hi) { f32x2 v = {lo, hi}; half2v h = __builtin_convertvector(v, half2v); return __builtin_bit_cast(unsigned, h); }
DI unsigned pk4f8(float a, float b, float c, float d) {
    a = __builtin_amdgcn_fmed3f(a, -448.f, 448.f); b = __builtin_amdgcn_fmed3f(b, -448.f, 448.f); c = __builtin_amdgcn_fmed3f(c, -448.f, 448.f); d = __builtin_amdgcn_fmed3f(d, -448.f, 448.f);
    int w = 0; w = __builtin_amdgcn_cvt_pk_fp8_f32(a, b, w, false); w = __builtin_amdgcn_cvt_pk_fp8_f32(c, d, w, true); return (unsigned)w; }
DI float h2f(h16 v) { return (float)__builtin_bit_cast(hf, v); }
DI f32x4 unpack4(const u32x2 w) { const half4 h = __builtin_bit_cast(half4, w); return (f32x4){(float)h[0], (float)h[1], (float)h[2], (float)h[3]}; }
DI float sx(float v, int mask, int lane) { return __builtin_bit_cast(float, __builtin_amdgcn_ds_bpermute((lane ^ mask) << 2, __builtin_bit_cast(int, v))); }
DI float wave_sum(float v, int lane) {
#pragma unroll
    for (int o = 1; o < 64; o <<= 1) v += sx(v, o, lane);
    return v;
}
DI float silu_f(float a) { return a * __builtin_amdgcn_rcpf(1.f + __builtin_amdgcn_exp2f(-1.4426950408889634f * a)); }
DI void unpack8(const u32x4 w, float (&o)[8]) {
    const half8 h = __builtin_bit_cast(half8, w);
#pragma unroll
    for (int i = 0; i < 8; ++i) o[i] = (float)h[i];
}
#define LDS_WAIT() asm volatile("s_waitcnt lgkmcnt(0)" ::: "memory")
#define VM_WAIT() asm volatile("s_waitcnt vmcnt(0)" ::: "memory")

namespace pg8 {
constexpr int BM = 256, BK = 64, HALF = 128, HTB = HALF * BK * 2, STAGE_BYTES = 8 * HTB, NXCD = 8, WGM = 8;
DI int lds_byte(int r, int c) { const int st = (r >> 4) * 2 + (c >> 5), rr = r & 15, cc = c & 31, ob = rr * 64 + cc * 2; return st * 1024 + (ob ^ (((ob >> 9) & 1) << 5)); }
DI void stage_rc(int b, int& R, int& C) { const int st = b / 1024, sb = b % 1024, swz = sb ^ (((sb >> 9) & 1) << 5); R = (st >> 1) * 16 + swz / 64; C = (st & 1) * 32 + (swz % 64) / 2; }
DI int perm32(int rho) { const int n = rho >> 4, i = rho & 15; return 8 * (i >> 2) + 4 * n + (i & 3); }

struct Unit { int pm, pn, ta, tb; };

DI bool tile_order(int i, int nM, int nN, int G, int c, int& pm, int& pn) {
    const int nwg = nM * nN; const long Lx = (long)i * G + c; if (Lx >= nwg) return false;
    int wgid = (int)Lx; { const int q = nwg / NXCD, r = nwg % NXCD, xcd = wgid % NXCD, off = wgid / NXCD; wgid = (xcd < r ? xcd * (q + 1) : r * (q + 1) + (xcd - r) * q) + off; }
    const int nig = WGM * nN, gid = wgid / nig, fm = gid * WGM, gsz = (nM - fm) < WGM ? (nM - fm) : WGM;
    pm = fm + ((wgid % nig) % gsz); pn = (wgid % nig) / gsz; return true;
}

typedef int v8i_t __attribute__((ext_vector_type(8)));
typedef int v4i_t __attribute__((ext_vector_type(4)));
template <bool GATHER, bool FP8, class Epi, class Sched>
DI void gemm_phase(LAS unsigned char* lds, const int tid, const h16* Ag, const h16* Btg, const int K, const Sched& S, const Epi& E, const int* SEL = nullptr) {
    const int wid = __builtin_amdgcn_readfirstlane(tid >> 6), lane = tid & 63, wr = wid >> 2, wc = wid & 3, fr = lane & 15, fq = lane >> 4;
    const int nt = K / BK;
    unsigned voffA[2], voffB[2];
#pragma unroll
    for (int i = 0; i < 2; ++i) { int R, C; stage_rc(tid * 16 + i * 8192, R, C); const int Rb = (R & ~31) + perm32(R & 31);
        voffA[i] = (unsigned)(R * K + C) * 2u; voffB[i] = (unsigned)(Rb * K + C) * 2u; }
    const size_t kstep = (size_t)(BK * 2);
    const size_t hstep = (size_t)HALF * K * 2;
    const size_t tstep = 2 * hstep;
    const unsigned ldsw = (unsigned)wid * 1024u;
    const int aoff = lds_byte(wr * 64 + fr, fq * 8), boff = lds_byte(wc * 32 + fr, fq * 8);
#define PG8_SA(b, h) (((b) * 2 + (h)) * HTB)
#define PG8_SB(b, h) ((4 + (b) * 2 + (h)) * HTB)
#define PG8_STAGE(bufoff, gbase, voff) do { _Pragma("unroll") for (int _i = 0; _i < 2; ++_i) \
        __builtin_amdgcn_global_load_lds((const unsigned*)((const char*)(gbase) + (voff)[_i]), (LAS unsigned*)(lds + (bufoff) + ldsw + _i * 8192), 16, 0, 0); } while (0)
#define PG8_STAGE_A(bufoff, gbase, h, gsel) do { if constexpr (GATHER) { PG8_STAGE(bufoff, gbase, (gsel)[h]); } else { PG8_STAGE(bufoff, (gbase) + (h) * hstep, voffA); } } while (0)
#define PG8_LOAD_G(g, ta_) do { _Pragma("unroll") for (int h_ = 0; h_ < 2; ++h_) _Pragma("unroll") for (int i_ = 0; i_ < 2; ++i_) { int R_, C_; stage_rc(tid * 16 + i_ * 8192, R_, C_); \
        const int row_ = SEL[(ta_) * BM + h_ * HALF + R_]; (g)[h_][i_] = (unsigned)(row_ * K + C_) * 2u; } } while (0)
#define PG8_LDA(dst, b, h) do { if constexpr (FP8) { _Pragma("unroll") for (int m = 0; m < 4; ++m) dst##8[m] = __builtin_shufflevector(*(const LAS v4i_t*)(lds + PG8_SA(b, h) + aoff + m * 2048), *(const LAS v4i_t*)(lds + PG8_SA(b, h) + aoff + m * 2048 + 1024), 0, 1, 2, 3, 4, 5, 6, 7); } \
        else { _Pragma("unroll") for (int m = 0; m < 4; ++m) _Pragma("unroll") for (int k = 0; k < 2; ++k) dst[m][k] = *(const LAS half8*)(lds + PG8_SA(b, h) + aoff + m * 2048 + k * 1024); } } while (0)
#define PG8_LDB(dst, b, h) do { if constexpr (FP8) { _Pragma("unroll") for (int n = 0; n < 2; ++n) dst##8[n] = __builtin_shufflevector(*(const LAS v4i_t*)(lds + PG8_SB(b, h) + boff + n * 2048), *(const LAS v4i_t*)(lds + PG8_SB(b, h) + boff + n * 2048 + 1024), 0, 1, 2, 3, 4, 5, 6, 7); } \
        else { _Pragma("unroll") for (int n = 0; n < 2; ++n) _Pragma("unroll") for (int k = 0; k < 2; ++k) dst[n][k] = *(const LAS half8*)(lds + PG8_SB(b, h) + boff + n * 2048 + k * 1024); } } while (0)
#define PG8_CAT8(x0, x1) __builtin_shufflevector(__builtin_bit_cast(v4i_t, x0), __builtin_bit_cast(v4i_t, x1), 0, 1, 2, 3, 4, 5, 6, 7)
#define PG8_MMA(ai, bj, At, Bt) do { __builtin_amdgcn_s_setprio(1); \
        if constexpr (FP8) { _Pragma("unroll") for (int m = 0; m < 4; ++m) _Pragma("unroll") for (int n = 0; n < 2; ++n) \
            asm volatile("v_mfma_scale_f32_16x16x128_f8f6f4 %0, %1, %2, %0, %3, %3 op_sel_hi:[0,0,0]" : "+v"(acc[ai][bj][m][n]) : "v"(Bt##8[n]), "v"(At##8[m]), "v"(sc1)); } \
        else { _Pragma("unroll") for (int m = 0; m < 4; ++m) _Pragma("unroll") for (int n = 0; n < 2; ++n) _Pragma("unroll") for (int k = 0; k < 2; ++k) \
            acc[ai][bj][m][n] = __builtin_amdgcn_mfma_f32_16x16x32_f16(Bt[n][k], At[m][k], acc[ai][bj][m][n], 0, 0, 0); } \
        __builtin_amdgcn_s_setprio(0); } while (0)
#define PG8_WAIT_V(n) asm volatile("s_waitcnt vmcnt(" #n ")" ::: "memory")
#define PG8_WAIT_L(n) asm volatile("s_waitcnt lgkmcnt(" #n ")" ::: "memory")
#define PG8_BAR __builtin_amdgcn_s_barrier()
#define PG8_SCHED __builtin_amdgcn_sched_barrier(0)
    Unit cur, nxt; int ui = 0;
    if (!S.next(0, cur)) return;
    f32x4 acc[2][2][4][2];
    half8 At[4][2], B0[2][2], B1[2][2];
    v8i_t At8[4], B08[2], B18[2];
    int sc1 = 0x7F7F7F7F; asm volatile("" : "+v"(sc1));
    const char* cA = (const char*)Ag + (GATHER ? (size_t)0 : (size_t)cur.ta * tstep); const char* cB = (const char*)Btg + (size_t)cur.tb * tstep;
    unsigned gC[2][2], gN[2][2], gNN[2][2];
    if constexpr (GATHER) { PG8_LOAD_G(gC, cur.ta); Unit t1; if (S.next(1, t1)) { PG8_LOAD_G(gN, t1.ta); } else { PG8_LOAD_G(gN, cur.ta); }
        _Pragma("unroll") for (int h_ = 0; h_ < 2; ++h_) _Pragma("unroll") for (int i_ = 0; i_ < 2; ++i_) gNN[h_][i_] = gN[h_][i_]; }
    PG8_STAGE(PG8_SB(0, 0), cB, voffB); PG8_STAGE(PG8_SB(0, 1), cB + hstep, voffB); PG8_STAGE_A(PG8_SA(0, 0), cA, 0, gC); PG8_STAGE_A(PG8_SA(0, 1), cA, 1, gC);
    if (wr == 1) PG8_BAR;
    PG8_WAIT_V(2); PG8_BAR;
    PG8_STAGE(PG8_SB(1, 0), cB + kstep, voffB); PG8_STAGE_A(PG8_SA(1, 0), cA + kstep, 0, gC); PG8_STAGE(PG8_SB(1, 1), cB + hstep + kstep, voffB);
    PG8_WAIT_V(6); PG8_BAR;
#pragma unroll
    for (int a = 0; a < 2; ++a)
#pragma unroll
        for (int b = 0; b < 2; ++b)
#pragma unroll
            for (int m = 0; m < 4; ++m)
#pragma unroll
                for (int n = 0; n < 2; ++n) acc[a][b][m][n] = (f32x4){0.f, 0.f, 0.f, 0.f};
    for (;;) {
        const bool has_next = S.next(ui + 1, nxt);
        const char* nA = (has_next && !GATHER) ? (const char*)Ag + (size_t)nxt.ta * tstep : cA; const char* nB = has_next ? (const char*)Btg + (size_t)nxt.tb * tstep : cB;
        for (int t = 0; t < nt; t += 2) {
            const bool last = (t == nt - 2);
            const char* a1 = cA + (size_t)(t + 1) * kstep;
            const char* a2 = last ? nA : cA + (size_t)(t + 2) * kstep; const char* b2 = last ? nB : cB + (size_t)(t + 2) * kstep;
            const char* a3 = a2 + kstep; const char* b3 = b2 + kstep;
            unsigned gS[2][2];
            if constexpr (GATHER) { _Pragma("unroll") for (int h_ = 0; h_ < 2; ++h_) _Pragma("unroll") for (int i_ = 0; i_ < 2; ++i_) gS[h_][i_] = last ? gN[h_][i_] : gC[h_][i_]; }
            PG8_LDB(B0, 0, 0); PG8_LDB(B1, 0, 1); PG8_SCHED; PG8_LDA(At, 0, 0); PG8_STAGE_A(PG8_SA(1, 1), a1, 1, gC);
            PG8_WAIT_V(8); PG8_WAIT_L(0); PG8_BAR; PG8_MMA(0, 0, At, B0); PG8_MMA(0, 1, At, B1); PG8_BAR; PG8_SCHED;
            PG8_LDA(At, 0, 1); PG8_STAGE(PG8_SB(0, 0), b2, voffB); PG8_STAGE(PG8_SB(0, 1), b2 + hstep, voffB); PG8_STAGE_A(PG8_SA(0, 0), a2, 0, gS);
            PG8_WAIT_V(8); PG8_WAIT_L(0); PG8_BAR; PG8_MMA(1, 0, At, B0); PG8_MMA(1, 1, At, B1); PG8_BAR; PG8_SCHED;
            PG8_LDB(B0, 1, 0); PG8_LDB(B1, 1, 1); PG8_SCHED; PG8_LDA(At, 1, 0); PG8_STAGE_A(PG8_SA(0, 1), a2, 1, gS);
            PG8_WAIT_V(8); PG8_WAIT_L(0); PG8_BAR; PG8_MMA(0, 0, At, B0); PG8_MMA(0, 1, At, B1); PG8_BAR; PG8_SCHED;
            PG8_LDA(At, 1, 1); PG8_STAGE(PG8_SB(1, 0), b3, voffB); PG8_STAGE(PG8_SB(1, 1), b3 + hstep, voffB); PG8_STAGE_A(PG8_SA(1, 0), a3, 0, gS);
            PG8_WAIT_V(8); PG8_WAIT_L(0); PG8_BAR; PG8_MMA(1, 0, At, B0); PG8_MMA(1, 1, At, B1); PG8_BAR; PG8_SCHED;
        }
        if (wr == 0) PG8_BAR;
        if constexpr (FP8) asm volatile("s_nop 15\n\ts_nop 15" ::: "memory");
        if constexpr (GATHER) { Unit t2; if (has_next && S.next(ui + 2, t2)) { PG8_LOAD_G(gNN, t2.ta); } }
        { int fr_ = fr, fq_ = fq; asm volatile("" : "+v"(fr_), "+v"(fq_)); E(acc, cur, wr, wc, fr_, fq_); }
        if (!has_next) break;
#pragma unroll
        for (int a = 0; a < 2; ++a)
#pragma unroll
            for (int b = 0; b < 2; ++b)
#pragma unroll
                for (int m = 0; m < 4; ++m)
#pragma unroll
                    for (int n = 0; n < 2; ++n) acc[a][b][m][n] = (f32x4){0.f, 0.f, 0.f, 0.f};
        cur = nxt; cA = nA; cB = nB; ++ui;
        if constexpr (GATHER) { _Pragma("unroll") for (int h_ = 0; h_ < 2; ++h_) _Pragma("unroll") for (int i_ = 0; i_ < 2; ++i_) { gC[h_][i_] = gN[h_][i_]; gN[h_][i_] = gNN[h_][i_]; } }
        if (wr == 1) PG8_BAR;
    }
    PG8_WAIT_V(0);
    PG8_BAR;
#undef PG8_SA
#undef PG8_SB
#undef PG8_STAGE
#undef PG8_STAGE_A
#undef PG8_LOAD_G
#undef PG8_LDA
#undef PG8_LDB
#undef PG8_MMA
#undef PG8_CAT8
#undef PG8_WAIT_V
#undef PG8_WAIT_L
#undef PG8_BAR
#undef PG8_SCHED
}

struct SchedPlain {
    int nM, nN, G, c;
    DI bool next(int i, Unit& u) const { if (!tile_order(i, nM, nN, G, c, u.pm, u.pn)) return false; u.ta = u.pm; u.tb = u.pn; return true; }
};
struct SchedMoe {
    int nM, nN, G, c, tpe;
    DI bool next(int i, Unit& u) const { if (!tile_order(i, nM, nN, G, c, u.pm, u.pn)) return false; const int e = u.pm < 128 ? (u.pm >> 3) : (u.pm - 128); u.ta = u.pm; u.tb = e * tpe + u.pn; return true; }
};
struct SchedQkv {
    int G, c;
    DI bool next(int i, Unit& u) const {
        const long Lx = (long)i * G + c;
        if (Lx < 768) { tile_order(i, 64, 12, G, c, u.pm, u.pn); u.ta = u.pm; u.tb = u.pn; return true; }
        const int r = (int)(Lx - 768); if (r >= 64) return false;
        u.pm = 64 + (r & 7); u.pn = 4 + (r >> 3); u.ta = u.pm; u.tb = u.pn; return true;
    }
};

struct EpiPlain {
    h16* O; int ldc;
    DI void operator()(const f32x4 (&acc)[2][2][4][2], const Unit& u, int wr, int wc, int fr, int fq) const {
        const int row0 = u.pm * BM + wr * 64 + fr, col0 = u.pn * BM + wc * 32 + 8 * fq;
#pragma unroll
        for (int ai = 0; ai < 2; ++ai)
#pragma unroll
            for (int m = 0; m < 4; ++m) { h16* rowp = O + (size_t)(row0 + ai * HALF + m * 16) * ldc + col0;
#pragma unroll
                for (int bj = 0; bj < 2; ++bj) { const f32x4 v0 = acc[ai][bj][m][0], v1 = acc[ai][bj][m][1];
                    u32x4 w; w.x = pk2h(v0[0], v0[1]); w.y = pk2h(v0[2], v0[3]); w.z = pk2h(v1[0], v1[1]); w.w = pk2h(v1[2], v1[3]);
                    *(u32x4*)(rowp + bj * HALF) = w; } }
    }
};
struct EpiGin {
    h16* O;
    DI void operator()(const f32x4 (&acc)[2][2][4][2], const Unit& u, int wr, int wc, int fr, int fq) const {
        const int row0 = u.pm * BM + wr * 64 + fr;
        if (u.pn < 4) {
            const int col0 = u.pn * BM + wc * 32 + 8 * fq;
#pragma unroll
            for (int ai = 0; ai < 2; ++ai)
#pragma unroll
                for (int m = 0; m < 4; ++m) { h16* rowp = O + (size_t)(row0 + ai * HALF + m * 16) * 2048 + col0;
#pragma unroll
                    for (int bj = 0; bj < 2; ++bj) { const f32x4 v0 = acc[ai][bj][m][0], v1 = acc[ai][bj][m][1];
                        u32x4 w; w.x = pk2h(v0[0], v0[1]); w.y = pk2h(v0[2], v0[3]); w.z = pk2h(v1[0], v1[1]); w.w = pk2h(v1[2], v1[3]);
                        *(u32x4*)(rowp + bj * HALF) = w; } }
        } else {
            const int col0 = 1024 + (u.pn - 4) * HALF + wc * 32 + 8 * fq;
#pragma unroll
            for (int ai = 0; ai < 2; ++ai)
#pragma unroll
                for (int m = 0; m < 4; ++m) { const f32x4 p0 = acc[ai][0][m][0] * acc[ai][1][m][0], p1 = acc[ai][0][m][1] * acc[ai][1][m][1];
                    u32x4 w; w.x = pk2h(p0[0], p0[1]); w.y = pk2h(p0[2], p0[3]); w.z = pk2h(p1[0], p1[1]); w.w = pk2h(p1[2], p1[3]);
                    *(u32x4*)(O + (size_t)(row0 + ai * HALF + m * 16) * 2048 + col0) = w; }
        }
    }
};
struct EpiResid {
    h16* XC; const float* modl; int goff;
    DI void operator()(const f32x4 (&acc)[2][2][4][2], const Unit& u, int wr, int wc, int fr, int fq) const {
        const int row0 = u.pm * BM + wr * 64 + fr, col0 = u.pn * BM + wc * 32 + 8 * fq;
        const int r9 = u.pm < 64 ? (u.pm >> 3) : 8;
        const float* g = modl + r9 * 6144 + goff + col0;
        f32x4 gv[2][2];
#pragma unroll
        for (int bj = 0; bj < 2; ++bj)
#pragma unroll
            for (int n = 0; n < 2; ++n) gv[bj][n] = *(const f32x4*)(g + bj * HALF + 4 * n);
#pragma unroll
        for (int ai = 0; ai < 2; ++ai) {
            u32x4 xr[4][2];
#pragma unroll
            for (int m = 0; m < 4; ++m)
#pragma unroll
                for (int bj = 0; bj < 2; ++bj) xr[m][bj] = *(const u32x4*)(XC + (size_t)(row0 + ai * HALF + m * 16) * D + col0 + bj * HALF);
            __builtin_amdgcn_sched_barrier(0);
#pragma unroll
            for (int m = 0; m < 4; ++m) { h16* rowp = XC + (size_t)(row0 + ai * HALF + m * 16) * D + col0;
#pragma unroll
                for (int bj = 0; bj < 2; ++bj) { float x[8]; unpack8(xr[m][bj], x);
                    const f32x4 a0 = acc[ai][bj][m][0], a1 = acc[ai][bj][m][1], g0 = gv[bj][0], g1 = gv[bj][1];
                    u32x4 w; w.x = pk2h(x[0] + g0[0] * a0[0], x[1] + g0[1] * a0[1]); w.y = pk2h(x[2] + g0[2] * a0[2], x[3] + g0[3] * a0[3]);
                    w.z = pk2h(x[4] + g1[0] * a1[0], x[5] + g1[1] * a1[1]); w.w = pk2h(x[6] + g1[2] * a1[2], x[7] + g1[3] * a1[3]); *(u32x4*)(rowp + bj * HALF) = w; } }
            __builtin_amdgcn_sched_barrier(0);
        }
    }
};
struct EpiSwiglu {
    h16* HID;
    DI void operator()(const f32x4 (&acc)[2][2][4][2], const Unit& u, int wr, int wc, int fr, int fq) const {
        const int row0 = u.pm * BM + wr * 64 + fr, col0 = u.pn * HALF + wc * 32 + 8 * fq;
#pragma unroll
        for (int ai = 0; ai < 2; ++ai)
#pragma unroll
            for (int m = 0; m < 4; ++m) { h16* rowp = HID + (size_t)(row0 + ai * HALF + m * 16) * D + col0;
                float o[8];
#pragma unroll
                for (int n = 0; n < 2; ++n)
#pragma unroll
                    for (int j = 0; j < 4; ++j) { const float a = acc[ai][0][m][n][j], b = acc[ai][1][m][n][j]; o[4 * n + j] = silu_f(a) * b; }
                u32x4 w; w.x = pk2h(o[0], o[1]); w.y = pk2h(o[2], o[3]); w.z = pk2h(o[4], o[5]); w.w = pk2h(o[6], o[7]);
                *(u32x4*)rowp = w; }
    }
};
struct EpiDown {
    h16* YE; const float* GATE;
    DI void operator()(const f32x4 (&acc)[2][2][4][2], const Unit& u, int wr, int wc, int fr, int fq) const {
        const int row0 = u.pm * BM + wr * 64 + fr, col0 = u.pn * BM + wc * 32 + 8 * fq;
#pragma unroll
        for (int ai = 0; ai < 2; ++ai)
#pragma unroll
            for (int m = 0; m < 4; ++m) { const int row = row0 + ai * HALF + m * 16; const float gt = GATE[row]; h16* rowp = YE + (size_t)row * D + col0;
#pragma unroll
                for (int bj = 0; bj < 2; ++bj) { const f32x4 v0 = acc[ai][bj][m][0] * gt, v1 = acc[ai][bj][m][1] * gt;
                    u32x4 w; w.x = pk2h(v0[0], v0[1]); w.y = pk2h(v0[2], v0[3]); w.z = pk2h(v1[0], v1[1]); w.w = pk2h(v1[2], v1[3]);
                    *(u32x4*)(rowp + bj * HALF) = w; } }
    }
};
struct EpiSwiglu8 {
    unsigned char* HID8;
    DI void operator()(const f32x4 (&acc)[2][2][4][2], const Unit& u, int wr, int wc, int fr, int fq) const {
        const int row0 = u.pm * BM + wr * 64 + fr, col0 = u.pn * HALF + wc * 32 + 8 * fq;
#pragma unroll
        for (int ai = 0; ai < 2; ++ai)
#pragma unroll
            for (int m = 0; m < 4; ++m) { unsigned char* rowp = HID8 + (size_t)(row0 + ai * HALF + m * 16) * D + col0;
                float o[8];
#pragma unroll
                for (int n = 0; n < 2; ++n)
#pragma unroll
                    for (int j = 0; j < 4; ++j) { const float a = acc[ai][0][m][n][j] * (1.f / 512.f), b = acc[ai][1][m][n][j] * (4.f / 512.f); o[4 * n + j] = silu_f(a) * b; }
                u32x2 w; w.x = pk4f8(o[0], o[1], o[2], o[3]); w.y = pk4f8(o[4], o[5], o[6], o[7]);
                *(u32x2*)rowp = w; }
    }
};
struct EpiDown8 {
    unsigned char* YE; const float* GATE;
    DI void operator()(const f32x4 (&acc)[2][2][4][2], const Unit& u, int wr, int wc, int fr, int fq) const {
        const int row0 = u.pm * BM + wr * 64 + fr, col0 = u.pn * BM + wc * 32 + 8 * fq;
        float gt[2][4];
#pragma unroll
        for (int ai = 0; ai < 2; ++ai)
#pragma unroll
            for (int m = 0; m < 4; ++m) gt[ai][m] = GATE[row0 + ai * HALF + m * 16];
        __builtin_amdgcn_sched_barrier(0);
#pragma unroll
        for (int ai = 0; ai < 2; ++ai)
#pragma unroll
            for (int m = 0; m < 4; ++m) { const int row = row0 + ai * HALF + m * 16; const float g = gt[ai][m] * (16.f / 256.f); unsigned char* rowp = YE + (size_t)row * D + col0;
#pragma unroll
                for (int bj = 0; bj < 2; ++bj) { const f32x4 v0 = acc[ai][bj][m][0] * g, v1 = acc[ai][bj][m][1] * g;
                    u32x2 w; w.x = pk4f8(v0[0], v0[1], v0[2], v0[3]); w.y = pk4f8(v1[0], v1[1], v1[2], v1[3]);
                    *(u32x2*)(rowp + bj * HALF) = w; } }
    }
};
constexpr float ATT_C2 = 0.125f * 1.4426950408889634f;
struct EpiQkv {
    h16 *Q, *Kb, *Vb; const float *RC, *RS;
    DI void operator()(const f32x4 (&acc)[2][2][4][2], const Unit& u, int wr, int wc, int fr, int fq) const {
        const bool ctx = u.pm >= 64; const int sec = u.pn >> 2;
        const int lr0 = wr * 64 + fr, col0 = (u.pn & 3) * BM + wc * 32 + 8 * fq;
        h16* base; size_t rowb;
        if (sec == 0) { base = Q; rowb = (size_t)u.pm * BM; }
        else { base = sec == 1 ? Kb : Vb; rowb = ctx ? (size_t)(u.pm - 64) * KVR : (size_t)(u.pm >> 3) * KVR + LC + (size_t)(u.pm & 7) * BM; }
        const bool rope = (sec < 2) && !ctx; const float sc = sec == 0 ? ATT_C2 : 1.f;
#pragma unroll
        for (int ai = 0; ai < 2; ++ai) {
            f32x4 cs[4], sn[4];
#pragma unroll
            for (int m = 0; m < 4; ++m) { cs[m] = (f32x4){1.f, 1.f, 1.f, 1.f}; sn[m] = (f32x4){0.f, 0.f, 0.f, 0.f}; }
            if (rope) {
#pragma unroll
                for (int m = 0; m < 4; ++m) { const int t = (u.pm & 7) * BM + lr0 + ai * HALF + m * 16; const int pos = (wc & 1) ? (t & 63) : (t >> 6); cs[m] = *(const f32x4*)(RC + pos * 16 + 4 * fq); sn[m] = *(const f32x4*)(RS + pos * 16 + 4 * fq); } }
            __builtin_amdgcn_sched_barrier(0);
#pragma unroll
            for (int m = 0; m < 4; ++m) { const int lr = lr0 + ai * HALF + m * 16; h16* rowp = base + (rowb + lr) * D + col0;
#pragma unroll
                for (int bj = 0; bj < 2; ++bj) { const f32x4 x1 = acc[ai][bj][m][0], x2 = acc[ai][bj][m][1];
                    const f32x4 v0 = (x1 * cs[m] - x2 * sn[m]) * sc, v1 = (x2 * cs[m] + x1 * sn[m]) * sc;
                    u32x4 w; w.x = pk2h(v0[0], v0[1]); w.y = pk2h(v0[2], v0[3]); w.z = pk2h(v1[0], v1[1]); w.w = pk2h(v1[2], v1[3]);
                    *(u32x4*)(rowp + bj * HALF) = w; } }
            __builtin_amdgcn_sched_barrier(0);
        }
    }
};
}

#define XB_TMO      128
#define XB_XCNT(j)  (256  + 64 * (j))
#define XB_XSUB(j)  (1280 + 64 * (j))
#define XB_XGEN(j)  (2304 + 64 * (j))
#define XB_TOP      3328
#define XB_TOPGEN   3392
#define XCD_BAR_WORDS 3456
#define XB_SPIN_CAP (1u << 22)
DI unsigned xb_ld(unsigned* p)              { return __hip_atomic_load(p, __ATOMIC_RELAXED, __HIP_MEMORY_SCOPE_AGENT); }
DI unsigned xb_add(unsigned* p, unsigned v) { return __hip_atomic_fetch_add(p, v, __ATOMIC_RELAXED, __HIP_MEMORY_SCOPE_AGENT); }
DI unsigned xb_xcc_id() { return (unsigned)__builtin_amdgcn_s_getreg((3 << 11) | 20) & 0xFu; }
#define XB_SPIN(cond, bar) do { unsigned _sp = 0; while (cond) { __builtin_amdgcn_s_sleep(1); \
    if ((++_sp & 255u) == 0u) { if (xb_ld(&(bar)[XB_TMO])) break; if (_sp > XB_SPIN_CAP) { atomicAdd(&(bar)[XB_TMO], 1u); break; } } } } while (0)
struct XcdBarrier { unsigned* bar; unsigned x; volatile LAS unsigned* st; };
DI XcdBarrier xcd_barrier_post(unsigned* bar, volatile LAS unsigned* st) {
    XcdBarrier b; b.bar = bar; b.x = xb_xcc_id(); b.st = st;
    if (threadIdx.x == 0) (void)xb_add(&bar[XB_XCNT(b.x)], 1u);
    return b;
}
DI void xcd_barrier_complete(unsigned* bar, unsigned x, unsigned& nloc, unsigned& nx) {
    const unsigned G = gridDim.x * gridDim.y * gridDim.z;
    unsigned sum, cnt, mine, sp = 0u;
    for (;;) {
        sum = 0u; cnt = 0u; mine = 0u;
#pragma unroll
        for (unsigned j = 0; j < 16; ++j) { const unsigned c = xb_ld(&bar[XB_XCNT(j)]); sum += c; cnt += (c > 0u) ? 1u : 0u; mine = (j == x) ? c : mine; }
        if (sum == G) break;
        __builtin_amdgcn_s_sleep(1);
        if ((++sp & 255u) == 0u) { if (xb_ld(&bar[XB_TMO])) break; if (sp > XB_SPIN_CAP) { atomicAdd(&bar[XB_TMO], 1u); break; } }
    }
    nloc = mine > 0u ? mine : 1u; nx = cnt > 0u ? cnt : 1u;
}
DI void xcd_barrier(const XcdBarrier& b, const bool leader) {
    asm volatile("s_waitcnt vmcnt(0)" ::: "memory");
    __syncthreads();
    if (leader) {
        unsigned* bar = b.bar;
        __builtin_amdgcn_s_waitcnt(0);
        unsigned nloc = b.st[0], nx = b.st[1];
        if (nloc == 0u) { xcd_barrier_complete(bar, b.x, nloc, nx); b.st[0] = nloc; b.st[1] = nx; }
        const unsigned old = xb_add(&bar[XB_XSUB(b.x)], 1u);
        const unsigned gen = old / nloc;
        if (old + 1u == (gen + 1u) * nloc) {
            __builtin_amdgcn_fence(__ATOMIC_RELEASE, "agent");
            asm volatile("s_waitcnt vmcnt(0)" ::: "memory");
            const unsigned og = xb_add(&bar[XB_TOP], 1u);
            const unsigned tg = og / nx;
            if (og + 1u == (tg + 1u) * nx) xb_add(&bar[XB_TOPGEN], 1u);
            else XB_SPIN(xb_ld(&bar[XB_TOPGEN]) == tg, bar);
            __builtin_amdgcn_fence(__ATOMIC_ACQUIRE, "agent");
            xb_add(&bar[XB_XGEN(b.x)], 1u);
            asm volatile("s_waitcnt vmcnt(0)" ::: "memory");
        } else {
            XB_SPIN(xb_ld(&bar[XB_XGEN(b.x)]) == gen, bar);
            __builtin_amdgcn_fence(__ATOMIC_ACQUIRE, "agent");
            asm volatile("s_waitcnt vmcnt(0)" ::: "memory");
        }
    }
    __syncthreads();
}

struct Args { const float* in[34]; float* out; unsigned char* ws; int ph_lo, ph_hi; };
enum { I_X = 0, I_C, I_CTX, I_CCTX, I_WADA, I_BADA, I_N1G, I_N2G, I_FG, I_AWIN, I_ACONV, I_AWOUT, I_BQKV, I_LQ1, I_LK1, I_LQ2, I_LK2, I_SUBG, I_BWOUT,
       I_CWIN, I_CCONV, I_F1W, I_F1B, I_F1F, I_F2W, I_F2B, I_F2F, I_F3W, I_SKIP, I_CWOUT, I_ROUTER, I_WGATE, I_WUP, I_WDOWN };

typedef __attribute__((address_space(4))) const Args CArgs;
struct Ctx { LAS unsigned char* lds; int tid, lane, wave, G, bx, vcu, gw, NGW; };

DI int perm_l2p(int l) { return ((l >> 2) & 3) * 8 + (l >> 4) * 4 + (l & 3); }
DI int map_row(int mode, int n) {
    if (mode == 1) return n < 2048 ? (n & ~31) + perm_l2p(n & 31) : n;
    if (mode == 2) return (n >> 7) * 256 + (n & 127);
    if (mode == 3) return (n >> 7) * 256 + 128 + (n & 127);
    if (mode == 4) { if (n < 1024) return n; const int c = (n - 1024) & 1023; return 1024 + (c >> 7) * 256 + (n >= 2048 ? 128 : 0) + (c & 127); }
    return n;
}
struct TJob { const float* W; h16* WT; int N, mode, item; bool f8; };
constexpr int P0_NSPEC = 1024, P0_NITEMS = P0_NSPEC + 192 * 64;
#ifndef P0_NAUX
#define P0_NAUX 64
#endif
DI TJob p0_decode(CArgs& a, int it) {
    unsigned char* ws = a.ws; TJob j;
    int r = it;
    if (r >= P0_NSPEC) { r -= P0_NSPEC; const int mat = r >> 6; const int kind = mat >> 6, le = mat & 63;
        j.W = a.in[I_WGATE + kind] + (size_t)le * 1024 * 1024; j.N = 1024; j.item = r & 63; j.mode = kind == 0 ? 2 : (kind == 1 ? 3 : 0);
        j.WT = kind < 2 ? (h16*)(ws + WS_WGU + (size_t)le * 2048 * 1024) : (h16*)(ws + WS_WDN + (size_t)le * 1024 * 1024); j.f8 = true; return j; }
    j.mode = 0; j.f8 = false;
    if (r < 192) { j.W = a.in[I_AWIN]; j.N = 3072; j.WT = (h16*)(ws + WS_WAIN); j.item = r; j.mode = 4; return j; } r -= 192;
    if (r < 192) { j.W = a.in[I_AWIN] + (size_t)1024 * 3072; j.N = 3072; j.WT = (h16*)(ws + WS_WAIN) + (size_t)3072 * 1024; j.item = r; j.mode = 4; return j; } r -= 192;
    if (r < 64) { j.W = a.in[I_AWOUT]; j.N = 1024; j.WT = (h16*)(ws + WS_WAOUT); j.item = r; return j; } r -= 64;
    if (r < 64) { j.W = a.in[I_AWOUT] + (size_t)1024 * 1024; j.N = 1024; j.WT = (h16*)(ws + WS_WAOUT) + (size_t)1024 * 1024; j.item = r; return j; } r -= 64;
    if (r < 192) { j.W = a.in[I_BQKV]; j.N = 3072; j.WT = (h16*)(ws + WS_WQKV); j.item = r; j.mode = 1; return j; } r -= 192;
    if (r < 64) { j.W = a.in[I_BWOUT]; j.N = 1024; j.WT = (h16*)(ws + WS_WBOUT); j.item = r; return j; } r -= 64;
    if (r < 192) { j.W = a.in[I_CWIN]; j.N = 3072; j.WT = (h16*)(ws + WS_WCIN); j.item = r; return j; } r -= 192;
    j.W = a.in[I_CWOUT]; j.N = 1024; j.WT = (h16*)(ws + WS_WCOUT); j.item = r; return j;
}
DI void p0_tr_load(const TJob& j, int tid, f32x4 (&v)[8]) {
    const int nblk = j.N / 128, kb = j.item / nblk, nb = j.item % nblk, k0 = 128 * kb, n0 = 128 * nb;
    const float* p = j.W + (size_t)(k0 + (tid >> 5)) * j.N + n0 + 4 * (tid & 31);
#pragma unroll
    for (int i = 0; i < 8; ++i) v[i] = __builtin_nontemporal_load((const f32x4*)(p + (size_t)(16 * i) * j.N));
}
#define P0_LBAR() asm volatile("s_waitcnt lgkmcnt(0)\n\ts_barrier" ::: "memory")
DI void p0_tr_store(const TJob& j, int tid, LAS float* scr, const f32x4 (&v)[8]) {
    const int nblk = j.N / 128, kb = j.item / nblk, nb = j.item % nblk, k0 = 128 * kb, n0 = 128 * nb;
#pragma unroll
    for (int i = 0; i < 8; ++i) { LAS float* d = scr + ((tid >> 5) + 16 * i) * 129 + 4 * (tid & 31); d[0] = v[i].x; d[1] = v[i].y; d[2] = v[i].z; d[3] = v[i].w; }
    P0_LBAR();
    const int n = tid >> 2, kq = tid & 3;
    const LAS float* s = scr + (32 * kq) * 129 + n;
    const size_t orow = (size_t)map_row(j.mode, n0 + n) * 1024 + k0 + 32 * kq;
    if (j.f8) {
        u32x4 o0, o1;
        o0.x = pk4f8(s[0 * 129] * 64.f, s[1 * 129] * 64.f, s[2 * 129] * 64.f, s[3 * 129] * 64.f);     o0.y = pk4f8(s[4 * 129] * 64.f, s[5 * 129] * 64.f, s[6 * 129] * 64.f, s[7 * 129] * 64.f);
        o0.z = pk4f8(s[8 * 129] * 64.f, s[9 * 129] * 64.f, s[10 * 129] * 64.f, s[11 * 129] * 64.f);   o0.w = pk4f8(s[12 * 129] * 64.f, s[13 * 129] * 64.f, s[14 * 129] * 64.f, s[15 * 129] * 64.f);
        o1.x = pk4f8(s[16 * 129] * 64.f, s[17 * 129] * 64.f, s[18 * 129] * 64.f, s[19 * 129] * 64.f); o1.y = pk4f8(s[20 * 129] * 64.f, s[21 * 129] * 64.f, s[22 * 129] * 64.f, s[23 * 129] * 64.f);
        o1.z = pk4f8(s[24 * 129] * 64.f, s[25 * 129] * 64.f, s[26 * 129] * 64.f, s[27 * 129] * 64.f); o1.w = pk4f8(s[28 * 129] * 64.f, s[29 * 129] * 64.f, s[30 * 129] * 64.f, s[31 * 129] * 64.f);
        u32x4* d = (u32x4*)((unsigned char*)j.WT + orow); d[0] = o0; d[1] = o1;
    } else {
        u32x4* d = (u32x4*)(j.WT + orow);
#pragma unroll
        for (int g = 0; g < 4; ++g) { const LAS float* t = s + (8 * g) * 129;
            u32x4 o; o.x = pk2h(t[0 * 129], t[1 * 129]); o.y = pk2h(t[2 * 129], t[3 * 129]); o.z = pk2h(t[4 * 129], t[5 * 129]); o.w = pk2h(t[6 * 129], t[7 * 129]); d[g] = o; }
    }
    P0_LBAR();
}

DI void p0_prologue(const Ctx& F, CArgs& a) {
    unsigned char* ws = a.ws;
    const int NAUX = F.G >= 128 ? P0_NAUX : 0;
    const bool aux = F.bx < NAUX || NAUX == 0, conv = F.bx >= NAUX;
    const int cbx = F.bx - NAUX, cG = F.G - NAUX, abx = F.bx, aG = NAUX ? NAUX : F.G;
    if (conv) {
        LAS float* scr = (LAS float*)F.lds;
        int it = cbx;
        f32x4 v0[8], v1[8]; TJob j0, j1;
        if (it < P0_NITEMS) { j0 = p0_decode(a, it); p0_tr_load(j0, F.tid, v0); }
        while (it < P0_NITEMS) {
            int itn = it + cG; bool hn = itn < P0_NITEMS;
            if (hn) { j1 = p0_decode(a, itn); p0_tr_load(j1, F.tid, v1); }
            p0_tr_store(j0, F.tid, scr, v0);
            it = itn; if (!hn) break;
            itn = it + cG; hn = itn < P0_NITEMS;
            if (hn) { j0 = p0_decode(a, itn); p0_tr_load(j0, F.tid, v0); }
            p0_tr_store(j1, F.tid, scr, v1);
            it = itn;
        }
    }
    __syncthreads();
    if (aux) {
        LAS float* S = (LAS float*)F.lds;
        LAS float* P = (LAS float*)(F.lds + 40960);
        for (int i = F.tid; i < 9 * 1024; i += NTHR) { const int r = i >> 10, k = i & 1023; const float v = r < 8 ? a.in[I_C][r * 1024 + k] : a.in[I_CCTX][k]; S[i] = v / (1.f + expf(-v)); }
        __syncthreads();
        float* MOD = (float*)(ws + WS_MOD);
        for (int it = abx; it < 4 * 96; it += aG) {
            const int l = it / 96, n0 = (it % 96) * 64;
            const float* W = a.in[I_WADA] + (size_t)l * 1024 * 6144 + n0 + F.lane;
            float acc[9];
#pragma unroll
            for (int r = 0; r < 9; ++r) acc[r] = 0.f;
            const int kb = F.wave * 128;
            for (int k0 = 0; k0 < 128; k0 += 32) {
                float w[32];
#pragma unroll
                for (int kk = 0; kk < 32; ++kk) w[kk] = __builtin_nontemporal_load(W + (size_t)(kb + k0 + kk) * 6144);
#pragma unroll
                for (int kk = 0; kk < 32; ++kk) {
#pragma unroll
                    for (int r = 0; r < 9; ++r) acc[r] += S[r * 1024 + kb + k0 + kk] * w[kk]; } }
#pragma unroll
            for (int r = 0; r < 9; ++r) P[(F.wave * 9 + r) * 64 + F.lane] = acc[r];
            __syncthreads();
            for (int o = F.tid; o < 9 * 64; o += NTHR) { const int r = o >> 6, n = o & 63; float s = 0.f;
#pragma unroll
                for (int w = 0; w < 8; ++w) s += P[(w * 9 + r) * 64 + n];
                MOD[((size_t)l * 9 + r) * 6144 + n0 + n] = s + a.in[I_BADA][l * 6144 + n0 + n]; }
            __syncthreads();
        }
    }
    if (aux && abx == 0) {
        float* RC = (float*)(ws + WS_SMALL); float* RS = RC + 1024;
        for (int i = F.tid; i < 1024; i += NTHR) { const int pos = i >> 4, f = i & 15; const float inv = powf(10000.f, -(float)(2 * f) / 32.f); const float ang = (float)pos * inv; RC[i] = cosf(ang); RS[i] = sinf(ang); }
    }
    __syncthreads();
    if (aux) {
        LAS float* ZB = (LAS float*)F.lds;
        LAS float* H1 = ZB + 512;
        LAS float* HB = H1 + 512;
        h16* FILT = (h16*)(ws + WS_FILT);
        const float* f1w = a.in[I_F1W]; const float* f2w = a.in[I_F2W]; const float* f3w = a.in[I_F3W];
        for (int it = abx; it < L / 8; it += aG) {
            const int p0 = it * 8; const int t = p0 + F.wave;
            {
                const float tl = (float)t / (float)(L - 1); const float wang = 2.0f * 3.14159265358979323846f * (float)t / (float)L;
                float zv = 0.f;
                if (F.lane == 0) zv = tl;
                else if (F.lane < 33) { const int q = (F.lane - 1) & 15; const float fq = 1e-4f + (float)q * ((15.0f - 1e-4f) / 15.0f); const float ang = fq * wang; zv = F.lane < 17 ? cosf(ang) : -sinf(ang); }
                ZB[F.wave * 64 + F.lane] = zv;
                LDS_WAIT();
                float s = a.in[I_F1B][F.lane];
                for (int i = 0; i < 33; ++i) s += ZB[F.wave * 64 + i] * f1w[i * 64 + F.lane];
                const float h1 = sinf(a.in[I_F1F][F.lane] * s);
                H1[F.wave * 64 + F.lane] = h1;
                LDS_WAIT();
                float s2 = a.in[I_F2B][F.lane];
                for (int k = 0; k < 64; ++k) s2 += H1[F.wave * 64 + k] * f2w[k * 64 + F.lane];
                HB[F.wave * 64 + F.lane] = sinf(a.in[I_F2F][F.lane] * s2);
            }
            __syncthreads();
            for (int cc = F.wave; cc < 16; cc += 8) {
                const int n = cc * 256 + 4 * F.lane;
                f32x4 acc[8];
#pragma unroll
                for (int p = 0; p < 8; ++p) acc[p] = (f32x4){0.f, 0.f, 0.f, 0.f};
                for (int k = 0; k < 64; ++k) { const f32x4 w = *(const f32x4*)(f3w + (size_t)k * 4096 + n);
#pragma unroll
                    for (int p = 0; p < 8; ++p) acc[p] += w * HB[p * 64 + k]; }
                const int o2 = n >> 10, c0 = n & 1023;
                const float mind = logf(1e-2f) / 1.5f, maxd = logf(1e-2f) / 0.3f;
#pragma unroll
                for (int j = 0; j < 4; ++j) { const int c = c0 + j; const float delta = fabsf(mind + (float)c * ((maxd - mind) / (float)(D - 1)));
                    float o[8];
#pragma unroll
                    for (int p = 0; p < 8; ++p) { const float tl = (float)(p0 + p) / (float)(L - 1); o[p] = acc[p][j] * expf(-tl * delta); }
                    u32x4 w; w.x = pk2h(o[0], o[1]); w.y = pk2h(o[2], o[3]); w.z = pk2h(o[4], o[5]); w.w = pk2h(o[6], o[7]);
                    *(u32x4*)(FILT + ((size_t)(o2 * 1024 + c) * L + p0)) = w; }
            }
            __syncthreads();
        }
    }
}

DI void rows_load(const float* src, int lane, f32x4 (&v)[4]) {
#pragma unroll
    for (int j = 0; j < 4; ++j) v[j] = __builtin_nontemporal_load((const f32x4*)(src + 4 * lane + 256 * j));
}
DI void rows_load_h(const h16* src, int lane, f32x4 (&v)[4]) {
#pragma unroll
    for (int j = 0; j < 4; ++j) v[j] = unpack4(*(const u32x2*)(src + 4 * lane + 256 * j));
}
DI void rows_phase(const Ctx& F, CArgs& a, int nrows, bool copy_in, bool combine, int lmoe, int lnext, bool final_out, bool from_input = false) {
    unsigned char* ws = a.ws;
    h16* XC = (h16*)(ws + WS_XC); h16* H = (h16*)(ws + WS_H);
    const float* MOD = (const float*)(ws + WS_MOD);
    const int* SLOT = (const int*)(ws + WS_SLOT); const unsigned char* YE = ws + WS_XIN;
    const bool ext = copy_in || from_input;
    int row = F.gw;
    f32x4 nv[4]; int nslot = -1;
    if (row < nrows) { if (ext) rows_load(row < T ? a.in[I_X] + (size_t)row * D : a.in[I_CTX] + (size_t)(row - T) * D, F.lane, nv); else rows_load_h(XC + (size_t)row * D, F.lane, nv);
        if (combine) nslot = SLOT[(size_t)row * 16 + (F.lane & 15)]; }
    for (; row < nrows; row += F.NGW) {
        const int r9 = row < T ? (row >> 11) : 8;
        f32x4 v[4];
#pragma unroll
        for (int j = 0; j < 4; ++j) v[j] = nv[j];
        const int myslot = nslot;
        { const int nr = row + F.NGW < nrows ? row + F.NGW : row;
          if (ext) rows_load(nr < T ? a.in[I_X] + (size_t)nr * D : a.in[I_CTX] + (size_t)(nr - T) * D, F.lane, nv); else rows_load_h(XC + (size_t)nr * D, F.lane, nv);
          if (combine) nslot = SLOT[(size_t)nr * 16 + (F.lane & 15)]; }
        f32x4 g2v[4], gA[4], shA[4], scA[4];
        if (combine) { const float* g2 = MOD + ((size_t)lmoe * 9 + r9) * 6144 + 5120 + 4 * F.lane;
#pragma unroll
            for (int j = 0; j < 4; ++j) g2v[j] = *(const f32x4*)(g2 + 256 * j); }
        if (final_out) {
#pragma unroll
            for (int j = 0; j < 4; ++j) gA[j] = *(const f32x4*)(a.in[I_FG] + 4 * F.lane + 256 * j);
        } else { const float* g1 = a.in[I_N1G] + lnext * D + 4 * F.lane; const float* md = MOD + ((size_t)lnext * 9 + r9) * 6144 + 4 * F.lane;
#pragma unroll
            for (int j = 0; j < 4; ++j) { gA[j] = *(const f32x4*)(g1 + 256 * j); shA[j] = *(const f32x4*)(md + 256 * j); scA[j] = *(const f32x4*)(md + 1024 + 256 * j); } }
        if (combine) {
            f32x4 s[4];
#pragma unroll
            for (int j = 0; j < 4; ++j) s[j] = (f32x4){0.f, 0.f, 0.f, 0.f};
            unsigned m = (unsigned)(__ballot(myslot >= 0) & 0xFFFFull);
            while (m) {
                int sl[4]; unsigned y[4][4];
#pragma unroll
                for (int q = 0; q < 4; ++q) { sl[q] = -1; if (m) { const int e = __builtin_ctz(m); m &= m - 1; sl[q] = __builtin_amdgcn_readlane(myslot, e); } }
#pragma unroll
                for (int q = 0; q < 4; ++q) if (sl[q] >= 0) { const unsigned char* yp = YE + (size_t)sl[q] * D + 4 * F.lane;
#pragma unroll
                    for (int j = 0; j < 4; ++j) y[q][j] = *(const unsigned*)(yp + 256 * j); }
#pragma unroll
                for (int q = 0; q < 4; ++q) if (sl[q] >= 0) {
#pragma unroll
                    for (int j = 0; j < 4; ++j) { const f32x2 lo = __builtin_amdgcn_cvt_pk_f32_fp8((int)y[q][j], false), hi2 = __builtin_amdgcn_cvt_pk_f32_fp8((int)y[q][j], true);
                        s[j] += (f32x4){lo.x, lo.y, hi2.x, hi2.y}; } }
            }
#pragma unroll
            for (int j = 0; j < 4; ++j) v[j] += g2v[j] * s[j] * (1.f / 16.f);
        }
        float ss = 0.f;
#pragma unroll
        for (int j = 0; j < 4; ++j) ss += (v[j].x * v[j].x + v[j].y * v[j].y) + (v[j].z * v[j].z + v[j].w * v[j].w);
        const float rstd = 1.0f / sqrtf(wave_sum(ss, F.lane) * (1.f / D) + 1e-6f);
        if (final_out) {
            f32x4 o[4];
#pragma unroll
            for (int j = 0; j < 4; ++j) o[j] = v[j] * rstd * gA[j];
            if (row < T) {
#pragma unroll
                for (int j = 0; j < 4; ++j) __builtin_nontemporal_store(o[j], (f32x4*)(a.out + (size_t)row * D + 4 * F.lane + 256 * j)); }
        } else {
            u32x2 hw[4];
#pragma unroll
            for (int j = 0; j < 4; ++j) { const f32x4 h = (v[j] * rstd * gA[j]) * (1.f + scA[j]) + shA[j];
                hw[j].x = pk2h(h.x, h.y); hw[j].y = pk2h(h.z, h.w); }
            if (copy_in || combine) {
#pragma unroll
                for (int j = 0; j < 4; ++j) { u32x2 w; w.x = pk2h(v[j].x, v[j].y); w.y = pk2h(v[j].z, v[j].w); *(u32x2*)(XC + (size_t)row * D + 4 * F.lane + 256 * j) = w; } }
#pragma unroll
            for (int j = 0; j < 4; ++j) *(u32x2*)(H + (size_t)row * D + 4 * F.lane + 256 * j) = hw[j];
        }
    }
}


DI void cg_load_u(const h16* BCV, int row, int c0, float (&u)[8]) {
    float cg[8], v[8];
    unpack8(*(const u32x4*)(BCV + (size_t)row * 3072 + 1024 + c0), cg); unpack8(*(const u32x4*)(BCV + (size_t)row * 3072 + 2048 + c0), v);
#pragma unroll
    for (int q = 0; q < 8; ++q) u[q] = cg[q] * v[q];
}
DI void cg_raw(const h16* BU, int row, int c0, u32x4& ur) { ur = *(const u32x4*)(BU + (size_t)row * 2048 + 1024 + c0); }
DI void cg_mul(const u32x4& ur, bool valid, float (&u)[8]) {
    float t[8]; unpack8(ur, t);
#pragma unroll
    for (int q = 0; q < 8; ++q) u[q] = valid ? t[q] : 0.f;
}
DI void convgate_phase(const Ctx& F, CArgs& a, int j, int nrows) {
    const h16* BU = (const h16*)(a.ws + WS_BIG); h16* Z = (h16*)(a.ws + WS_Z);
    const float* cw = a.in[I_ACONV] + (size_t)j * 3 * D;
    const int RI = nrows == T ? 16 : 8;
    const int nitems = (nrows / RI) * 2;
    for (int it = F.gw; it < nitems; it += F.NGW) {
        const int hsel = it & 1, r0 = (it >> 1) * RI, c0 = hsel * 512 + 8 * F.lane;
        const int ls = r0 < T ? L : LC; const int t0 = r0 < T ? (r0 & (L - 1)) : ((r0 - T) & (LC - 1));
        u32x4 cm, c0r, c1r, cA, cB, bw, bw1;
        cg_raw(BU, r0 - 1, c0, cm); cg_raw(BU, r0, c0, c0r); cg_raw(BU, r0 + 1, c0, c1r);
        bw = *(const u32x4*)(BU + (size_t)r0 * 2048 + c0);
        cg_raw(BU, r0 + 2, c0, cA); cg_raw(BU, r0 + 3, c0, cB);
        bw1 = *(const u32x4*)(BU + (size_t)(r0 + 1) * 2048 + c0);
        float w0[8], w1[8], w2[8];
#pragma unroll
        for (int q = 0; q < 8; ++q) { w0[q] = cw[c0 + q]; w1[q] = cw[D + c0 + q]; w2[q] = cw[2 * D + c0 + q]; }
        __builtin_amdgcn_sched_barrier(0);
        float up[8], uc[8], un[8];
        cg_mul(cm, t0 > 0, up); cg_mul(c0r, true, uc); cg_mul(c1r, t0 + 1 < ls, un);
        for (int i = 0; i < RI; ++i) {
            const int row = r0 + i;
            u32x4 cN, bw2;
            { const int k4 = i + 4 < RI ? i + 4 : RI, k2 = i + 2 < RI ? i + 2 : RI - 1;
              cg_raw(BU, r0 + k4, c0, cN); bw2 = *(const u32x4*)(BU + (size_t)(r0 + k2) * 2048 + c0); }
            float un2[8]; cg_mul(cA, (i + 2 <= RI) && (t0 + i + 2 < ls), un2);
            float bv[8], o[8]; unpack8(bw, bv);
#pragma unroll
            for (int q = 0; q < 8; ++q) o[q] = bv[q] * (w0[q] * up[q] + w1[q] * uc[q] + w2[q] * un[q]);
            u32x4 w; w.x = pk2h(o[0], o[1]); w.y = pk2h(o[2], o[3]); w.z = pk2h(o[4], o[5]); w.w = pk2h(o[6], o[7]);
            *(u32x4*)(Z + (size_t)row * D + c0) = w;
#pragma unroll
            for (int q = 0; q < 8; ++q) { up[q] = uc[q]; uc[q] = un[q]; un[q] = un2[q]; }
            bw = bw1; bw1 = bw2; cA = cB; cB = cN;
        }
    }
}

DI void moe_rows_phase(const Ctx& F, CArgs& a, int l, int nrows) {
    unsigned char* ws = a.ws;
    const h16* XC = (const h16*)(ws + WS_XC); unsigned char* H8 = ws + WS_Z; const float* MOD = (const float*)(ws + WS_MOD); float* AFF = (float*)(ws + WS_AFF);
    LAS float* WR = (LAS float*)F.lds;
    const float* rt = a.in[I_ROUTER] + (size_t)l * 1024 * 16;
    const int ngroups = nrows >> 2;
    u32x2 raw[4][4];
    if (F.gw < ngroups) {
#pragma unroll
        for (int r = 0; r < 4; ++r)
#pragma unroll
            for (int c = 0; c < 4; ++c) raw[r][c] = *(const u32x2*)(XC + (size_t)(F.gw * 4 + r) * D + 4 * F.lane + 256 * c); }
    { float tv[32];
#pragma unroll
      for (int k = 0; k < 32; ++k) tv[k] = rt[F.tid + NTHR * k];
      __builtin_amdgcn_sched_barrier(0);
#pragma unroll
      for (int k = 0; k < 32; ++k) { const int i = F.tid + NTHR * k; WR[(i & 15) * 1028 + (i >> 4)] = tv[k]; } }
    __syncthreads();
    const int rs = F.lane >> 4, l16 = F.lane & 15;
    const float* g2 = a.in[I_N2G] + l * D + 4 * F.lane;
    const bool spread = (F.NGW == 2048) && (ngroups == 4608);
#define MR_SEQ(k) (spread ? ((k) < 2 ? F.gw + (k) * 2048 : (((k) == 2 && F.wave < 2) ? 4096 + F.vcu + 256 * F.wave : ngroups)) : F.gw + (k) * F.NGW)
    for (int kk = 0, grp = F.gw; grp < ngroups; ++kk, grp = MR_SEQ(kk)) {
        const int row0 = grp * 4;
        const int r9 = row0 < T ? (row0 >> 11) : 8;
        f32x4 gq[4], shq[4], scq[4];
        const float* md = MOD + ((size_t)l * 9 + r9) * 6144 + 3072 + 4 * F.lane;
#pragma unroll
        for (int c = 0; c < 4; ++c) { gq[c] = *(const f32x4*)(g2 + 256 * c); shq[c] = *(const f32x4*)(md + 256 * c); scq[c] = *(const f32x4*)(md + 1024 + 256 * c); }
        __builtin_amdgcn_sched_barrier(0);
        f32x4 h[4][4];
        float ss[4];
#pragma unroll
        for (int r = 0; r < 4; ++r) { float s_ = 0.f;
#pragma unroll
            for (int c = 0; c < 4; ++c) { h[r][c] = unpack4(raw[r][c]); s_ += (h[r][c].x * h[r][c].x + h[r][c].y * h[r][c].y) + (h[r][c].z * h[r][c].z + h[r][c].w * h[r][c].w); }
            ss[r] = s_; }
        { const int gnx = min(MR_SEQ(kk + 1), ngroups - 1);
#pragma unroll
            for (int r = 0; r < 4; ++r)
#pragma unroll
                for (int c = 0; c < 4; ++c) raw[r][c] = *(const u32x2*)(XC + (size_t)(gnx * 4 + r) * D + 4 * F.lane + 256 * c); }
        __builtin_amdgcn_sched_barrier(0);
#pragma unroll
        for (int o = 1; o < 64; o <<= 1)
#pragma unroll
            for (int r = 0; r < 4; ++r) ss[r] += sx(ss[r], o, F.lane);
        unsigned w8[4][4];
        f32x2 hx[2][4][4];
#pragma unroll
        for (int c = 0; c < 4; ++c) { const f32x4 g = gq[c], sh = shq[c], sc = scq[c];
#pragma unroll
            for (int r = 0; r < 4; ++r) { const float rstd = 1.0f / sqrtf(ss[r] * (1.f / D) + 1e-6f);
                const f32x4 v = (h[r][c] * rstd * g) * (1.f + sc) + sh;
                w8[r][c] = pk4f8(v.x * 8.f, v.y * 8.f, v.z * 8.f, v.w * 8.f);
                hx[r >> 1][c][0][r & 1] = v.x; hx[r >> 1][c][1][r & 1] = v.y; hx[r >> 1][c][2][r & 1] = v.z; hx[r >> 1][c][3][r & 1] = v.w; } }
        f32x2 p[2][16];
#pragma unroll
        for (int e = 0; e < 16; ++e) { f32x2 q0 = {0.f, 0.f}, q1_ = {0.f, 0.f};
#pragma unroll
            for (int c = 0; c < 4; ++c) { const f32x4 w = *(const LAS f32x4*)(WR + e * 1028 + 4 * F.lane + 256 * c);
#pragma unroll
                for (int i = 0; i < 4; ++i) { const f32x2 wv = {w[i], w[i]}; q0 = __builtin_elementwise_fma(hx[0][c][i], wv, q0); q1_ = __builtin_elementwise_fma(hx[1][c][i], wv, q1_); } }
            p[0][e] = q0; p[1][e] = q1_; if ((e & 3) == 3) __builtin_amdgcn_sched_barrier(0); }
        float p16[16];
        { const bool hb = (F.lane & 32) != 0; float t2[2][16];
#pragma unroll
          for (int e = 0; e < 16; ++e)
#pragma unroll
              for (int k = 0; k < 2; ++k) { const float send = hb ? p[0][e][k] : p[1][e][k], keep = hb ? p[1][e][k] : p[0][e][k]; t2[k][e] = keep + sx(send, 32, F.lane); }
          const bool hc = (F.lane & 16) != 0;
#pragma unroll
          for (int e = 0; e < 16; ++e) { const float send = hc ? t2[0][e] : t2[1][e], keep = hc ? t2[1][e] : t2[0][e]; p16[e] = keep + sx(send, 16, F.lane); } }
        float q8[8], q4[4], q2[2], q1;
        { const bool hb = (l16 & 8) != 0;
#pragma unroll
          for (int i = 0; i < 8; ++i) { const float send = hb ? p16[i] : p16[i + 8], keep = hb ? p16[i + 8] : p16[i]; q8[i] = keep + sx(send, 8, F.lane); } }
        { const bool hb = (l16 & 4) != 0;
#pragma unroll
          for (int i = 0; i < 4; ++i) { const float send = hb ? q8[i] : q8[i + 4], keep = hb ? q8[i + 4] : q8[i]; q4[i] = keep + sx(send, 4, F.lane); } }
        { const bool hb = (l16 & 2) != 0;
#pragma unroll
          for (int i = 0; i < 2; ++i) { const float send = hb ? q4[i] : q4[i + 2], keep = hb ? q4[i + 2] : q4[i]; q2[i] = keep + sx(send, 2, F.lane); } }
        { const bool hb = (l16 & 1) != 0; const float send = hb ? q2[0] : q2[1], keep = hb ? q2[1] : q2[0]; q1 = keep + sx(send, 1, F.lane); }
        float mx = q1;
#pragma unroll
        for (int o = 1; o < 16; o <<= 1) mx = fmaxf(mx, sx(mx, o, F.lane));
        const float mine = expf(q1 - mx);
        float sum = mine;
#pragma unroll
        for (int o = 1; o < 16; o <<= 1) sum += sx(sum, o, F.lane);
        const float af = mine / sum;
#pragma unroll
        for (int r = 0; r < 4; ++r)
#pragma unroll
            for (int c = 0; c < 4; ++c) *(unsigned*)(H8 + (size_t)(row0 + r) * D + 4 * F.lane + 256 * c) = w8[r][c];
        const int row = row0 + rs;
        if (row < T) AFF[((size_t)(row >> 11) * 16 + l16) * L + (row & (L - 1))] = af;
        else { const int rc = row - T; AFF[(size_t)NB * 16 * L + ((size_t)(rc >> 8) * 16 + l16) * LC + (rc & (LC - 1))] = af; }
    }
}

DI int lanes_below(unsigned long long m) { return (int)__builtin_amdgcn_mbcnt_hi((unsigned)(m >> 32), __builtin_amdgcn_mbcnt_lo((unsigned)m, 0u)); }
DI void topk_phase(const Ctx& F, CArgs& a, int l) {
    unsigned char* ws = a.ws;
    const float* AFF = (const float*)(ws + WS_AFF); int* SLOT = (int*)(ws + WS_SLOT); float* GATE = (float*)(ws + WS_GATE);
    int* SEL = (int*)(ws + WS_GATE + 512 * 1024);
    volatile LAS int* CNT = (volatile LAS int*)F.lds;
    const int nitems = 128 + (l == 0 ? 128 : 0);
    for (int it = F.bx; it < nitems; it += F.G) {
        const bool ctx = it >= 128; const int id = it & 127, e = id >> 3, b = id & 7;
        const int N = ctx ? LC : L, cap = ctx ? CAPC : CAP;
        const float* src = ctx ? AFF + (size_t)NB * 16 * L + ((size_t)b * 16 + e) * LC : AFF + ((size_t)b * 16 + e) * L;
        unsigned kb[4];
        { f32x4 v = {0.f, 0.f, 0.f, 0.f}; if (4 * F.tid < N) v = *(const f32x4*)(src + 4 * F.tid);
          kb[0] = __float_as_uint(v.x); kb[1] = __float_as_uint(v.y); kb[2] = __float_as_uint(v.z); kb[3] = __float_as_uint(v.w); }
        unsigned cur = 0u; int par = 0;
        for (int bit = 30; bit >= 0; --bit) {
            const unsigned cand = cur | (1u << bit);
            int c = 0;
#pragma unroll
            for (int q = 0; q < 4; ++q) c += __builtin_popcountll(__ballot(kb[q] >= cand));
            if (F.lane == 0) CNT[par * 8 + F.wave] = c;
            __syncthreads();
            int tot = 0;
#pragma unroll
            for (int w = 0; w < 8; ++w) tot += CNT[par * 8 + w];
            if (tot >= cap) cur = cand;
            par ^= 1;
        }
        unsigned long long mg[4], me[4]; int cg = 0, ce = 0;
#pragma unroll
        for (int q = 0; q < 4; ++q) { mg[q] = __ballot(kb[q] > cur); me[q] = __ballot(kb[q] == cur); cg += __builtin_popcountll(mg[q]); ce += __builtin_popcountll(me[q]); }
        __syncthreads();
        if (F.lane == 0) { CNT[16 + F.wave] = cg; CNT[24 + F.wave] = ce; }
        __syncthreads();
        int n_gt = 0, eq_before_wave = 0;
#pragma unroll
        for (int w = 0; w < 8; ++w) { const int g_ = CNT[16 + w], e_ = CNT[24 + w]; n_gt += g_; eq_before_wave += (w < F.wave) ? e_ : 0; }
        const int need_eq = cap - n_gt;
        int eqb = eq_before_wave;
#pragma unroll
        for (int q = 0; q < 4; ++q) eqb += lanes_below(me[q]);
        bool sel[4]; int eq_run = eqb;
#pragma unroll
        for (int q = 0; q < 4; ++q) { const bool isg = kb[q] > cur, ise = kb[q] == cur; sel[q] = isg || (ise && eq_run < need_eq); eq_run += ise ? 1 : 0; }
        unsigned long long ms[4]; int cs = 0;
#pragma unroll
        for (int q = 0; q < 4; ++q) { ms[q] = __ballot(sel[q]); cs += __builtin_popcountll(ms[q]); }
        __syncthreads();
        if (F.lane == 0) CNT[16 + F.wave] = cs;
        __syncthreads();
        int slot = 0;
#pragma unroll
        for (int w = 0; w < 8; ++w) slot += (w < F.wave) ? CNT[16 + w] : 0;
#pragma unroll
        for (int q = 0; q < 4; ++q) slot += lanes_below(ms[q]);
        const int gbase = ctx ? NGL + id * CAPC : id * CAP, rowbase = ctx ? T + b * LC : b * L;
        if (4 * F.tid < N) {
#pragma unroll
            for (int q = 0; q < 4; ++q) { const int row = rowbase + 4 * F.tid + q;
                if (sel[q]) { const int g = gbase + slot; SLOT[(size_t)row * 16 + e] = g; GATE[g] = __uint_as_float(kb[q]); SEL[g] = row; ++slot; }
                else SLOT[(size_t)row * 16 + e] = -1; }
        }
        __syncthreads();
    }
}

namespace attn_body {
constexpr int DM = 1024, NW = 8, QBLK = 32, QB = 256, KVBLK = 64, NT = KVR / KVBLK;
DI int crow(int r, int hi) { return (r & 3) + 8 * (r >> 2) + 4 * hi; }
#define SBAR() __builtin_amdgcn_sched_barrier(0)
constexpr int NSLOT = 3, SLOTB = 8192;
constexpr int LDS_K = 0, LDS_V = NSLOT * SLOTB, LDS_WS = 2 * NSLOT * SLOTB, LDS_OST = LDS_WS + NW * 64 * 4, LDS_BYTES_A = LDS_OST + NW * 4096;
DI void glds16(const void* gsrc, unsigned lds_dst) { unsigned keep;
    asm volatile("s_mov_b32 %0, m0\n\ts_mov_b32 m0, %2\n\ts_nop 0\n\tglobal_load_lds_dwordx4 %1, off\n\ts_mov_b32 m0, %0" : "=&s"(keep) : "v"(gsrc), "s"(lds_dst) : "memory"); }
DI float max3f(float a, float b, float c) { float r; asm("v_max3_f32 %0, %1, %2, %3" : "=v"(r) : "v"(a), "v"(b), "v"(c)); return r; }
DI float max2f(float a, float b) { float r; asm("v_max_f32_e32 %0, %1, %2" : "=v"(r) : "v"(a), "v"(b)); return r; }
DI float fadd_s(float a, float b) { float r; asm("v_add_f32_e32 %0, %1, %2" : "=v"(r) : "v"(a), "v"(b)); return r; }
DI float fsub_s(float a, float b) { float r; asm("v_sub_f32_e32 %0, %1, %2" : "=v"(r) : "v"(a), "v"(b)); return r; }
DI unsigned cvtpk_s(float lo, float hi) { return pk2h(lo, hi); }
DI f32x16 MF(s16x8 x, s16x8 y, f32x16 c) { return __builtin_amdgcn_mfma_f32_32x32x16_f16(__builtin_bit_cast(half8, x), __builtin_bit_cast(half8, y), c, 0, 0, 0); }
#define WAIT_BAR(N) asm volatile("s_waitcnt vmcnt(" #N ") lgkmcnt(0)\n\ts_barrier" ::: "memory")
DI void qkt(f32x16& p0, f32x16& p1, const char* Kslot, const s16x8* qr, const f32x16& negm, int r32, int hi) {
    const char* kb = Kslot + hi * 1024 + r32 * 16;
#pragma unroll
    for (int d0 = 0; d0 < 4; ++d0) {
        const s16x8 b0 = *reinterpret_cast<const s16x8*>(kb + d0 * 2048);
        const s16x8 b1 = *reinterpret_cast<const s16x8*>(kb + d0 * 2048 + 512);
        if (d0 == 0) { p0 = MF(b0, qr[0], negm); p1 = MF(b1, qr[0], negm); }
        else { p0 = MF(b0, qr[d0], p0); p1 = MF(b1, qr[d0], p1); } }
}
typedef __attribute__((address_space(3))) const char* lds_cptr;
typedef short v4i16_t __attribute__((ext_vector_type(4)));
DI void kload8(s16x8* kf, lds_cptr kp) {
    kf[0] = *(const LAS s16x8*)(kp);        kf[1] = *(const LAS s16x8*)(kp + 512);
    kf[2] = *(const LAS s16x8*)(kp + 2048); kf[3] = *(const LAS s16x8*)(kp + 2560);
    kf[4] = *(const LAS s16x8*)(kp + 4096); kf[5] = *(const LAS s16x8*)(kp + 4608);
    kf[6] = *(const LAS s16x8*)(kp + 6144); kf[7] = *(const LAS s16x8*)(kp + 6656);
}
DI void kload2(s16x8* kf, lds_cptr kp, int j) { kf[2 * j] = *(const LAS s16x8*)(kp + j * 2048); kf[2 * j + 1] = *(const LAS s16x8*)(kp + j * 2048 + 512); }
DI s16x4 vtr(lds_cptr p) { return __builtin_bit_cast(s16x4, __builtin_amdgcn_ds_read_tr16_b64_v4i16((LAS v4i16_t*)p)); }
DI float rowmax(const f32x16& p0, const f32x16& p1) {
    float a = max3f(p0[0], p0[1], p1[0]), b = max3f(p0[2], p0[3], p1[1]); a = max3f(a, p1[2], p1[3]);
#pragma unroll
    for (int r = 4; r < 16; r += 4) { a = max3f(a, p0[r], p0[r + 1]); b = max3f(b, p0[r + 2], p0[r + 3]); a = max3f(a, p1[r], p1[r + 1]); b = max3f(b, p1[r + 2], p1[r + 3]); }
    const float m = max2f(a, b);
    auto rr = __builtin_amdgcn_permlane32_swap(__float_as_uint(m), __float_as_uint(m), false, false);
    return max2f(__uint_as_float(rr[0]), __uint_as_float(rr[1]));
}
DI void pv(f32x16* o, int vb, s16x8 pa0, s16x8 pa1, s16x8 pa2, s16x8 pa3) {
#pragma unroll
    for (int d0 = 0; d0 < 2; ++d0) { s16x4 lo[4], hi[4];
#pragma unroll
        for (int ks = 0; ks < 4; ++ks) {
            asm volatile("ds_read_b64_tr_b16 %0,%1 offset:%c2" : "=&v"(lo[ks]) : "v"(vb), "i"(d0 * 4096 + ks * 1024) : "memory");
            asm volatile("ds_read_b64_tr_b16 %0,%1 offset:%c2" : "=&v"(hi[ks]) : "v"(vb), "i"(d0 * 4096 + ks * 1024 + 512) : "memory"); }
        asm volatile("s_waitcnt lgkmcnt(0)" ::: "memory"); SBAR();
#define PK(k) (s16x8){lo[k][0], lo[k][1], lo[k][2], lo[k][3], hi[k][0], hi[k][1], hi[k][2], hi[k][3]}
        o[d0] = MF(pa0, PK(0), o[d0]);
        o[d0] = MF(pa1, PK(1), o[d0]);
        o[d0] = MF(pa2, PK(2), o[d0]);
        o[d0] = MF(pa3, PK(3), o[d0]);
#undef PK
    }
}
template <int THRL> DI void attn_unit2(const int tid, const hf* Qw0, const hf* __restrict__ Kh, const hf* __restrict__ Vh, hf* Ow0, char* shm,
                                        const bool fuse = false, const hf* O1src = nullptr, const float lam = 0.f, const float* subg = nullptr) {
    const int lane = tid & 63, r32 = lane & 31, hi = lane >> 5; const int wid = __builtin_amdgcn_readfirstlane(tid >> 6);
    const hf* Qw = Qw0 + (long)(wid * QBLK) * DM;
    const unsigned lds0 = (unsigned)(uintptr_t)shm;
    constexpr int LDS_V2 = NSLOT * SLOTB, LDS_WS2 = LDS_V2 + NSLOT * 2 * SLOTB, LDS_OST2 = LDS_WS2 + NW * 64 * 4;
    float* wsf = (float*)(shm + LDS_WS2) + wid * 64;
    const hf* ksrc = Kh + (long)lane * DM + wid * 8;
    const hf* vsrc = Vh + (long)(16 * (wid & 3) + (lane >> 2)) * DM + (wid >> 2) * 32 + (lane & 3) * 8;
    const unsigned kdst = lds0 + LDS_K + wid * 1024, vdst = lds0 + LDS_V2 + wid * 1024;
#define DMA_K(t, slot) glds16(ksrc + (long)(t) * KVBLK * DM, (unsigned)__builtin_amdgcn_readfirstlane(kdst + (slot)))
#define DMA_V(t, slot) do { glds16(vsrc + (long)(t) * KVBLK * DM, (unsigned)__builtin_amdgcn_readfirstlane(vdst + 2 * (slot))); glds16(vsrc + (long)(t) * KVBLK * DM + 64, (unsigned)__builtin_amdgcn_readfirstlane(vdst + 2 * (slot) + 8192)); } while (0)
    const int vb0 = (int)(lds0 + LDS_V2) + ((lane >> 4) & 1) * 32 + (lane & 3) * 8 + (4 * hi + ((lane & 15) >> 2)) * 64;
    const char* Kbase = shm + LDS_K; s16x8 kf[8];
    const lds_cptr shm3 = (lds_cptr)shm; const lds_cptr kp0 = shm3 + LDS_K + hi * 1024 + r32 * 16; const lds_cptr vp0 = shm3 + LDS_V2 + ((lane >> 4) & 1) * 32 + (lane & 3) * 8 + (4 * hi + ((lane & 15) >> 2)) * 64;
    DMA_K(0, 0); DMA_V(0, 0); DMA_K(1, SLOTB);
    constexpr int LDS_Q2 = LDS_OST2 + NW * 4096;
    const lds_cptr qp0 = shm3 + LDS_Q2 + wid * 4096 + lane * 16;
    s16x8 qr[4];
#pragma unroll
    for (int d0 = 0; d0 < 4; ++d0) { qr[d0] = *reinterpret_cast<const s16x8*>(&Qw[(long)r32 * DM + d0 * 16 + hi * 8]); *(LAS s16x8*)((LAS char*)qp0 + d0 * 1024) = qr[d0]; }
#define QLD(d0) (*(const LAS s16x8*)(qp0 + (d0) * 1024))
    float mhat = 0.f, l_reg = 0.f; f32x16 o[4]; o[0] = f32x16{}; o[1] = f32x16{}; o[2] = f32x16{}; o[3] = f32x16{}; const f32x16 zero16 = f32x16{};
    bool resc = false;
#define START(P0, P1) do { const float rm = rowmax(P0, P1); resc = false; \
    { const float dl = rm; mhat = fadd_s(mhat, dl); \
      _Pragma("unroll") for (int r = 0; r < 16; ++r) { P0[r] = fsub_s(P0[r], dl); P1[r] = fsub_s(P1[r], dl); } } \
    _Pragma("unroll") for (int r = 0; r < 16; ++r) P0[r] = __builtin_amdgcn_exp2f(P0[r]); } while (0)
#define RESC() do { if (resc) { asm volatile("s_waitcnt lgkmcnt(0)" ::: "memory"); \
      _Pragma("unroll") for (int d_ = 0; d_ < 4; ++d_) _Pragma("unroll") for (int r = 0; r < 16; ++r) o[d_][r] *= wsf[crow(r, hi)]; } } while (0)
    f32x16 pA0, pA1, pB0, pB1;
    int sl_prev = 0, sl_cur = 0, sl_next = SLOTB;
#define ROT() do { sl_prev = sl_cur; sl_cur = sl_next; sl_next = (sl_next == (NSLOT - 1) * SLOTB) ? 0 : sl_next + SLOTB; } while (0)
    DMA_K(2, 2 * SLOTB);
    WAIT_BAR(3);
    qkt(pA0, pA1, Kbase, qr, zero16, r32, hi); asm volatile("s_nop 15\n\ts_nop 7" : "+v"(pA0), "+v"(pA1));
    START(pA0, pA1);
    _Pragma("unroll") for (int r = 0; r < 16; ++r) pA1[r] = __builtin_amdgcn_exp2f(pA1[r]);
    WAIT_BAR(0);
    DMA_K(3, 0); DMA_V(1, SLOTB);
    ROT();
    kload8(kf, kp0 + sl_cur);
    WAIT_BAR(3);
    s16x4 vlo[8], vhi[8]; u32x4 pw0, pw1, pw2, pw3;
    s16x8 qa_ = QLD(0), qb_ = QLD(1);
#define PKW(P, B) cvtpk_s(P[B], P[B + 1])
#define PAF(k) __builtin_bit_cast(s16x8, pw##k)
#define VFR(i) (s16x8){vlo[i][0], vlo[i][1], vlo[i][2], vlo[i][3], vhi[i][0], vhi[i][1], vhi[i][2], vhi[i][3]}
#define PIN(x) asm volatile("" : "+v"(x))
#define MX3(a, b, c) __builtin_fmaxf(__builtin_fmaxf((a), (b)), (c))
#define GAPA(MFX, A0, A1, A2, A3, W0, W1, PW) do { MFX; sacc += A0; sacc += A1; sacc += A2; sacc += A3; PIN(sacc); W0; W1; PIN(PW); SBAR(); } while (0)
#define EX(v) __builtin_amdgcn_exp2f(v)
#define GAPB(MFX, X, B) do { MFX; X[B] = EX(X[B]); X[B + 1] = EX(X[B + 1]); PIN(X); SBAR(); } while (0)
#define VRD(i) do { vlo[i] = vtr(vp_ + (((i) >> 2) * 4096 + ((i) & 3) * 1024)); vhi[i] = vtr(vp_ + (((i) >> 2) * 4096 + ((i) & 3) * 1024 + 512)); } while (0)
#define VRD2(i) do { vlo[i] = vtr(vp_ + (8192 + ((i) >> 2) * 4096 + ((i) & 3) * 1024)); vhi[i] = vtr(vp_ + (8192 + ((i) >> 2) * 4096 + ((i) & 3) * 1024 + 512)); } while (0)
#define KRD(G, j) do { if (G) { kload2(kf, kp0 + sl_next, j); SBAR(); } } while (0)
#define STEP(C0, C1, P0, P1, t, GK, GV, GL) do { SBAR(); \
    const lds_cptr vp_ = vp0 + 2 * sl_prev; \
    VRD(0); SBAR(); float sacc = (P0[0] + P0[1]); \
    GAPA(C0 = MF(kf[0], qa_, zero16), P0[2], P0[3], P0[4], P0[5],     pw0[0] = PKW(P0, 0), pw0[1] = PKW(P0, 2), pw0); \
    VRD(4); SBAR(); GAPA(C1 = MF(kf[1], qa_, zero16), P0[6], P0[7], P0[8], P0[9],     pw0[2] = PKW(P0, 4), pw0[3] = PKW(P0, 6), pw0); \
    qa_ = QLD(2); VRD(1); SBAR(); GAPA(C0 = MF(kf[2], qb_, C0),   P0[10], P0[11], P0[12], P0[13], pw1[0] = PKW(P0, 8), pw1[1] = PKW(P0, 10), pw1); \
    VRD(5); SBAR(); GAPA(C1 = MF(kf[3], qb_, C1),   P0[14], P0[15], P1[0], P1[1],   pw1[2] = PKW(P0, 12), pw1[3] = PKW(P0, 14), pw1); \
    qb_ = QLD(3); VRD(2); SBAR(); GAPA(C0 = MF(kf[4], qa_, C0),   P1[2], P1[3], P1[4], P1[5],     pw2[0] = PKW(P1, 0), pw2[1] = PKW(P1, 2), pw2); \
    VRD(6); SBAR(); GAPA(C1 = MF(kf[5], qa_, C1),   P1[6], P1[7], P1[8], P1[9],     pw2[2] = PKW(P1, 4), pw2[3] = PKW(P1, 6), pw2); \
    VRD(3); SBAR(); GAPA(C0 = MF(kf[6], qb_, C0),   P1[10], P1[11], P1[12], P1[13], pw3[0] = PKW(P1, 8), pw3[1] = PKW(P1, 10), pw3); \
    VRD(7); SBAR(); GAPA(C1 = MF(kf[7], qb_, C1),   P1[14], P1[15], 0.f, 0.f,       pw3[2] = PKW(P1, 12), pw3[3] = PKW(P1, 14), pw3); \
    l_reg += sacc; \
    if (GK) { DMA_K((t) + 3, sl_cur); } if (GV) { DMA_V((t) + 1, sl_next); } \
    { float a = MX3(C0[0], C0[1], C1[0]), b = MX3(C0[2], C0[3], C1[1]); a = MX3(a, C1[2], C1[3]); \
      _Pragma("unroll") for (int r = 4; r < 16; r += 4) { a = MX3(a, C0[r], C0[r + 1]); b = MX3(b, C0[r + 2], C0[r + 3]); a = MX3(a, C1[r], C1[r + 1]); b = MX3(b, C1[r + 2], C1[r + 3]); } \
      float rm = __builtin_fmaxf(a, b); { auto rr = __builtin_amdgcn_permlane32_swap(__float_as_uint(rm), __float_as_uint(rm), false, false); rm = __builtin_fmaxf(__uint_as_float(rr[0]), __uint_as_float(rr[1])); } \
      rm -= mhat;                                                       \
      resc = false; \
      if (__builtin_expect(__any(rm > (float)THRL), 0)) { const float dl = __builtin_fmaxf(rm, 0.f); mhat += dl; \
        const float f = __builtin_amdgcn_exp2f(-dl); l_reg *= f; if (hi == 0) wsf[r32] = f; resc = true; } \
      _Pragma("unroll") for (int r = 0; r < 16; ++r) { C0[r] -= mhat; C1[r] -= mhat; } } \
    SBAR(); \
    GAPB(o[0] = MF(PAF(0), VFR(0), o[0]), C0, 0); \
    GAPB(o[1] = MF(PAF(0), VFR(4), o[1]), C0, 2); \
    KRD(GL, 0); GAPB(o[0] = MF(PAF(1), VFR(1), o[0]), C0, 4); \
    VRD2(0); VRD2(4); SBAR(); \
    KRD(GL, 1); GAPB(o[1] = MF(PAF(1), VFR(5), o[1]), C0, 6); \
    KRD(GL, 2); GAPB(o[0] = MF(PAF(2), VFR(2), o[0]), C0, 8); \
    VRD2(1); VRD2(5); SBAR(); \
    KRD(GL, 3); GAPB(o[1] = MF(PAF(2), VFR(6), o[1]), C0, 10); \
    GAPB(o[0] = MF(PAF(3), VFR(3), o[0]), C0, 12); \
    VRD2(2); VRD2(6); SBAR(); \
    GAPB(o[1] = MF(PAF(3), VFR(7), o[1]), C0, 14); \
    VRD2(3); VRD2(7); SBAR(); \
    GAPB(o[2] = MF(PAF(0), VFR(0), o[2]), C1, 0); \
    GAPB(o[3] = MF(PAF(0), VFR(4), o[3]), C1, 2); \
    GAPB(o[2] = MF(PAF(1), VFR(1), o[2]), C1, 4); \
    GAPB(o[3] = MF(PAF(1), VFR(5), o[3]), C1, 6); \
    qa_ = QLD(0); qb_ = QLD(1); SBAR(); \
    GAPB(o[2] = MF(PAF(2), VFR(2), o[2]), C1, 8); \
    GAPB(o[3] = MF(PAF(2), VFR(6), o[3]), C1, 10); \
    GAPB(o[2] = MF(PAF(3), VFR(3), o[2]), C1, 12); \
    GAPB(o[3] = MF(PAF(3), VFR(7), o[3]), C1, 14); \
    } while (0)
    int t = 1;
    for (; t + 5 < NT; t += 2) {
        STEP(pB0, pB1, pA0, pA1, t, true, true, true);     WAIT_BAR(3); RESC(); ROT();
        STEP(pA0, pA1, pB0, pB1, t + 1, true, true, true); WAIT_BAR(3); RESC(); ROT();
    }
#define ENDW(tt) do { if ((tt) + 3 < NT) { WAIT_BAR(3); } else if ((tt) + 2 < NT) { WAIT_BAR(2); } else { WAIT_BAR(0); } } while (0)
    for (; t + 1 < NT; t += 2) {
        STEP(pB0, pB1, pA0, pA1, t, (t + 3 < NT), (t + 1 < NT), (t + 1 < NT));         ENDW(t);     RESC(); ROT();
        STEP(pA0, pA1, pB0, pB1, t + 1, (t + 4 < NT), (t + 2 < NT), (t + 2 < NT));     ENDW(t + 1); RESC(); ROT();
    }
    STEP(pB0, pB1, pA0, pA1, NT - 1, false, false, false); RESC();
    { float sacc = pB0[0] + pB0[1]; _Pragma("unroll") for (int r = 2; r < 16; ++r) sacc += pB0[r]; _Pragma("unroll") for (int r = 0; r < 16; ++r) sacc += pB1[r]; l_reg += sacc;
      pw0 = (u32x4){PKW(pB0, 0), PKW(pB0, 2), PKW(pB0, 4), PKW(pB0, 6)}; pw1 = (u32x4){PKW(pB0, 8), PKW(pB0, 10), PKW(pB0, 12), PKW(pB0, 14)}; pw2 = (u32x4){PKW(pB1, 0), PKW(pB1, 2), PKW(pB1, 4), PKW(pB1, 6)}; pw3 = (u32x4){PKW(pB1, 8), PKW(pB1, 10), PKW(pB1, 12), PKW(pB1, 14)};
      SBAR(); pv(o, vb0 + 2 * sl_cur, PAF(0), PAF(1), PAF(2), PAF(3)); pv(o + 2, vb0 + 2 * sl_cur + 8192, PAF(0), PAF(1), PAF(2), PAF(3)); }
#undef PKW
#undef PAF
#undef VFR
#undef PIN
#undef MX3
#undef GAPA
#undef GAPB
#undef EX
#undef VRD
#undef KRD
#undef STEP
#undef ENDW
    { auto rr = __builtin_amdgcn_permlane32_swap(__float_as_uint(l_reg), __float_as_uint(l_reg), false, false); l_reg = __uint_as_float(rr[0]) + __uint_as_float(rr[1]); }
    if (hi == 0) wsf[32 + r32] = l_reg; asm volatile("s_waitcnt lgkmcnt(0)" ::: "memory");
    float rli[16];
#pragma unroll
    for (int r = 0; r < 16; ++r) rli[r] = __builtin_amdgcn_rcpf(wsf[32 + crow(r, hi)]);
    hf* Ow = Ow0 + (long)(wid * QBLK) * DM;
    int lane2 = lane; asm volatile("" : "+v"(lane2));
    if (fuse) {
        asm volatile("s_waitcnt vmcnt(0)" ::: "memory");
        const hf* O1w = O1src + (long)(wid * QBLK) * DM; asm volatile("" : "+s"(O1w)); asm volatile("" : "+s"(Ow));
        u32x4 dvp[2][4]; float ssr[4] = {0.f, 0.f, 0.f, 0.f};
        hf* stg = (hf*)(shm + LDS_OST2) + wid * 2048;
#pragma unroll
        for (int hh2 = 0; hh2 < 2; ++hh2) {
            u32x4 x1r[4];
#pragma unroll
            for (int i = 0; i < 4; ++i) { const int row = i * 8 + (lane2 >> 3), ch = lane2 & 7; x1r[i] = *(const u32x4*)(O1w + (long)row * DM + 64 * hh2 + ch * 8); }
#pragma unroll
            for (int r = 0; r < 16; ++r) { const int orow = crow(r, hi);
#pragma unroll
                for (int d0 = 0; d0 < 2; ++d0) stg[orow * 64 + d0 * 32 + r32] = (hf)(o[2 * hh2 + d0][r] * rli[r]); }
            asm volatile("s_waitcnt lgkmcnt(0)" ::: "memory");
#pragma unroll
            for (int i = 0; i < 4; ++i) { const int row = i * 8 + (lane2 >> 3), ch = lane2 & 7; const u32x4 v2 = *(const u32x4*)(stg + row * 64 + ch * 8);
                float x1[8], x2[8]; unpack8(x1r[i], x1); unpack8(v2, x2);
#pragma unroll
                for (int j = 0; j < 8; ++j) { x1[j] -= lam * x2[j]; ssr[i] += x1[j] * x1[j]; }
                dvp[hh2][i].x = pk2h(x1[0], x1[1]); dvp[hh2][i].y = pk2h(x1[2], x1[3]); dvp[hh2][i].z = pk2h(x1[4], x1[5]); dvp[hh2][i].w = pk2h(x1[6], x1[7]); }
            asm volatile("s_waitcnt lgkmcnt(0)" ::: "memory");
        }
#pragma unroll
        for (int i = 0; i < 4; ++i) { float ss = ssr[i]; ss += sx(ss, 1, lane2); ss += sx(ss, 2, lane2); ss += sx(ss, 4, lane2); ssr[i] = (1.f - 0.35550907f) / sqrtf(ss * (1.f / 128.f) + 1e-5f); }
#pragma unroll
        for (int hh2 = 0; hh2 < 2; ++hh2) {
            const f32x4 g0 = *(const f32x4*)(subg + hh2 * 64 + (lane2 & 7) * 8), g1 = *(const f32x4*)(subg + hh2 * 64 + (lane2 & 7) * 8 + 4);
#pragma unroll
            for (int i = 0; i < 4; ++i) { const int row = i * 8 + (lane2 >> 3), ch = lane2 & 7; const float rs_ = ssr[i]; float dq[8]; unpack8(dvp[hh2][i], dq);
                u32x4 w; w.x = pk2h(dq[0] * rs_ * g0[0], dq[1] * rs_ * g0[1]); w.y = pk2h(dq[2] * rs_ * g0[2], dq[3] * rs_ * g0[3]);
                w.z = pk2h(dq[4] * rs_ * g1[0], dq[5] * rs_ * g1[1]); w.w = pk2h(dq[6] * rs_ * g1[2], dq[7] * rs_ * g1[3]);
                *(u32x4*)(Ow + (long)row * DM + 64 * hh2 + ch * 8) = w; } }
    } else
    { hf* stg = (hf*)(shm + LDS_OST2) + wid * 2048;
#pragma unroll
      for (int hh2 = 0; hh2 < 2; ++hh2) {
#pragma unroll
        for (int r = 0; r < 16; ++r) { const int orow = crow(r, hi);
#pragma unroll
          for (int d0 = 0; d0 < 2; ++d0) stg[orow * 64 + d0 * 32 + r32] = (hf)(o[2 * hh2 + d0][r] * rli[r]); }
        asm volatile("s_waitcnt lgkmcnt(0)" ::: "memory");
#pragma unroll
        for (int i = 0; i < 4; ++i) { const int row = i * 8 + (lane2 >> 3), ch = lane2 & 7; const u32x4 v = *(const u32x4*)(stg + row * 64 + ch * 8); *(u32x4*)(Ow + (long)row * DM + 64 * hh2 + ch * 8) = v; }
        asm volatile("s_waitcnt lgkmcnt(0)" ::: "memory");
      } }
    asm volatile("s_waitcnt lgkmcnt(0)\n\ts_barrier" ::: "memory");
#undef DMA_K
#undef QLD
#undef VRD2
#undef DMA_V
#undef START
#undef RESC
#undef ROT
}
#undef SBAR
#undef WAIT_BAR
}

DI void attn_phase(const Ctx& F, CArgs& a) {
    unsigned char* ws = a.ws;
    const hf* Q = (const hf*)(ws + WS_BIG); const hf* Kb = Q + (size_t)T * D; const hf* Vb = Kb + (size_t)NB * KVR * D;
    hf* OP = (hf*)(ws + WS_XIN); hf* ZN = (hf*)(ws + WS_Z);
    const float lam_init = 0.35550907f;
    const float l1 = wave_sum(a.in[I_LQ1][F.lane] * a.in[I_LK1][F.lane], F.lane), l2 = wave_sum(a.in[I_LQ2][F.lane] * a.in[I_LK2][F.lane], F.lane);
    const float lam_s = __int_as_float(__builtin_amdgcn_readfirstlane(__float_as_int(expf(l1) - expf(l2) + lam_init)));
    for (int i = 0;; ++i) {
        const long P = (long)(i >> 1) * F.G + F.vcu; if (P >= 512) break;
        const int r = i & 1, qb = (int)(P & 7), bh = (int)(P >> 3), b = bh >> 3, hh = bh & 7;
        const int qcol = hh * 128 + r * 64, vcol = hh * 128;
        const size_t orow0 = ((size_t)b * L + (size_t)qb * 256) * D + vcol;
        const hf* Qw0 = Q + ((size_t)b * L + (size_t)qb * 256) * D + qcol;
        const hf* Kh = Kb + (size_t)b * KVR * D + qcol; const hf* Vh = Vb + (size_t)b * KVR * D + vcol;
        attn_body::attn_unit2<8>(F.tid, Qw0, Kh, Vh, (r ? ZN : OP) + orow0, (char*)F.lds, r != 0, OP + orow0, lam_s, a.in[I_SUBG]);
    }
}

DI void attn_post_phase(const Ctx& F, CArgs& a) {
    unsigned char* ws = a.ws;
    const h16* O0 = (const h16*)(ws + WS_XIN); const h16* O1 = O0 + (size_t)T * D; h16* ON = (h16*)(ws + WS_Z);
    const float lam_init = 0.35550907f;
    const float l1 = wave_sum(a.in[I_LQ1][F.lane] * a.in[I_LK1][F.lane], F.lane), l2 = wave_sum(a.in[I_LQ2][F.lane] * a.in[I_LK2][F.lane], F.lane);
    const float lam = expf(l1) - expf(l2) + lam_init;
    float g[16];
#pragma unroll
    for (int i = 0; i < 16; ++i) g[i] = a.in[I_SUBG][(F.lane & 7) * 16 + i] * (1.f - lam_init);
    for (int row0 = F.gw; row0 < T; row0 += 4 * F.NGW) {
        u32x4 in[4][4];
#pragma unroll
        for (int q = 0; q < 4; ++q) { const int row = row0 + q * F.NGW; if (row < T) { const size_t off = (size_t)row * D + 16 * F.lane;
            in[q][0] = *(const u32x4*)(O0 + off); in[q][1] = *(const u32x4*)(O0 + off + 8); in[q][2] = *(const u32x4*)(O1 + off); in[q][3] = *(const u32x4*)(O1 + off + 8); } }
        u32x4 outw[4][2];
#pragma unroll
        for (int q = 0; q < 4; ++q) { const int row = row0 + q * F.NGW; if (row < T) {
            float x0[8], x1[8], y0[8], y1[8];
            unpack8(in[q][0], x0); unpack8(in[q][1], x1); unpack8(in[q][2], y0); unpack8(in[q][3], y1);
            float o[16]; float ss = 0.f;
#pragma unroll
            for (int i = 0; i < 8; ++i) { o[i] = x0[i] - lam * y0[i]; o[8 + i] = x1[i] - lam * y1[i]; }
#pragma unroll
            for (int i = 0; i < 16; ++i) ss += o[i] * o[i];
            ss += sx(ss, 1, F.lane); ss += sx(ss, 2, F.lane); ss += sx(ss, 4, F.lane);
            const float rstd = 1.0f / sqrtf(ss * (1.f / 128.f) + 1e-5f);
            u32x4 w0, w1;
            w0.x = pk2h(o[0] * rstd * g[0], o[1] * rstd * g[1]); w0.y = pk2h(o[2] * rstd * g[2], o[3] * rstd * g[3]); w0.z = pk2h(o[4] * rstd * g[4], o[5] * rstd * g[5]); w0.w = pk2h(o[6] * rstd * g[6], o[7] * rstd * g[7]);
            w1.x = pk2h(o[8] * rstd * g[8], o[9] * rstd * g[9]); w1.y = pk2h(o[10] * rstd * g[10], o[11] * rstd * g[11]); w1.z = pk2h(o[12] * rstd * g[12], o[13] * rstd * g[13]); w1.w = pk2h(o[14] * rstd * g[14], o[15] * rstd * g[15]);
            outw[q][0] = w0; outw[q][1] = w1; } }
#pragma unroll
        for (int q = 0; q < 4; ++q) { const int row = row0 + q * F.NGW; if (row < T) { const size_t off = (size_t)row * D + 16 * F.lane; *(u32x4*)(ON + off) = outw[q][0]; *(u32x4*)(ON + off + 8) = outw[q][1]; } }
    }
}

namespace hy {
constexpr int VPS = 2568;
constexpr int OFF_SA = 0, OFF_VP = 65536, OFF_G = OFF_VP + 8 * VPS * 2, OFF_RG = OFF_G + 32768, OFF_END = OFF_RG + 8192;
static_assert(OFF_END <= LDS_CTL_OFF, "hyena LDS map");
DI f32x16 MF(s16x8 x, s16x8 y, f32x16 c) { return __builtin_amdgcn_mfma_f32_32x32x16_f16(__builtin_bit_cast(half8, x), __builtin_bit_cast(half8, y), c, 0, 0, 0); }
DI int crow(int r, int hi) { return (r & 3) + 8 * (r >> 2) + 4 * hi; }

struct RowRaw { u32x4 d[4]; h16 prev, next; };
DI void raw_load(const h16* UT, int chr, int tid, RowRaw& r) {
    const int b = tid >> 6, t0 = (tid & 63) * 32;
    const h16* src = UT + (size_t)chr * T + (size_t)b * L + t0;
    r.prev = t0 > 0 ? src[-1] : (h16)0; r.next = t0 + 32 < L ? src[32] : (h16)0;
#pragma unroll
    for (int q = 0; q < 4; ++q) r.d[q] = *(const u32x4*)(src + 8 * q);
}
DI void conv3_store(const RowRaw& r, float w0, float w1, float w2, LAS h16* dst, int pitch, int tid) {
    const int b = tid >> 6, t0 = (tid & 63) * 32;
    float u[34];
    u[0] = h2f(r.prev); u[33] = h2f(r.next);
#pragma unroll
    for (int q = 0; q < 4; ++q) { float tmp[8]; unpack8(r.d[q], tmp);
#pragma unroll
        for (int e = 0; e < 8; ++e) u[1 + 8 * q + e] = tmp[e]; }
#pragma unroll
    for (int q = 0; q < 4; ++q) { float o[8];
#pragma unroll
        for (int e = 0; e < 8; ++e) { const int i = 8 * q + e; o[e] = w0 * u[i] + w1 * u[i + 1] + w2 * u[i + 2]; }
        u32x4 w; w.x = pk2h(o[0], o[1]); w.y = pk2h(o[2], o[3]); w.z = pk2h(o[4], o[5]); w.w = pk2h(o[6], o[7]);
        *(LAS u32x4*)(dst + b * pitch + t0 + 8 * q) = w; }
}
DI void rg_load(const h16* hfw, const h16* hbw, int tid, h16 (&v)[8]) {
#pragma unroll
    for (int e = 0; e < 8; ++e) { const int idx = tid * 8 + e; h16 x = 0; if (idx >= 1 && idx <= L) x = hfw[L - idx]; else if (idx > L) x = hbw[idx - L]; v[e] = x; }
}
DI void rg_store(LAS h16* RG, int tid, const h16 (&v)[8]) {
    u32x4 w; w.x = v[0] | ((unsigned)v[1] << 16); w.y = v[2] | ((unsigned)v[3] << 16); w.z = v[4] | ((unsigned)v[5] << 16); w.w = v[6] | ((unsigned)v[7] << 16);
    *(LAS u32x4*)(RG + tid * 8) = w;
}
DI void build_sa(const LAS h16* RG, LAS unsigned char* SA, int tid) {
#pragma unroll
    for (int i = 0; i < 8; ++i) { const int q = tid + NTHR * i; unsigned short v[8];
#pragma unroll
        for (int e = 0; e < 8; ++e) v[e] = (q + e < 4096) ? RG[q + e] : (unsigned short)0;
        u32x4 w; w.x = v[0] | ((unsigned)v[1] << 16); w.y = v[2] | ((unsigned)v[3] << 16); w.z = v[4] | ((unsigned)v[5] << 16); w.w = v[6] | ((unsigned)v[7] << 16);
        *(LAS u32x4*)(SA + q * 16) = w; }
}
DI void toeplitz(const LAS unsigned char* SA, const LAS h16* VP, int wave, int lane, f32x16 (&acc)[2]) {
    const int i = lane & 31, hi = lane >> 5, n = lane & 31, b = n >> 2, q = n & 3;
    const int T0 = 256 * wave, dhi = T0 + 192;
    const LAS unsigned char* ap = SA + (L - dhi + 8 * hi - i) * 16;
    const LAS h16* bp = VP + b * VPS + 256 + (T0 + 64 * q - dhi) + 8 * hi;
    acc[0] = f32x16{}; acc[1] = f32x16{};
    s16x8 p0 = *(const LAS s16x8*)(ap - 512), p1 = *(const LAS s16x8*)(ap - 512 + 256);
    s16x8 xa0 = *(const LAS s16x8*)(ap), xa1 = *(const LAS s16x8*)(ap + 256), xb0 = *(const LAS s16x8*)(bp), xb1 = *(const LAS s16x8*)(bp + 16);
    s16x8 ya0, ya1, yb0, yb1;
    for (int d = 0; d < 70; d += 2) {
        ya0 = *(const LAS s16x8*)(ap + (d + 1) * 512); ya1 = *(const LAS s16x8*)(ap + (d + 1) * 512 + 256); yb0 = *(const LAS s16x8*)(bp + (d + 1) * 32); yb1 = *(const LAS s16x8*)(bp + (d + 1) * 32 + 16);
        __builtin_amdgcn_sched_barrier(0);
        acc[0] = MF(xa0, xb0, acc[0]); acc[1] = MF(p0, xb0, acc[1]);
        acc[0] = MF(xa1, xb1, acc[0]); acc[1] = MF(p1, xb1, acc[1]);
        __builtin_amdgcn_sched_barrier(0);
        { const int d2 = (d + 2 < 70) ? d + 2 : d;
          p0 = xa0; p1 = xa1;
          xa0 = *(const LAS s16x8*)(ap + d2 * 512); xa1 = *(const LAS s16x8*)(ap + d2 * 512 + 256); xb0 = *(const LAS s16x8*)(bp + d2 * 32); xb1 = *(const LAS s16x8*)(bp + d2 * 32 + 16); }
        __builtin_amdgcn_sched_barrier(0);
        acc[0] = MF(ya0, yb0, acc[0]); acc[1] = MF(p0, yb0, acc[1]);
        acc[0] = MF(ya1, yb1, acc[0]); acc[1] = MF(p1, yb1, acc[1]);
        __builtin_amdgcn_sched_barrier(0);
        p0 = ya0; p1 = ya1;
    }
}
}

#define HY_LBAR() asm volatile("s_waitcnt lgkmcnt(0)\n\ts_barrier" ::: "memory")
DI void hyconv_phase(const Ctx& F, CArgs& a) {
    using namespace hy;
    unsigned char* ws = a.ws;
    const h16* UT = (const h16*)(ws + WS_BIG); h16* ZT = (h16*)(ws + WS_XIN); const h16* FILT = (const h16*)(ws + WS_FILT);
    const float* cconv = a.in[I_CCONV]; const float* skip = a.in[I_SKIP];
    LAS unsigned char* SA = F.lds + OFF_SA; LAS h16* VP = (LAS h16*)(F.lds + OFF_VP); LAS h16* GB = (LAS h16*)(F.lds + OFF_G); LAS h16* RG = (LAS h16*)(F.lds + OFF_RG);
    for (int i = F.tid; i < 8 * 512; i += NTHR) { const int b = i >> 9, p = i & 511; VP[b * VPS + (p < 256 ? p : 2048 + p)] = 0; }
    const int lane = F.lane, hi = lane >> 5, n = lane & 31, bq = n >> 2, q = n & 3;
    int ch = F.bx;
    RowRaw rx1, rv, rx2; h16 g1[8], g2[8];
    if (ch < D) { raw_load(UT, ch, F.tid, rx1); raw_load(UT, 2048 + ch, F.tid, rv); rg_load(FILT + (size_t)(0 * 1024 + ch) * L, FILT + (size_t)(1 * 1024 + ch) * L, F.tid, g1); }
    for (; ch < D; ch += F.G) {
        HY_LBAR();
        conv3_store(rx1, cconv[ch], cconv[3072 + ch], cconv[2 * 3072 + ch], GB, L, F.tid);
        conv3_store(rv, cconv[2048 + ch], cconv[3072 + 2048 + ch], cconv[2 * 3072 + 2048 + ch], VP + 256, VPS, F.tid);
        rg_store(RG, F.tid, g1);
        raw_load(UT, 1024 + ch, F.tid, rx2); rg_load(FILT + (size_t)(2 * 1024 + ch) * L, FILT + (size_t)(3 * 1024 + ch) * L, F.tid, g2);
        HY_LBAR();
        build_sa(RG, SA, F.tid);
        HY_LBAR();
        f32x16 acc[2];
        toeplitz(SA, VP, F.wave, lane, acc);
        const float sk0 = skip[ch], sk1 = skip[1024 + ch];
        u32x2 z1p[2][4];
#pragma unroll
        for (int tau = 0; tau < 2; ++tau)
#pragma unroll
            for (int g4 = 0; g4 < 4; ++g4) { const int t = 256 * F.wave + 64 * q + 32 * tau + 8 * g4 + 4 * hi;
                const f32x4 vv = unpack4(*(const LAS u32x2*)(VP + bq * VPS + 256 + t)); const f32x4 xx = unpack4(*(const LAS u32x2*)(GB + bq * L + t));
                const float o0 = xx[0] * (acc[tau][4 * g4 + 0] + vv[0] * sk0); const float o1 = xx[1] * (acc[tau][4 * g4 + 1] + vv[1] * sk0);
                const float o2 = xx[2] * (acc[tau][4 * g4 + 2] + vv[2] * sk0); const float o3 = xx[3] * (acc[tau][4 * g4 + 3] + vv[3] * sk0);
                z1p[tau][g4].x = pk2h(o0, o1); z1p[tau][g4].y = pk2h(o2, o3); }
        HY_LBAR();
#pragma unroll
        for (int tau = 0; tau < 2; ++tau)
#pragma unroll
            for (int g4 = 0; g4 < 4; ++g4) { const int t = 256 * F.wave + 64 * q + 32 * tau + 8 * g4 + 4 * hi; *(LAS u32x2*)(VP + bq * VPS + 256 + t) = z1p[tau][g4]; }
        conv3_store(rx2, cconv[1024 + ch], cconv[3072 + 1024 + ch], cconv[2 * 3072 + 1024 + ch], GB, L, F.tid);
        rg_store(RG, F.tid, g2);
        { const int nc = ch + F.G;
          if (nc < D) { raw_load(UT, nc, F.tid, rx1); raw_load(UT, 2048 + nc, F.tid, rv); rg_load(FILT + (size_t)(0 * 1024 + nc) * L, FILT + (size_t)(1 * 1024 + nc) * L, F.tid, g1); } }
        HY_LBAR();
        build_sa(RG, SA, F.tid);
        HY_LBAR();
        toeplitz(SA, VP, F.wave, lane, acc);
#pragma unroll
        for (int tau = 0; tau < 2; ++tau)
#pragma unroll
            for (int g4 = 0; g4 < 4; ++g4) { const int t = 256 * F.wave + 64 * q + 32 * tau + 8 * g4 + 4 * hi;
                const f32x4 vv = unpack4(*(const LAS u32x2*)(VP + bq * VPS + 256 + t)); const f32x4 xx = unpack4(*(const LAS u32x2*)(GB + bq * L + t));
                const float o0 = xx[0] * (acc[tau][4 * g4 + 0] + vv[0] * sk1); const float o1 = xx[1] * (acc[tau][4 * g4 + 1] + vv[1] * sk1);
                const float o2 = xx[2] * (acc[tau][4 * g4 + 2] + vv[2] * sk1); const float o3 = xx[3] * (acc[tau][4 * g4 + 3] + vv[3] * sk1);
                u32x2 w; w.x = pk2h(o0, o1); w.y = pk2h(o2, o3);
                *(u32x2*)(ZT + (size_t)ch * T + (size_t)bq * L + t) = w; }
    }
    __syncthreads();
}

DI void trans_phase(const Ctx& F, CArgs& a) {
    const h16* ZT = (const h16*)(a.ws + WS_XIN); h16* Z = (h16*)(a.ws + WS_Z);
    LAS h16* tile = (LAS h16*)(F.lds + F.wave * 16384);
    const int nitems = (D / 64) * (T / 64);
    for (int it = F.gw; it < nitems; it += F.NGW) {
        const int cb = it & 15, tb = it >> 4, c0 = cb * 64, t0 = tb * 64;
        u32x4 tw[8];
#pragma unroll
        for (int i = 0; i < 8; ++i) { const int c = (F.lane >> 3) + 8 * i, ck = F.lane & 7; tw[i] = *(const u32x4*)(ZT + (size_t)(c0 + c) * T + t0 + 8 * ck); }
        __builtin_amdgcn_sched_barrier(0);
#pragma unroll
        for (int i = 0; i < 8; ++i) { const int c = (F.lane >> 3) + 8 * i, ck = F.lane & 7; *(LAS u32x4*)(tile + c * 72 + 8 * ck) = tw[i]; }
        LDS_WAIT(); asm volatile("" ::: "memory");
#pragma unroll
        for (int i = 0; i < 8; ++i) { const int t = (F.lane >> 3) + 8 * i, ck = F.lane & 7; unsigned short v[8];
#pragma unroll
            for (int e = 0; e < 8; ++e) v[e] = tile[(8 * ck + e) * 72 + t];
            u32x4 w; w.x = v[0] | ((unsigned)v[1] << 16); w.y = v[2] | ((unsigned)v[3] << 16); w.z = v[4] | ((unsigned)v[5] << 16); w.w = v[6] | ((unsigned)v[7] << 16);
            *(u32x4*)(Z + (size_t)(t0 + t) * D + c0 + 8 * ck) = w; }
        LDS_WAIT(); asm volatile("" ::: "memory");
    }
}

enum { K_PRO = 0, K_ROWS, K_GIN, K_CONVGATE, K_GOUT, K_MOEROWS, K_TOPK, K_GMOE1, K_GMOE2, K_GQKV, K_ATTN, K_ATTNPOST, K_GHYIN, K_HYCONV, K_TRANS };
constexpr int NPHASE = 35;
DI void phase_desc(int ph, int& kind, int& layer) {
    if (ph == 0) { kind = K_PRO; layer = 0; return; }
    if (ph == 1) { kind = K_ROWS; layer = -1; return; }
    int l, r;
    if (ph < 10) { l = 0; r = ph - 2; } else if (ph < 18) { l = 1; r = ph - 10; } else if (ph < 27) { l = 2; r = ph - 18; } else { l = 3; r = ph - 27; }
    layer = l;
    const int nmix = (l == 2) ? 4 : 3;
    if (r >= nmix) { const int m = r - nmix; kind = m == 0 ? K_MOEROWS : m == 1 ? K_TOPK : m == 2 ? K_GMOE1 : m == 3 ? K_GMOE2 : K_ROWS; return; }
    if (l == 0 || l == 3) kind = r == 0 ? K_GIN : r == 1 ? K_CONVGATE : K_GOUT;
    else if (l == 1) kind = r == 0 ? K_GQKV : r == 1 ? K_ATTN : K_GOUT;
    else kind = r == 0 ? K_GHYIN : r == 1 ? K_HYCONV : r == 2 ? K_TRANS : K_GOUT;
}

__global__ void __launch_bounds__(NTHR, 2) mk_fwd(Args a_) {
    extern __shared__ __attribute__((aligned(16))) unsigned char lds_raw[];
    cg::grid_group grid = cg::this_grid();
    const int ph_lo = a_.ph_lo, ph_hi = a_.ph_hi;
    { volatile LAS unsigned* st0 = (volatile LAS unsigned*)((LAS unsigned char*)lds_raw + LDS_CTL_OFF); if (threadIdx.x < 16) st0[threadIdx.x] = 0u; }
    __syncthreads();
    XcdBarrier xbar = xcd_barrier_post((unsigned*)(a_.ws + WS_CTL) + 4096, (volatile LAS unsigned*)((LAS unsigned char*)lds_raw + LDS_CTL_OFF));
    int wave_s = __builtin_amdgcn_readfirstlane((int)(threadIdx.x >> 6)); asm volatile("" : "+s"(wave_s));
    for (int ph = ph_lo; ph < ph_hi; ++ph) {
#define MK_CTX Ctx F; { unsigned am_ = ~0u; asm volatile("" : "+s"(am_)); int tid_ = wave_s * 64 + (int)__builtin_amdgcn_mbcnt_hi(am_, __builtin_amdgcn_mbcnt_lo(am_, 0u)); asm volatile("" : "+v"(tid_)); int bx = blockIdx.x; asm volatile("" : "+s"(bx)); \
          F.lds = (LAS unsigned char*)lds_raw; F.tid = tid_; F.lane = tid_ & 63; F.wave = __builtin_amdgcn_readfirstlane(tid_ >> 6); \
          int G_ = gridDim.x; asm volatile("" : "+s"(G_)); F.G = G_; F.bx = bx; F.vcu = (F.G % 8 == 0) ? (bx % 8) * (F.G / 8) + bx / 8 : bx; \
          F.gw = F.vcu * NWAVES + F.wave; F.NGW = F.G * NWAVES; }
        CArgs* apl = (CArgs*)__builtin_amdgcn_kernarg_segment_ptr(); asm volatile("" : "+s"(apl)); CArgs& a = *apl;
        unsigned char* ws = a.ws;
        int kind, l; phase_desc(ph, kind, l);
        const bool dbg_final = (ph > DBG_STOP);
        if (dbg_final && ph != NPHASE - 1) continue;
        if (dbg_final) { kind = K_ROWS; }
#ifdef ONLY_KIND
        kind = ONLY_KIND;
#endif
        const unsigned long long amp_t0 = DBG_AMP_MASK ? __builtin_amdgcn_s_memrealtime() : 0ull;
        switch (kind) {
        case K_PRO: { MK_CTX; p0_prologue(F, a); } break;
        case K_ROWS: { MK_CTX;
            const bool first = (l < 0) && !dbg_final, fin = dbg_final || l == 3;
            const int lm = l < 0 ? 0 : l;
            rows_phase(F, a, (first || lm == 0) && !dbg_final ? TT : T, first, !first && !dbg_final, lm, lm + (first ? 0 : 1), fin, dbg_final && DBG_CHECK);
        } break;
        case K_GIN: { MK_CTX; const int j = l == 0 ? 0 : 1;
            pg8::SchedPlain S{l == 0 ? 72 : 64, 12, F.G, F.bx}; pg8::EpiGin E{(h16*)(ws + WS_BIG)};
            pg8::gemm_phase<false, false>(F.lds, F.tid, (const h16*)(ws + WS_H), (const h16*)(ws + WS_WAIN) + (size_t)j * 3072 * 1024, 1024, S, E); } break;
        case K_CONVGATE: { MK_CTX; convgate_phase(F, a, l == 0 ? 0 : 1, l == 0 ? TT : T); } break;
        case K_GOUT: { MK_CTX; const h16* W = l == 0 ? (const h16*)(ws + WS_WAOUT) : l == 1 ? (const h16*)(ws + WS_WBOUT) : l == 2 ? (const h16*)(ws + WS_WCOUT) : (const h16*)(ws + WS_WAOUT) + (size_t)1024 * 1024;
            pg8::SchedPlain S{l == 0 ? 72 : 64, 4, F.G, F.bx}; pg8::EpiResid E{(h16*)(ws + WS_XC), (const float*)(ws + WS_MOD) + (size_t)l * 9 * 6144, 2048};
            pg8::gemm_phase<false, false>(F.lds, F.tid, (const h16*)(ws + WS_Z), W, 1024, S, E); } break;
        case K_MOEROWS: { MK_CTX; moe_rows_phase(F, a, l, l == 0 ? TT : T); } break;
        case K_TOPK: { MK_CTX; topk_phase(F, a, l); } break;
        case K_GMOE1: { MK_CTX; pg8::SchedMoe S{l == 0 ? 144 : 128, 8, F.G, F.bx, 8}; pg8::EpiSwiglu8 E{(unsigned char*)(ws + WS_BIG)};
            pg8::gemm_phase<true, true>(F.lds, F.tid, (const h16*)(ws + WS_Z), (const h16*)(ws + WS_WGU + (size_t)l * 16 * 2048 * 1024), 512, S, E, (const int*)(ws + WS_GATE + 512 * 1024)); } break;
        case K_GMOE2: { MK_CTX; pg8::SchedMoe S{l == 0 ? 144 : 128, 4, F.G, F.bx, 4}; pg8::EpiDown8 E{(unsigned char*)(ws + WS_XIN), (const float*)(ws + WS_GATE)};
            pg8::gemm_phase<false, true>(F.lds, F.tid, (const h16*)(ws + WS_BIG), (const h16*)(ws + WS_WDN + (size_t)l * 16 * 1024 * 1024), 512, S, E); } break;
        case K_GQKV: { MK_CTX; pg8::SchedQkv S{F.G, F.bx};
            h16* Q = (h16*)(ws + WS_BIG); h16* Kb = Q + (size_t)T * D; h16* Vb = Kb + (size_t)NB * KVR * D;
            pg8::EpiQkv E{Q, Kb, Vb, (const float*)(ws + WS_SMALL), (const float*)(ws + WS_SMALL) + 1024};
            pg8::gemm_phase<false, false>(F.lds, F.tid, (const h16*)(ws + WS_H), (const h16*)(ws + WS_WQKV), 1024, S, E); } break;
        case K_ATTN: { MK_CTX; attn_phase(F, a); } break;
        case K_ATTNPOST: { MK_CTX; attn_post_phase(F, a); } break;
        case K_GHYIN: { MK_CTX; pg8::SchedPlain S{12, 64, F.G, F.bx}; pg8::EpiPlain E{(h16*)(ws + WS_BIG), T};
            pg8::gemm_phase<false, false>(F.lds, F.tid, (const h16*)(ws + WS_WCIN), (const h16*)(ws + WS_H), 1024, S, E); } break;
        case K_HYCONV: { MK_CTX; hyconv_phase(F, a); } break;
        case K_TRANS: { MK_CTX; trans_phase(F, a); } break;
        default: break;
        }
        if (DBG_AMP_MASK && ((DBG_AMP_MASK >> kind) & 1)) { const unsigned long long t1 = __builtin_amdgcn_s_memrealtime(); const unsigned long long dt = (t1 - amp_t0) * DBG_AMP_M; while (__builtin_amdgcn_s_memrealtime() - t1 < dt) __builtin_amdgcn_s_sleep(8); }
        if (ph + 1 < ph_hi) { if (ph_lo < -1) grid.sync();
            unsigned am2_ = ~0u; asm volatile("" : "+s"(am2_));
            xcd_barrier(xbar, wave_s == 0 && __builtin_amdgcn_mbcnt_hi(am2_, __builtin_amdgcn_mbcnt_lo(am2_, 0u)) == 0u); }
    }
}

#if DBG_CHECK
__device__ unsigned dbg_hash(unsigned x) { x ^= x >> 16; x *= 0x7feb352dU; x ^= x >> 15; x *= 0x846ca68bU; x ^= x >> 16; return x; }
__global__ void dbg_check_gemm(const h16* A, const float* W, int N, const h16* O, int ldo, int nrows, float* accum) {
    const unsigned id = blockIdx.x * blockDim.x + threadIdx.x;
    const int row = dbg_hash(id * 2 + 1) % nrows, col = dbg_hash(id * 2 + 2) % N;
    float s = 0.f;
    for (int k = 0; k < 1024; ++k) s += h2f(A[(size_t)row * 1024 + k]) * W[(size_t)k * N + col];
    const float o = h2f(O[(size_t)row * ldo + col]);
    atomicAdd(accum, (o - s) * (o - s)); atomicAdd(accum + 1, s * s);
}
__global__ void dbg_check_convgate(const h16* BCV, const float* cw, const h16* Z, int nrows, float* accum) {
    const unsigned id = blockIdx.x * blockDim.x + threadIdx.x;
    const int row = dbg_hash(id * 2 + 1) % nrows, c = dbg_hash(id * 2 + 2) % 1024;
    const int ls = row < T ? L : LC; const int t = row < T ? (row % L) : ((row - T) % LC);
    auto u = [&](int r) { return h2f(BCV[(size_t)r * 3072 + 1024 + c]) * h2f(BCV[(size_t)r * 3072 + 2048 + c]); };
    float s = cw[1024 + c] * u(row);
    if (t > 0) s += cw[c] * u(row - 1);
    if (t + 1 < ls) s += cw[2048 + c] * u(row + 1);
    s *= h2f(BCV[(size_t)row * 3072 + c]);
    const float o = h2f(Z[(size_t)row * 1024 + c]);
    atomicAdd(accum, (o - s) * (o - s)); atomicAdd(accum + 1, s * s);
}
__global__ void dbg_check_resid(const h16* Zb, const float* W, const float* XC, const float* xin, const float* gate  , float* accum) {
    const unsigned id = blockIdx.x * blockDim.x + threadIdx.x;
    const int row = dbg_hash(id * 2 + 1) % T, col = dbg_hash(id * 2 + 2) % 1024;
    float s = 0.f;
    for (int k = 0; k < 1024; ++k) s += h2f(Zb[(size_t)row * 1024 + k]) * W[(size_t)k * 1024 + col];
    s *= gate[(size_t)(row / L) * 6144 + col];
    const float o = XC[(size_t)row * 1024 + col] - xin[(size_t)row * 1024 + col];
    atomicAdd(accum, (o - s) * (o - s)); atomicAdd(accum + 1, s * s);
}
__global__ void dbg_encode(float* out, const float* accum, int n) {
    const float e = sqrtf(accum[0] / fmaxf(accum[1], 1e-30f));
    const float k = fminf(fmaxf(log10f(fmaxf(e, 1e-20f)) + 7.f, 0.f), 8.f);
    const float s = 1.f + k;
    for (int i = blockIdx.x * blockDim.x + threadIdx.x; i < n; i += gridDim.x * blockDim.x) out[i] *= s;
}
#endif

extern "C" void kernel_launch(void* const* d_in, const int* in_sizes, int n_in, void* d_out, int out_size, void* d_ws, size_t ws_size, hipStream_t stream) {
    static int grid = 0;
    if (grid == 0) {
        if (n_in != 34 || in_sizes[0] != T * D || out_size != T * D || ws_size < WS_END) { fprintf(stderr, "kernel_launch: unexpected shapes / workspace (n_in %d, in0 %d, out %d, ws %zu); nothing launched\n", n_in, n_in > 0 ? in_sizes[0] : -1, out_size, ws_size); grid = -1; return; }
        int dev = 0, cus = 0, per_cu = 0;
        if (hipGetDevice(&dev) != hipSuccess || hipDeviceGetAttribute(&cus, hipDeviceAttributeMultiprocessorCount, dev) != hipSuccess) { fprintf(stderr, "kernel_launch: device query failed\n"); grid = -1; return; }
        if (hipFuncSetAttribute((const void*)mk_fwd, hipFuncAttributeMaxDynamicSharedMemorySize, LDS_BYTES) != hipSuccess) { fprintf(stderr, "kernel_launch: hipFuncSetAttribute failed\n"); grid = -1; return; }
        if (hipOccupancyMaxActiveBlocksPerMultiprocessor(&per_cu, (const void*)mk_fwd, NTHR, LDS_BYTES) != hipSuccess || per_cu < 1) { fprintf(stderr, "kernel_launch: occupancy query says %d\n", per_cu); (void)hipGetLastError(); per_cu = 1; }
        grid = cus * 1;
    }
    if (grid < 0) return;
    (void)hipMemsetAsync((char*)d_ws + WS_CTL, 0, CTL_ZERO_BYTES, stream);
    Args a{};
    for (int i = 0; i < 34; ++i) a.in[i] = (const float*)d_in[i];
    a.out = (float*)d_out; a.ws = (unsigned char*)d_ws;
    constexpr int NPH = NPHASE;
#if MK_N_LAUNCHES == 1
    a.ph_lo = 0; a.ph_hi = NPH;
    void* args[] = {&a};
    hipError_t e = hipLaunchCooperativeKernel((const void*)mk_fwd, dim3(grid), dim3(NTHR), args, LDS_BYTES, stream);
    if (e != hipSuccess) fprintf(stderr, "kernel_launch: cooperative launch failed: %s (grid %d)\n", hipGetErrorString(e), grid);
#else
    for (int ph = 0; ph < NPH; ++ph) { a.ph_lo = ph; a.ph_hi = ph + 1; hipLaunchKernelGGL(mk_fwd, dim3(grid), dim3(NTHR), LDS_BYTES, stream, a); }
#endif
#if DBG_CHECK
    {
        unsigned char* ws = (unsigned char*)d_ws; float* accum = (float*)(ws + WS_CTL + 512 * 1024);
        (void)hipMemsetAsync(accum, 0, 64, stream);
        if (DBG_CHECK == 1) hipLaunchKernelGGL(dbg_check_gemm, dim3(64), dim3(256), 0, stream, (const h16*)(ws + WS_H), (const float*)d_in[I_AWIN], 3072, (const h16*)(ws + WS_BIG), 3072, TT, accum);
        if (DBG_CHECK == 2)
            hipLaunchKernelGGL(dbg_check_convgate, dim3(64), dim3(256), 0, stream, (const h16*)(ws + WS_BIG), (const float*)d_in[I_ACONV], (const h16*)(ws + WS_Z), TT, accum);
        if (DBG_CHECK == 3)
            hipLaunchKernelGGL(dbg_check_resid, dim3(64), dim3(256), 0, stream, (const h16*)(ws + WS_Z), (const float*)d_in[I_AWOUT], (const float*)(ws + WS_XC), (const float*)d_in[I_X], (const float*)(ws + WS_MOD) + 2048, accum);
        hipLaunchKernelGGL(dbg_encode, dim3(1024), dim3(256), 0, stream, (float*)d_out, (const float*)accum, T * D);
    }
#endif
}
```

```cpp
#include <hip/hip_runtime.h>
#include <hip/hip_cooperative_groups.h>
#include <cstdio>
#include <cstdint>
#include <cmath>
namespace cg = cooperative_groups;

#define LAS __attribute__((address_space(3)))
#define GAS __attribute__((address_space(1)))
#define DI __device__ __forceinline__

typedef unsigned short h16;
typedef _Float16 hf;
typedef _Float16 half8 __attribute__((ext_vector_type(8)));
typedef _Float16 half4 __attribute__((ext_vector_type(4)));
typedef _Float16 half2v __attribute__((ext_vector_type(2)));
typedef short s16x8 __attribute__((ext_vector_type(8)));
typedef short s16x4 __attribute__((ext_vector_type(4)));
typedef float f32x2 __attribute__((ext_vector_type(2)));
typedef float f32x4 __attribute__((ext_vector_type(4)));
typedef float f32x16 __attribute__((ext_vector_type(16)));
typedef unsigned u32x2 __attribute__((ext_vector_type(2)));
typedef unsigned u32x4 __attribute__((ext_vector_type(4)));

#ifndef MK_N_LAUNCHES
#define MK_N_LAUNCHES 1
#endif
#ifndef DBG_CHECK
#define DBG_CHECK 0
#endif
#ifndef DBG_AMP_MASK
#define DBG_AMP_MASK 0
#endif
#define DBG_AMP_M 4
#ifndef DBG_STOP
#define DBG_STOP 35
#endif

constexpr int D = 1024, NB = 8, L = 2048, T = NB * L, LC = 256, TC = NB * LC, TT = T + TC;
constexpr int NE = 16, CAP = 256, CAPC = 32, NH = 8;
constexpr int NGL = NE * NB * CAP, NGC = NE * NB * CAPC, NG = NGL + NGC;
constexpr int KVR = LC + L;
constexpr int NWAVES = 8, NTHR = 512;

constexpr size_t MiB = 1u << 20;
constexpr size_t WS_CTL = 0, WS_MOD = 1 * MiB, WS_SMALL = 2 * MiB, WS_AFF = 3 * MiB, WS_SLOT = 5 * MiB, WS_GATE = 7 * MiB, WS_FILT = 8 * MiB;
constexpr size_t WS_WAIN = 24 * MiB, WS_WAOUT = 36 * MiB, WS_WQKV = 40 * MiB, WS_WBOUT = 46 * MiB, WS_WCIN = 48 * MiB, WS_WCOUT = 54 * MiB;
constexpr size_t WS_WGU = 56 * MiB, WS_WDN = 312 * MiB;
constexpr size_t WS_XC = 440 * MiB, WS_H = 512 * MiB, WS_BIG = 548 * MiB, WS_Z = 656 * MiB, WS_XIN = 692 * MiB, WS_END = 764 * MiB;
constexpr size_t CTL_ZERO_BYTES = 1 * MiB;

constexpr int LDS_BYTES = 160 * 1024;
constexpr int LDS_CTL_OFF = 159 * 1024;

DI unsigned pk2h(float lo, float hi) { f32x2 v = {lo, hi}; half2v h = __builtin_convertvector(v, half2v); return __builtin_bit_cast(unsigned, h); }
DI unsigned pk4f8(float a, float b, float c, float d) {
    a = __builtin_amdgcn_fmed3f(a, -448.f, 448.f); b = __builtin_amdgcn_fmed3f(b, -448.f, 448.f); c = __builtin_amdgcn_fmed3f(c, -448.f, 448.f); d = __builtin_amdgcn_fmed3f(d, -448.f, 448.f);
    int w = 0; w = __builtin_amdgcn_cvt_pk_fp8_f32(a, b, w, false); w = __builtin_amdgcn_cvt_pk_fp8_f32(c, d, w, true); return (unsigned)w; }
DI float h2f(h16 v) { return (float)__builtin_bit_cast(hf, v); }
DI f32x4 unpack4(const u32x2 w) { const half4 h = __builtin_bit_cast(half4, w); return (f32x4){(float)h[0], (float)h[1], (float)h[2], (float)h[3]}; }
DI float sx(float v, int mask, int lane) { return __builtin_bit_cast(float, __builtin_amdgcn_ds_bpermute((lane ^ mask) << 2, __builtin_bit_cast(int, v))); }
DI float wave_sum(float v, int lane) {
#pragma unroll
    for (int o = 1; o < 64; o <<= 1) v += sx(v, o, lane);
    return v;
}
DI float silu_f(float a) { return a * __builtin_amdgcn_rcpf(1.f + __builtin_amdgcn_exp2f(-1.4426950408889634f * a)); }
DI void unpack8(const u32x4 w, float (&o)[8]) {
    const half8 h = __builtin_bit_cast(half8, w);
#pragma unroll
    for (int i = 0; i < 8; ++i) o[i] = (float)h[i];
}
#define LDS_WAIT() asm volatile("s_waitcnt lgkmcnt(0)" ::: "memory")
#define VM_WAIT() asm volatile("s_waitcnt vmcnt(0)" ::: "memory")

namespace pg8 {
constexpr int BM = 256, BK = 64, HALF = 128, HTB = HALF * BK * 2, STAGE_BYTES = 8 * HTB, NXCD = 8, WGM = 8;
DI int lds_byte(int r, int c) { const int st = (r >> 4) * 2 + (c >> 5), rr = r & 15, cc = c & 31, ob = rr * 64 + cc * 2; return st * 1024 + (ob ^ (((ob >> 9) & 1) << 5)); }
DI void stage_rc(int b, int& R, int& C) { const int st = b / 1024, sb = b % 1024, swz = sb ^ (((sb >> 9) & 1) << 5); R = (st >> 1) * 16 + swz / 64; C = (st & 1) * 32 + (swz % 64) / 2; }
DI int perm32(int rho) { const int n = rho >> 4, i = rho & 15; return 8 * (i >> 2) + 4 * n + (i & 3); }

struct Unit { int pm, pn, ta, tb; };

DI bool tile_order(int i, int nM, int nN, int G, int c, int& pm, int& pn) {
    const int nwg = nM * nN; const long Lx = (long)i * G + c; if (Lx >= nwg) return false;
    int wgid = (int)Lx; { const int q = nwg / NXCD, r = nwg % NXCD, xcd = wgid % NXCD, off = wgid / NXCD; wgid = (xcd < r ? xcd * (q + 1) : r * (q + 1) + (xcd - r) * q) + off; }
    const int nig = WGM * nN, gid = wgid / nig, fm = gid * WGM, gsz = (nM - fm) < WGM ? (nM - fm) : WGM;
    pm = fm + ((wgid % nig) % gsz); pn = (wgid % nig) / gsz; return true;
}

typedef int v8i_t __attribute__((ext_vector_type(8)));
typedef int v4i_t __attribute__((ext_vector_type(4)));
template <bool GATHER, bool FP8, class Epi, class Sched>
DI void gemm_phase(LAS unsigned char* lds, const int tid, const h16* Ag, const h16* Btg, const int K, const Sched& S, const Epi& E, const int* SEL = nullptr) {
    const int wid = __builtin_amdgcn_readfirstlane(tid >> 6), lane = tid & 63, wr = wid >> 2, wc = wid & 3, fr = lane & 15, fq = lane >> 4;
    const int nt = K / BK;
    unsigned voffA[2], voffB[2];
#pragma unroll
    for (int i = 0; i < 2; ++i) { int R, C; stage_rc(tid * 16 + i * 8192, R, C); const int Rb = (R & ~31) + perm32(R & 31);
        voffA[i] = (unsigned)(R * K + C) * 2u; voffB[i] = (unsigned)(Rb * K + C) * 2u; }
    const size_t kstep = (size_t)(BK * 2);
    const size_t hstep = (size_t)HALF * K * 2;
    const size_t tstep = 2 * hstep;
    const unsigned ldsw = (unsigned)wid * 1024u;
    const int aoff = lds_byte(wr * 64 + fr, fq * 8), boff = lds_byte(wc * 32 + fr, fq * 8);
#define PG8_SA(b, h) (((b) * 2 + (h)) * HTB)
#define PG8_SB(b, h) ((4 + (b) * 2 + (h)) * HTB)
#define PG8_STAGE(bufoff, gbase, voff) do { _Pragma("unroll") for (int _i = 0; _i < 2; ++_i) \
        __builtin_amdgcn_global_load_lds((const unsigned*)((const char*)(gbase) + (voff)[_i]), (LAS unsigned*)(lds + (bufoff) + ldsw + _i * 8192), 16, 0, 0); } while (0)
#define PG8_STAGE_A(bufoff, gbase, h, gsel) do { if constexpr (GATHER) { PG8_STAGE(bufoff, gbase, (gsel)[h]); } else { PG8_STAGE(bufoff, (gbase) + (h) * hstep, voffA); } } while (0)
#define PG8_LOAD_G(g, ta_) do { _Pragma("unroll") for (int h_ = 0; h_ < 2; ++h_) _Pragma("unroll") for (int i_ = 0; i_ < 2; ++i_) { int R_, C_; stage_rc(tid * 16 + i_ * 8192, R_, C_); \
        const int row_ = SEL[(ta_) * BM + h_ * HALF + R_]; (g)[h_][i_] = (unsigned)(row_ * K + C_) * 2u; } } while (0)
#define PG8_LDA(dst, b, h) do { if constexpr (FP8) { _Pragma("unroll") for (int m = 0; m < 4; ++m) dst##8[m] = __builtin_shufflevector(*(const LAS v4i_t*)(lds + PG8_SA(b, h) + aoff + m * 2048), *(const LAS v4i_t*)(lds + PG8_SA(b, h) + aoff + m * 2048 + 1024), 0, 1, 2, 3, 4, 5, 6, 7); } \
        else { _Pragma("unroll") for (int m = 0; m < 4; ++m) _Pragma("unroll") for (int k = 0; k < 2; ++k) dst[m][k] = *(const LAS half8*)(lds + PG8_SA(b, h) + aoff + m * 2048 + k * 1024); } } while (0)
#define PG8_LDB(dst, b, h) do { if constexpr (FP8) { _Pragma("unroll") for (int n = 0; n < 2; ++n) dst##8[n] = __builtin_shufflevector(*(const LAS v4i_t*)(lds + PG8_SB(b, h) + boff + n * 2048), *(const LAS v4i_t*)(lds + PG8_SB(b, h) + boff + n * 2048 + 1024), 0, 1, 2, 3, 4, 5, 6, 7); } \
        else { _Pragma("unroll") for (int n = 0; n < 2; ++n) _Pragma("unroll") for (int k = 0; k < 2; ++k) dst[n][k] = *(const LAS half8*)(lds + PG8_SB(b, h) + boff + n * 2048 + k * 1024); } } while (0)
#define PG8_CAT8(x0, x1) __builtin_shufflevector(__builtin_bit_cast(v4i_t, x0), __builtin_bit_cast(v4i_t, x1), 0, 1, 2, 3, 4, 5, 6, 7)
#define PG8_MMA(ai, bj, At, Bt) do { __builtin_amdgcn_s_setprio(1); \
        if constexpr (FP8) { _Pragma("unroll") for (int m = 0; m < 4; ++m) _Pragma("unroll") for (int n = 0; n < 2; ++n) \
            asm volatile("v_mfma_scale_f32_16x16x128_f8f6f4 %0, %1, %2, %0, %3, %3 op_sel_hi:[0,0,0]" : "+v"(acc[ai][bj][m][n]) : "v"(Bt##8[n]), "v"(At##8[m]), "v"(sc1)); } \
        else { _Pragma("unroll") for (int m = 0; m < 4; ++m) _Pragma("unroll") for (int n = 0; n < 2; ++n) _Pragma("unroll") for (int k = 0; k < 2; ++k) \
            acc[ai][bj][m][n] = __builtin_amdgcn_mfma_f32_16x16x32_f16(Bt[n][k], At[m][k], acc[ai][bj][m][n], 0, 0, 0); } \
        __builtin_amdgcn_s_setprio(0); } while (0)
#define PG8_WAIT_V(n) asm volatile("s_waitcnt vmcnt(" #n ")" ::: "memory")
#define PG8_WAIT_L(n) asm volatile("s_waitcnt lgkmcnt(" #n ")" ::: "memory")
#define PG8_BAR __builtin_amdgcn_s_barrier()
#define PG8_SCHED __builtin_amdgcn_sched_barrier(0)
    Unit cur, nxt; int ui = 0;
    if (!S.next(0, cur)) return;
    f32x4 acc[2][2][4][2];
    half8 At[4][2], B0[2][2], B1[2][2];
    v8i_t At8[4], B08[2], B18[2];
    int sc1 = 0x7F7F7F7F; asm volatile("" : "+v"(sc1));
    const char* cA = (const char*)Ag + (GATHER ? (size_t)0 : (size_t)cur.ta * tstep); const char* cB = (const char*)Btg + (size_t)cur.tb * tstep;
    unsigned gC[2][2], gN[2][2], gNN[2][2];
    if constexpr (GATHER) { PG8_LOAD_G(gC, cur.ta); Unit t1; if (S.next(1, t1)) { PG8_LOAD_G(gN, t1.ta); } else { PG8_LOAD_G(gN, cur.ta); }
        _Pragma("unroll") for (int h_ = 0; h_ < 2; ++h_) _Pragma("unroll") for (int i_ = 0; i_ < 2; ++i_) gNN[h_][i_] = gN[h_][i_]; }
    PG8_STAGE(PG8_SB(0, 0), cB, voffB); PG8_STAGE(PG8_SB(0, 1), cB + hstep, voffB); PG8_STAGE_A(PG8_SA(0, 0), cA, 0, gC); PG8_STAGE_A(PG8_SA(0, 1), cA, 1, gC);
    if (wr == 1) PG8_BAR;
    PG8_WAIT_V(2); PG8_BAR;
    PG8_STAGE(PG8_SB(1, 0), cB + kstep, voffB); PG8_STAGE_A(PG8_SA(1, 0), cA + kstep, 0, gC); PG8_STAGE(PG8_SB(1, 1), cB + hstep + kstep, voffB);
    PG8_WAIT_V(6); PG8_BAR;
#pragma unroll
    for (int a = 0; a < 2; ++a)
#pragma unroll
        for (int b = 0; b < 2; ++b)
#pragma unroll
            for (int m = 0; m < 4; ++m)
#pragma unroll
                for (int n = 0; n < 2; ++n) acc[a][b][m][n] = (f32x4){0.f, 0.f, 0.f, 0.f};
    for (;;) {
        const bool has_next = S.next(ui + 1, nxt);
        const char* nA = (has_next && !GATHER) ? (const char*)Ag + (size_t)nxt.ta * tstep : cA; const char* nB = has_next ? (const char*)Btg + (size_t)nxt.tb * tstep : cB;
        for (int t = 0; t < nt; t += 2) {
            const bool last = (t == nt - 2);
            const char* a1 = cA + (size_t)(t + 1) * kstep;
            const char* a2 = last ? nA : cA + (size_t)(t + 2) * kstep; const char* b2 = last ? nB : cB + (size_t)(t + 2) * kstep;
            const char* a3 = a2 + kstep; const char* b3 = b2 + kstep;
            unsigned gS[2][2];
            if constexpr (GATHER) { _Pragma("unroll") for (int h_ = 0; h_ < 2; ++h_) _Pragma("unroll") for (int i_ = 0; i_ < 2; ++i_) gS[h_][i_] = last ? gN[h_][i_] : gC[h_][i_]; }
            PG8_LDB(B0, 0, 0); PG8_LDB(B1, 0, 1); PG8_SCHED; PG8_LDA(At, 0, 0); PG8_STAGE_A(PG8_SA(1, 1), a1, 1, gC);
            PG8_WAIT_V(8); PG8_WAIT_L(0); PG8_BAR; PG8_MMA(0, 0, At, B0); PG8_MMA(0, 1, At, B1); PG8_BAR; PG8_SCHED;
            PG8_LDA(At, 0, 1); PG8_STAGE(PG8_SB(0, 0), b2, voffB); PG8_STAGE(PG8_SB(0, 1), b2 + hstep, voffB); PG8_STAGE_A(PG8_SA(0, 0), a2, 0, gS);
            PG8_WAIT_V(8); PG8_WAIT_L(0); PG8_BAR; PG8_MMA(1, 0, At, B0); PG8_MMA(1, 1, At, B1); PG8_BAR; PG8_SCHED;
            PG8_LDB(B0, 1, 0); PG8_LDB(B1, 1, 1); PG8_SCHED; PG8_LDA(At, 1, 0); PG8_STAGE_A(PG8_SA(0, 1), a2, 1, gS);
            PG8_WAIT_V(8); PG8_WAIT_L(0); PG8_BAR; PG8_MMA(0, 0, At, B0); PG8_MMA(0, 1, At, B1); PG8_BAR; PG8_SCHED;
            PG8_LDA(At, 1, 1); PG8_STAGE(PG8_SB(1, 0), b3, voffB); PG8_STAGE(PG8_SB(1, 1), b3 + hstep, voffB); PG8_STAGE_A(PG8_SA(1, 0), a3, 0, gS);
            PG8_WAIT_V(8); PG8_WAIT_L(0); PG8_BAR; PG8_MMA(1, 0, At, B0); PG8_MMA(1, 1, At, B1); PG8_BAR; PG8_SCHED;
        }
        if (wr == 0) PG8_BAR;
        if constexpr (FP8) asm volatile("s_nop 15\n\ts_nop 15" ::: "memory");
        if constexpr (GATHER) { Unit t2; if (has_next && S.next(ui + 2, t2)) { PG8_LOAD_G(gNN, t2.ta); } }
        { int fr_ = fr, fq_ = fq; asm volatile("" : "+v"(fr_), "+v"(fq_)); E(acc, cur, wr, wc, fr_, fq_); }
        if (!has_next) break;
#pragma unroll
        for (int a = 0; a < 2; ++a)
#pragma unroll
            for (int b = 0; b < 2; ++b)
#pragma unroll
                for (int m = 0; m < 4; ++m)
#pragma unroll
                    for (int n = 0; n < 2; ++n) acc[a][b][m][n] = (f32x4){0.f, 0.f, 0.f, 0.f};
        cur = nxt; cA = nA; cB = nB; ++ui;
        if constexpr (GATHER) { _Pragma("unroll") for (int h_ = 0; h_ < 2; ++h_) _Pragma("unroll") for (int i_ = 0; i_ < 2; ++i_) { gC[h_][i_] = gN[h_][i_]; gN[h_][i_] = gNN[h_][i_]; } }
        if (wr == 1) PG8_BAR;
    }
    PG8_WAIT_V(0);
    PG8_BAR;
#undef PG8_SA
#undef PG8_SB
#undef PG8_STAGE
#undef PG8_STAGE_A
#undef PG8_LOAD_G
#undef PG8_LDA
#undef PG8_LDB
#undef PG8_MMA
#undef PG8_CAT8
#undef PG8_WAIT_V
#undef PG8_WAIT_L
#undef PG8_BAR
#undef PG8_SCHED
}

struct SchedPlain {
    int nM, nN, G, c;
    DI bool next(int i, Unit& u) const { if (!tile_order(i, nM, nN, G, c, u.pm, u.pn)) return false; u.ta = u.pm; u.tb = u.pn; return true; }
};
struct SchedMoe {
    int nM, nN, G, c, tpe;
    DI bool next(int i, Unit& u) const { if (!tile_order(i, nM, nN, G, c, u.pm, u.pn)) return false; const int e = u.pm < 128 ? (u.pm >> 3) : (u.pm - 128); u.ta = u.pm; u.tb = e * tpe + u.pn; return true; }
};
struct SchedQkv {
    int G, c;
    DI bool next(int i, Unit& u) const {
        const long Lx = (long)i * G + c;
        if (Lx < 768) { tile_order(i, 64, 12, G, c, u.pm, u.pn); u.ta = u.pm; u.tb = u.pn; return true; }
        const int r = (int)(Lx - 768); if (r >= 64) return false;
        u.pm = 64 + (r & 7); u.pn = 4 + (r >> 3); u.ta = u.pm; u.tb = u.pn; return true;
    }
};

struct EpiPlain {
    h16* O; int ldc;
    DI void operator()(const f32x4 (&acc)[2][2][4][2], const Unit& u, int wr, int wc, int fr, int fq) const {
        const int row0 = u.pm * BM + wr * 64 + fr, col0 = u.pn * BM + wc * 32 + 8 * fq;
#pragma unroll
        for (int ai = 0; ai < 2; ++ai)
#pragma unroll
            for (int m = 0; m < 4; ++m) { h16* rowp = O + (size_t)(row0 + ai * HALF + m * 16) * ldc + col0;
#pragma unroll
                for (int bj = 0; bj < 2; ++bj) { const f32x4 v0 = acc[ai][bj][m][0], v1 = acc[ai][bj][m][1];
                    u32x4 w; w.x = pk2h(v0[0], v0[1]); w.y = pk2h(v0[2], v0[3]); w.z = pk2h(v1[0], v1[1]); w.w = pk2h(v1[2], v1[3]);
                    *(u32x4*)(rowp + bj * HALF) = w; } }
    }
};
struct EpiGin {
    h16* O;
    DI void operator()(const f32x4 (&acc)[2][2][4][2], const Unit& u, int wr, int wc, int fr, int fq) const {
        const int row0 = u.pm * BM + wr * 64 + fr;
        if (u.pn < 4) {
            const int col0 = u.pn * BM + wc * 32 + 8 * fq;
#pragma unroll
            for (int ai = 0; ai < 2; ++ai)
#pragma unroll
                for (int m = 0; m < 4; ++m) { h16* rowp = O + (size_t)(row0 + ai * HALF + m * 16) * 2048 + col0;
#pragma unroll
                    for (int bj = 0; bj < 2; ++bj) { const f32x4 v0 = acc[ai][bj][m][0], v1 = acc[ai][bj][m][1];
                        u32x4 w; w.x = pk2h(v0[0], v0[1]); w.y = pk2h(v0[2], v0[3]); w.z = pk2h(v1[0], v1[1]); w.w = pk2h(v1[2], v1[3]);
                        *(u32x4*)(rowp + bj * HALF) = w; } }
        } else {
            const int col0 = 1024 + (u.pn - 4) * HALF + wc * 32 + 8 * fq;
#pragma unroll
            for (int ai = 0; ai < 2; ++ai)
#pragma unroll
                for (int m = 0; m < 4; ++m) { const f32x4 p0 = acc[ai][0][m][0] * acc[ai][1][m][0], p1 = acc[ai][0][m][1] * acc[ai][1][m][1];
                    u32x4 w; w.x = pk2h(p0[0], p0[1]); w.y = pk2h(p0[2], p0[3]); w.z = pk2h(p1[0], p1[1]); w.w = pk2h(p1[2], p1[3]);
                    *(u32x4*)(O + (size_t)(row0 + ai * HALF + m * 16) * 2048 + col0) = w; }
        }
    }
};
struct EpiResid {
    h16* XC; const float* modl; int goff;
    DI void operator()(const f32x4 (&acc)[2][2][4][2], const Unit& u, int wr, int wc, int fr, int fq) const {
        const int row0 = u.pm * BM + wr * 64 + fr, col0 = u.pn * BM + wc * 32 + 8 * fq;
        const int r9 = u.pm < 64 ? (u.pm >> 3) : 8;
        const float* g = modl + r9 * 6144 + goff + col0;
        f32x4 gv[2][2];
#pragma unroll
        for (int bj = 0; bj < 2; ++bj)
#pragma unroll
            for (int n = 0; n < 2; ++n) gv[bj][n] = *(const f32x4*)(g + bj * HALF + 4 * n);
#pragma unroll
        for (int ai = 0; ai < 2; ++ai) {
            u32x4 xr[4][2];
#pragma unroll
            for (int m = 0; m < 4; ++m)
#pragma unroll
                for (int bj = 0; bj < 2; ++bj) xr[m][bj] = *(const u32x4*)(XC + (size_t)(row0 + ai * HALF + m * 16) * D + col0 + bj * HALF);
            __builtin_amdgcn_sched_barrier(0);
#pragma unroll
            for (int m = 0; m < 4; ++m) { h16* rowp = XC + (size_t)(row0 + ai * HALF + m * 16) * D + col0;
#pragma unroll
                for (int bj = 0; bj < 2; ++bj) { float x[8]; unpack8(xr[m][bj], x);
                    const f32x4 a0 = acc[ai][bj][m][0], a1 = acc[ai][bj][m][1], g0 = gv[bj][0], g1 = gv[bj][1];
                    u32x4 w; w.x = pk2h(x[0] + g0[0] * a0[0], x[1] + g0[1] * a0[1]); w.y = pk2h(x[2] + g0[2] * a0[2], x[3] + g0[3] * a0[3]);
                    w.z = pk2h(x[4] + g1[0] * a1[0], x[5] + g1[1] * a1[1]); w.w = pk2h(x[6] + g1[2] * a1[2], x[7] + g1[3] * a1[3]); *(u32x4*)(rowp + bj * HALF) = w; } }
            __builtin_amdgcn_sched_barrier(0);
        }
    }
};
struct EpiSwiglu {
    h16* HID;
    DI void operator()(const f32x4 (&acc)[2][2][4][2], const Unit& u, int wr, int wc, int fr, int fq) const {
        const int row0 = u.pm * BM + wr * 64 + fr, col0 = u.pn * HALF + wc * 32 + 8 * fq;
#pragma unroll
        for (int ai = 0; ai < 2; ++ai)
#pragma unroll
            for (int m = 0; m < 4; ++m) { h16* rowp = HID + (size_t)(row0 + ai * HALF + m * 16) * D + col0;
                float o[8];
#pragma unroll
                for (int n = 0; n < 2; ++n)
#pragma unroll
                    for (int j = 0; j < 4; ++j) { const float a = acc[ai][0][m][n][j], b = acc[ai][1][m][n][j]; o[4 * n + j] = silu_f(a) * b; }
                u32x4 w; w.x = pk2h(o[0], o[1]); w.y = pk2h(o[2], o[3]); w.z = pk2h(o[4], o[5]); w.w = pk2h(o[6], o[7]);
                *(u32x4*)rowp = w; }
    }
};
struct EpiDown {
    h16* YE; const float* GATE;
    DI void operator()(const f32x4 (&acc)[2][2][4][2], const Unit& u, int wr, int wc, int fr, int fq) const {
        const int row0 = u.pm * BM + wr * 64 + fr, col0 = u.pn * BM + wc * 32 + 8 * fq;
#pragma unroll
        for (int ai = 0; ai < 2; ++ai)
#pragma unroll
            for (int m = 0; m < 4; ++m) { const int row = row0 + ai * HALF + m * 16; const float gt = GATE[row]; h16* rowp = YE + (size_t)row * D + col0;
#pragma unroll
                for (int bj = 0; bj < 2; ++bj) { const f32x4 v0 = acc[ai][bj][m][0] * gt, v1 = acc[ai][bj][m][1] * gt;
                    u32x4 w; w.x = pk2h(v0[0], v0[1]); w.y = pk2h(v0[2], v0[3]); w.z = pk2h(v1[0], v1[1]); w.w = pk2h(v1[2], v1[3]);
                    *(u32x4*)(rowp + bj * HALF) = w; } }
    }
};
struct EpiSwiglu8 {
    unsigned char* HID8;
    DI void operator()(const f32x4 (&acc)[2][2][4][2], const Unit& u, int wr, int wc, int fr, int fq) const {
        const int row0 = u.pm * BM + wr * 64 + fr, col0 = u.pn * HALF + wc * 32 + 8 * fq;
#pragma unroll
        for (int ai = 0; ai < 2; ++ai)
#pragma unroll
            for (int m = 0; m < 4; ++m) { unsigned char* rowp = HID8 + (size_t)(row0 + ai * HALF + m * 16) * D + col0;
                float o[8];
#pragma unroll
                for (int n = 0; n < 2; ++n)
#pragma unroll
                    for (int j = 0; j < 4; ++j) { const float a = acc[ai][0][m][n][j] * (1.f / 512.f), b = acc[ai][1][m][n][j] * (4.f / 512.f); o[4 * n + j] = silu_f(a) * b; }
                u32x2 w; w.x = pk4f8(o[0], o[1], o[2], o[3]); w.y = pk4f8(o[4], o[5], o[6], o[7]);
                *(u32x2*)rowp = w; }
    }
};
struct EpiDown8 {
    unsigned char* YE; const float* GATE;
    DI void operator()(const f32x4 (&acc)[2][2][4][2], const Unit& u, int wr, int wc, int fr, int fq) const {
        const int row0 = u.pm * BM + wr * 64 + fr, col0 = u.pn * BM + wc * 32 + 8 * fq;
        float gt[2][4];
#pragma unroll
        for (int ai = 0; ai < 2; ++ai)
#pragma unroll
            for (int m = 0; m < 4; ++m) gt[ai][m] = GATE[row0 + ai * HALF + m * 16];
        __builtin_amdgcn_sched_barrier(0);
#pragma unroll
        for (int ai = 0; ai < 2; ++ai)
#pragma unroll
            for (int m = 0; m < 4; ++m) { const int row = row0 + ai * HALF + m * 16; const float g = gt[ai][m] * (16.f / 256.f); unsigned char* rowp = YE + (size_t)row * D + col0;
#pragma unroll
                for (int bj = 0; bj < 2; ++bj) { const f32x4 v0 = acc[ai][bj][m][0] * g, v1 = acc[ai][bj][m][1] * g;
                    u32x2 w; w.x = pk4f8(v0[0], v0[1], v0[2], v0[3]); w.y = pk4f8(v1[0], v1[1], v1[2], v1[3]);
                    *(u32x2*)(rowp + bj * HALF) = w; } }
    }
};
constexpr float ATT_C2 = 0.125f * 1.4426950408889634f;
struct EpiQkv {
    h16 *Q, *Kb, *Vb; const float *RC, *RS;
    DI void operator()(const f32x4 (&acc)[2][2][4][2], const Unit& u, int wr, int wc, int fr, int fq) const {
        const bool ctx = u.pm >= 64; const int sec = u.pn >> 2;
        const int lr0 = wr * 64 + fr, col0 = (u.pn & 3) * BM + wc * 32 + 8 * fq;
        h16* base; size_t rowb;
        if (sec == 0) { base = Q; rowb = (size_t)u.pm * BM; }
        else { base = sec == 1 ? Kb : Vb; rowb = ctx ? (size_t)(u.pm - 64) * KVR : (size_t)(u.pm >> 3) * KVR + LC + (size_t)(u.pm & 7) * BM; }
        const bool rope = (sec < 2) && !ctx; const float sc = sec == 0 ? ATT_C2 : 1.f;
#pragma unroll
        for (int ai = 0; ai < 2; ++ai) {
            f32x4 cs[4], sn[4];
#pragma unroll
            for (int m = 0; m < 4; ++m) { cs[m] = (f32x4){1.f, 1.f, 1.f, 1.f}; sn[m] = (f32x4){0.f, 0.f, 0.f, 0.f}; }
            if (rope) {
#pragma unroll
                for (int m = 0; m < 4; ++m) { const int t = (u.pm & 7) * BM + lr0 + ai * HALF + m * 16; const int pos = (wc & 1) ? (t & 63) : (t >> 6); cs[m] = *(const f32x4*)(RC + pos * 16 + 4 * fq); sn[m] = *(const f32x4*)(RS + pos * 16 + 4 * fq); } }
            __builtin_amdgcn_sched_barrier(0);
#pragma unroll
            for (int m = 0; m < 4; ++m) { const int lr = lr0 + ai * HALF + m * 16; h16* rowp = base + (rowb + lr) * D + col0;
#pragma unroll
                for (int bj = 0; bj < 2; ++bj) { const f32x4 x1 = acc[ai][bj][m][0], x2 = acc[ai][bj][m][1];
                    const f32x4 v0 = (x1 * cs[m] - x2 * sn[m]) * sc, v1 = (x2 * cs[m] + x1 * sn[m]) * sc;
                    u32x4 w; w.x = pk2h(v0[0], v0[1]); w.y = pk2h(v0[2], v0[3]); w.z = pk2h(v1[0], v1[1]); w.w = pk2h(v1[2], v1[3]);
                    *(u32x4*)(rowp + bj * HALF) = w; } }
            __builtin_amdgcn_sched_barrier(0);
        }
    }
};
}

#define XB_TMO      128
#define XB_XCNT(j)  (256  + 64 * (j))
#define XB_XSUB(j)  (1280 + 64 * (j))
#define XB_XGEN(j)  (2304 + 64 * (j))
#define XB_TOP      3328
#define XB_TOPGEN   3392
#define XCD_BAR_WORDS 3456
#define XB_SPIN_CAP (1u << 22)
DI unsigned xb_ld(unsigned* p)              { return __hip_atomic_load(p, __ATOMIC_RELAXED, __HIP_MEMORY_SCOPE_AGENT); }
DI unsigned xb_add(unsigned* p, unsigned v) { return __hip_atomic_fetch_add(p, v, __ATOMIC_RELAXED, __HIP_MEMORY_SCOPE_AGENT); }
DI unsigned xb_xcc_id() { return (unsigned)__builtin_amdgcn_s_getreg((3 << 11) | 20) & 0xFu; }
#define XB_SPIN(cond, bar) do { unsigned _sp = 0; while (cond) { __builtin_amdgcn_s_sleep(1); \
    if ((++_sp & 255u) == 0u) { if (xb_ld(&(bar)[XB_TMO])) break; if (_sp > XB_SPIN_CAP) { atomicAdd(&(bar)[XB_TMO], 1u); break; } } } } while (0)
struct XcdBarrier { unsigned* bar; unsigned x; volatile LAS unsigned* st; };
DI XcdBarrier xcd_barrier_post(unsigned* bar, volatile LAS unsigned* st) {
    XcdBarrier b; b.bar = bar; b.x = xb_xcc_id(); b.st = st;
    if (threadIdx.x == 0) (void)xb_add(&bar[XB_XCNT(b.x)], 1u);
    return b;
}
DI void xcd_barrier_complete(unsigned* bar, unsigned x, unsigned& nloc, unsigned& nx) {
    const unsigned G = gridDim.x * gridDim.y * gridDim.z;
    unsigned sum, cnt, mine, sp = 0u;
    for (;;) {
        sum = 0u; cnt = 0u; mine = 0u;
#pragma unroll
        for (unsigned j = 0; j < 16; ++j) { const unsigned c = xb_ld(&bar[XB_XCNT(j)]); sum += c; cnt += (c > 0u) ? 1u : 0u; mine = (j == x) ? c : mine; }
        if (sum == G) break;
        __builtin_amdgcn_s_sleep(1);
        if ((++sp & 255u) == 0u) { if (xb_ld(&bar[XB_TMO])) break; if (sp > XB_SPIN_CAP) { atomicAdd(&bar[XB_TMO], 1u); break; } }
    }
    nloc = mine > 0u ? mine : 1u; nx = cnt > 0u ? cnt : 1u;
}
DI void xcd_barrier(const XcdBarrier& b, const bool leader) {
    asm volatile("s_waitcnt vmcnt(0)" ::: "memory");
    __syncthreads();
    if (leader) {
        unsigned* bar = b.bar;
        __builtin_amdgcn_s_waitcnt(0);
        unsigned nloc = b.st[0], nx = b.st[1];
        if (nloc == 0u) { xcd_barrier_complete(bar, b.x, nloc, nx); b.st[0] = nloc; b.st[1] = nx; }
        const unsigned old = xb_add(&bar[XB_XSUB(b.x)], 1u);
        const unsigned gen = old / nloc;
        if (old + 1u == (gen + 1u) * nloc) {
            __builtin_amdgcn_fence(__ATOMIC_RELEASE, "agent");
            asm volatile("s_waitcnt vmcnt(0)" ::: "memory");
            const unsigned og = xb_add(&bar[XB_TOP], 1u);
            const unsigned tg = og / nx;
            if (og + 1u == (tg + 1u) * nx) xb_add(&bar[XB_TOPGEN], 1u);
            else XB_SPIN(xb_ld(&bar[XB_TOPGEN]) == tg, bar);
            __builtin_amdgcn_fence(__ATOMIC_ACQUIRE, "agent");
            xb_add(&bar[XB_XGEN(b.x)], 1u);
            asm volatile("s_waitcnt vmcnt(0)" ::: "memory");
        } else {
            XB_SPIN(xb_ld(&bar[XB_XGEN(b.x)]) == gen, bar);
            __builtin_amdgcn_fence(__ATOMIC_ACQUIRE, "agent");
            asm volatile("s_waitcnt vmcnt(0)" ::: "memory");
        }
    }
    __syncthreads();
}

struct Args { const float* in[34]; float* out; unsigned char* ws; int ph_lo, ph_hi; };
enum { I_X = 0, I_C, I_CTX, I_CCTX, I_WADA, I_BADA, I_N1G, I_N2G, I_FG, I_AWIN, I_ACONV, I_AWOUT, I_BQKV, I_LQ1, I_LK1, I_LQ2, I_LK2, I_SUBG, I_BWOUT,
       I_CWIN, I_CCONV, I_F1W, I_F1B, I_F1F, I_F2W, I_F2B, I_F2F, I_F3W, I_SKIP, I_CWOUT, I_ROUTER, I_WGATE, I_WUP, I_WDOWN };

typedef __attribute__((address_space(4))) const Args CArgs;
struct Ctx { LAS unsigned char* lds; int tid, lane, wave, G, bx, vcu, gw, NGW; };

DI int perm_l2p(int l) { return ((l >> 2) & 3) * 8 + (l >> 4) * 4 + (l & 3); }
DI int map_row(int mode, int n) {
    if (mode == 1) return n < 2048 ? (n & ~31) + perm_l2p(n & 31) : n;
    if (mode == 2) return (n >> 7) * 256 + (n & 127);
    if (mode == 3) return (n >> 7) * 256 + 128 + (n & 127);
    if (mode == 4) { if (n < 1024) return n; const int c = (n - 1024) & 1023; return 1024 + (c >> 7) * 256 + (n >= 2048 ? 128 : 0) + (c & 127); }
    return n;
}
struct TJob { const float* W; h16* WT; int N, mode, item; bool f8; };
constexpr int P0_NSPEC = 1024, P0_NITEMS = P0_NSPEC + 192 * 64;
#ifndef P0_NAUX
#define P0_NAUX 88
#endif
DI TJob p0_expert_job(CArgs& a, int kind, int le, int item) {
    unsigned char* ws = a.ws; TJob j;
    j.W = a.in[I_WGATE + kind] + (size_t)le * 1024 * 1024; j.N = 1024; j.item = item; j.mode = kind == 0 ? 2 : (kind == 1 ? 3 : 0);
    j.WT = kind < 2 ? (h16*)(ws + WS_WGU + (size_t)le * 2048 * 1024) : (h16*)(ws + WS_WDN + (size_t)le * 1024 * 1024); j.f8 = true; return j;
}
#ifndef DEF_A
#define DEF_A 7
#endif
#ifndef DEF_B
#define DEF_B 3
#endif
constexpr int P0_NDEFER = 576 * DEF_A + 320 * DEF_B;
DI TJob p0_decode_deferred(CArgs& a, int d) { const int kind = d / 2048, rem = d % 2048; return p0_expert_job(a, kind, 32 + (rem >> 6), rem & 63); }
DI TJob p0_decode(CArgs& a, int it, bool defer) {
    unsigned char* ws = a.ws; TJob j;
    int r = it;
    if (r >= P0_NSPEC) { r -= P0_NSPEC;
        if (!defer) { const int mat = r >> 6; return p0_expert_job(a, mat >> 6, mat & 63, r & 63); }
        if (r < 6144) { const int mat = r >> 6; return p0_expert_job(a, mat >> 5, mat & 31, r & 63); }
        return p0_decode_deferred(a, P0_NDEFER + (r - 6144)); }
    j.mode = 0; j.f8 = false;
    if (r < 192) { j.W = a.in[I_AWIN]; j.N = 3072; j.WT = (h16*)(ws + WS_WAIN); j.item = r; j.mode = 4; return j; } r -= 192;
    if (r < 192) { j.W = a.in[I_AWIN] + (size_t)1024 * 3072; j.N = 3072; j.WT = (h16*)(ws + WS_WAIN) + (size_t)3072 * 1024; j.item = r; j.mode = 4; return j; } r -= 192;
    if (r < 64) { j.W = a.in[I_AWOUT]; j.N = 1024; j.WT = (h16*)(ws + WS_WAOUT); j.item = r; return j; } r -= 64;
    if (r < 64) { j.W = a.in[I_AWOUT] + (size_t)1024 * 1024; j.N = 1024; j.WT = (h16*)(ws + WS_WAOUT) + (size_t)1024 * 1024; j.item = r; return j; } r -= 64;
    if (r < 192) { j.W = a.in[I_BQKV]; j.N = 3072; j.WT = (h16*)(ws + WS_WQKV); j.item = r; j.mode = 1; return j; } r -= 192;
    if (r < 64) { j.W = a.in[I_BWOUT]; j.N = 1024; j.WT = (h16*)(ws + WS_WBOUT); j.item = r; return j; } r -= 64;
    if (r < 192) { j.W = a.in[I_CWIN]; j.N = 3072; j.WT = (h16*)(ws + WS_WCIN); j.item = r; return j; } r -= 192;
    j.W = a.in[I_CWOUT]; j.N = 1024; j.WT = (h16*)(ws + WS_WCOUT); j.item = r; return j;
}
DI void p0_tr_load(const TJob& j, int tid, f32x4 (&v)[8]) {
    const int nblk = j.N / 128, kb = j.item / nblk, nb = j.item % nblk, k0 = 128 * kb, n0 = 128 * nb;
    const float* p = j.W + (size_t)(k0 + (tid >> 5)) * j.N + n0 + 4 * (tid & 31);
#pragma unroll
    for (int i = 0; i < 8; ++i) v[i] = __builtin_nontemporal_load((const f32x4*)(p + (size_t)(16 * i) * j.N));
}
#define P0_LBAR() asm volatile("s_waitcnt lgkmcnt(0)\n\ts_barrier" ::: "memory")
DI void p0_tr_store(const TJob& j, int tid, LAS float* scr, const f32x4 (&v)[8]) {
    const int nblk = j.N / 128, kb = j.item / nblk, nb = j.item % nblk, k0 = 128 * kb, n0 = 128 * nb;
#pragma unroll
    for (int i = 0; i < 8; ++i) { LAS float* d = scr + ((tid >> 5) + 16 * i) * 129 + 4 * (tid & 31); d[0] = v[i].x; d[1] = v[i].y; d[2] = v[i].z; d[3] = v[i].w; }
    P0_LBAR();
    const int n = tid >> 2, kq = tid & 3;
    const LAS float* s = scr + (32 * kq) * 129 + n;
    const size_t orow = (size_t)map_row(j.mode, n0 + n) * 1024 + k0 + 32 * kq;
    if (j.f8) {
        u32x4 o0, o1;
        o0.x = pk4f8(s[0 * 129] * 64.f, s[1 * 129] * 64.f, s[2 * 129] * 64.f, s[3 * 129] * 64.f);     o0.y = pk4f8(s[4 * 129] * 64.f, s[5 * 129] * 64.f, s[6 * 129] * 64.f, s[7 * 129] * 64.f);
        o0.z = pk4f8(s[8 * 129] * 64.f, s[9 * 129] * 64.f, s[10 * 129] * 64.f, s[11 * 129] * 64.f);   o0.w = pk4f8(s[12 * 129] * 64.f, s[13 * 129] * 64.f, s[14 * 129] * 64.f, s[15 * 129] * 64.f);
        o1.x = pk4f8(s[16 * 129] * 64.f, s[17 * 129] * 64.f, s[18 * 129] * 64.f, s[19 * 129] * 64.f); o1.y = pk4f8(s[20 * 129] * 64.f, s[21 * 129] * 64.f, s[22 * 129] * 64.f, s[23 * 129] * 64.f);
        o1.z = pk4f8(s[24 * 129] * 64.f, s[25 * 129] * 64.f, s[26 * 129] * 64.f, s[27 * 129] * 64.f); o1.w = pk4f8(s[28 * 129] * 64.f, s[29 * 129] * 64.f, s[30 * 129] * 64.f, s[31 * 129] * 64.f);
        u32x4* d = (u32x4*)((unsigned char*)j.WT + orow); d[0] = o0; d[1] = o1;
    } else {
        u32x4* d = (u32x4*)(j.WT + orow);
#pragma unroll
        for (int g = 0; g < 4; ++g) { const LAS float* t = s + (8 * g) * 129;
            u32x4 o; o.x = pk2h(t[0 * 129], t[1 * 129]); o.y = pk2h(t[2 * 129], t[3 * 129]); o.z = pk2h(t[4 * 129], t[5 * 129]); o.w = pk2h(t[6 * 129], t[7 * 129]); d[g] = o; }
    }
    P0_LBAR();
}

DI void p0_prologue(const Ctx& F, CArgs& a) {
    unsigned char* ws = a.ws;
    const int NAUX = F.G >= 128 ? P0_NAUX : 0;
    const bool aux = F.bx < NAUX || NAUX == 0, conv = F.bx >= NAUX;
    const int cbx = F.bx - NAUX, cG = F.G - NAUX, abx = F.bx, aG = NAUX ? NAUX : F.G;
    if (conv) {
        const bool defer = (F.G == 256); const int nitems = defer ? P0_NITEMS - P0_NDEFER : P0_NITEMS;
        LAS float* scr = (LAS float*)F.lds;
        int it = cbx;
        f32x4 v0[8], v1[8]; TJob j0, j1;
        if (it < nitems) { j0 = p0_decode(a, it, defer); p0_tr_load(j0, F.tid, v0); }
        while (it < nitems) {
            int itn = it + cG; bool hn = itn < nitems;
            if (hn) { j1 = p0_decode(a, itn, defer); p0_tr_load(j1, F.tid, v1); }
            p0_tr_store(j0, F.tid, scr, v0);
            it = itn; if (!hn) break;
            itn = it + cG; hn = itn < nitems;
            if (hn) { j0 = p0_decode(a, itn, defer); p0_tr_load(j0, F.tid, v0); }
            p0_tr_store(j1, F.tid, scr, v1);
            it = itn;
        }
    }
    __syncthreads();
    if (aux) {
        LAS float* S = (LAS float*)F.lds;
        LAS float* P = (LAS float*)(F.lds + 40960);
        for (int i = F.tid; i < 9 * 1024; i += NTHR) { const int r = i >> 10, k = i & 1023; const float v = r < 8 ? a.in[I_C][r * 1024 + k] : a.in[I_CCTX][k]; S[i] = v / (1.f + expf(-v)); }
        __syncthreads();
        float* MOD = (float*)(ws + WS_MOD);
        for (int it = abx; it < 4 * 96; it += aG) {
            const int l = it / 96, n0 = (it % 96) * 64;
            const float* W = a.in[I_WADA] + (size_t)l * 1024 * 6144 + n0 + F.lane;
            float acc[9];
#pragma unroll
            for (int r = 0; r < 9; ++r) acc[r] = 0.f;
            const int kb = F.wave * 128;
            for (int k0 = 0; k0 < 128; k0 += 32) {
                float w[32];
#pragma unroll
                for (int kk = 0; kk < 32; ++kk) w[kk] = __builtin_nontemporal_load(W + (size_t)(kb + k0 + kk) * 6144);
#pragma unroll
                for (int kk = 0; kk < 32; ++kk) {
#pragma unroll
                    for (int r = 0; r < 9; ++r) acc[r] += S[r * 1024 + kb + k0 + kk] * w[kk]; } }
#pragma unroll
            for (int r = 0; r < 9; ++r) P[(F.wave * 9 + r) * 64 + F.lane] = acc[r];
            __syncthreads();
            for (int o = F.tid; o < 9 * 64; o += NTHR) { const int r = o >> 6, n = o & 63; float s = 0.f;
#pragma unroll
                for (int w = 0; w < 8; ++w) s += P[(w * 9 + r) * 64 + n];
                MOD[((size_t)l * 9 + r) * 6144 + n0 + n] = s + a.in[I_BADA][l * 6144 + n0 + n]; }
            __syncthreads();
        }
    }
    if (aux && abx == 0) {
        float* RC = (float*)(ws + WS_SMALL); float* RS = RC + 1024;
        for (int i = F.tid; i < 1024; i += NTHR) { const int pos = i >> 4, f = i & 15; const float inv = powf(10000.f, -(float)(2 * f) / 32.f); const float ang = (float)pos * inv; RC[i] = cosf(ang); RS[i] = sinf(ang); }
    }
    __syncthreads();
    if (aux) {
        LAS float* ZB = (LAS float*)F.lds;
        LAS float* H1 = ZB + 512;
        LAS float* HB = H1 + 512;
        h16* FILT = (h16*)(ws + WS_FILT);
        const float* f1w = a.in[I_F1W]; const float* f2w = a.in[I_F2W]; const float* f3w = a.in[I_F3W];
        for (int it = abx; it < L / 8; it += aG) {
            const int p0 = it * 8; const int t = p0 + F.wave;
            {
                const float tl = (float)t / (float)(L - 1); const float wang = 2.0f * 3.14159265358979323846f * (float)t / (float)L;
                float zv = 0.f;
                if (F.lane == 0) zv = tl;
                else if (F.lane < 33) { const int q = (F.lane - 1) & 15; const float fq = 1e-4f + (float)q * ((15.0f - 1e-4f) / 15.0f); const float ang = fq * wang; zv = F.lane < 17 ? cosf(ang) : -sinf(ang); }
                ZB[F.wave * 64 + F.lane] = zv;
                LDS_WAIT();
                float s = a.in[I_F1B][F.lane];
                for (int i = 0; i < 33; ++i) s += ZB[F.wave * 64 + i] * f1w[i * 64 + F.lane];
                const float h1 = sinf(a.in[I_F1F][F.lane] * s);
                H1[F.wave * 64 + F.lane] = h1;
                LDS_WAIT();
                float s2 = a.in[I_F2B][F.lane];
                for (int k = 0; k < 64; ++k) s2 += H1[F.wave * 64 + k] * f2w[k * 64 + F.lane];
                HB[F.wave * 64 + F.lane] = sinf(a.in[I_F2F][F.lane] * s2);
            }
            __syncthreads();
            for (int cc = F.wave; cc < 16; cc += 8) {
                const int n = cc * 256 + 4 * F.lane;
                f32x4 acc[8];
#pragma unroll
                for (int p = 0; p < 8; ++p) acc[p] = (f32x4){0.f, 0.f, 0.f, 0.f};
                for (int k = 0; k < 64; ++k) { const f32x4 w = *(const f32x4*)(f3w + (size_t)k * 4096 + n);
#pragma unroll
                    for (int p = 0; p < 8; ++p) acc[p] += w * HB[p * 64 + k]; }
                const int o2 = n >> 10, c0 = n & 1023;
                const float mind = logf(1e-2f) / 1.5f, maxd = logf(1e-2f) / 0.3f;
#pragma unroll
                for (int j = 0; j < 4; ++j) { const int c = c0 + j; const float delta = fabsf(mind + (float)c * ((maxd - mind) / (float)(D - 1)));
                    float o[8];
#pragma unroll
                    for (int p = 0; p < 8; ++p) { const float tl = (float)(p0 + p) / (float)(L - 1); o[p] = acc[p][j] * expf(-tl * delta); }
                    u32x4 w; w.x = pk2h(o[0], o[1]); w.y = pk2h(o[2], o[3]); w.z = pk2h(o[4], o[5]); w.w = pk2h(o[6], o[7]);
                    *(u32x4*)(FILT + ((size_t)(o2 * 1024 + c) * L + p0)) = w; }
            }
            __syncthreads();
        }
    }
}

DI void deferred_convert(const Ctx& F, CArgs& a, int first, int n) {
    LAS float* scr = (LAS float*)F.lds;
    f32x4 v0[8], v1[8]; TJob j0, j1;
    j0 = p0_decode_deferred(a, first); p0_tr_load(j0, F.tid, v0);
    for (int k = 0; k < n; k += 2) {
        const bool h1 = k + 1 < n;
        if (h1) { j1 = p0_decode_deferred(a, first + k + 1); p0_tr_load(j1, F.tid, v1); }
        p0_tr_store(j0, F.tid, scr, v0);
        if (!h1) break;
        if (k + 2 < n) { j0 = p0_decode_deferred(a, first + k + 2); p0_tr_load(j0, F.tid, v0); }
        p0_tr_store(j1, F.tid, scr, v1);
    }
    __syncthreads();
}

DI void rows_load(const float* src, int lane, f32x4 (&v)[4]) {
#pragma unroll
    for (int j = 0; j < 4; ++j) v[j] = __builtin_nontemporal_load((const f32x4*)(src + 4 * lane + 256 * j));
}
DI void rows_load_h(const h16* src, int lane, f32x4 (&v)[4]) {
#pragma unroll
    for (int j = 0; j < 4; ++j) v[j] = unpack4(*(const u32x2*)(src + 4 * lane + 256 * j));
}
DI void rows_phase(const Ctx& F, CArgs& a, int nrows, bool copy_in, bool combine, int lmoe, int lnext, bool final_out, bool from_input = false) {
    unsigned char* ws = a.ws;
    h16* XC = (h16*)(ws + WS_XC); h16* H = (h16*)(ws + WS_H);
    const float* MOD = (const float*)(ws + WS_MOD);
    const int* SLOT = (const int*)(ws + WS_SLOT); const unsigned char* YE = ws + WS_XIN;
    const bool ext = copy_in || from_input;
    int row = F.gw;
    f32x4 nv[4]; int nslot = -1;
    if (row < nrows) { if (ext) rows_load(row < T ? a.in[I_X] + (size_t)row * D : a.in[I_CTX] + (size_t)(row - T) * D, F.lane, nv); else rows_load_h(XC + (size_t)row * D, F.lane, nv);
        if (combine) nslot = SLOT[(size_t)row * 16 + (F.lane & 15)]; }
    for (; row < nrows; row += F.NGW) {
        const int r9 = row < T ? (row >> 11) : 8;
        f32x4 v[4];
#pragma unroll
        for (int j = 0; j < 4; ++j) v[j] = nv[j];
        const int myslot = nslot;
        { const int nr = row + F.NGW < nrows ? row + F.NGW : row;
          if (ext) rows_load(nr < T ? a.in[I_X] + (size_t)nr * D : a.in[I_CTX] + (size_t)(nr - T) * D, F.lane, nv); else rows_load_h(XC + (size_t)nr * D, F.lane, nv);
          if (combine) nslot = SLOT[(size_t)nr * 16 + (F.lane & 15)]; }
        f32x4 g2v[4], gA[4], shA[4], scA[4];
        if (combine) { const float* g2 = MOD + ((size_t)lmoe * 9 + r9) * 6144 + 5120 + 4 * F.lane;
#pragma unroll
            for (int j = 0; j < 4; ++j) g2v[j] = *(const f32x4*)(g2 + 256 * j); }
        if (final_out) {
#pragma unroll
            for (int j = 0; j < 4; ++j) gA[j] = *(const f32x4*)(a.in[I_FG] + 4 * F.lane + 256 * j);
        } else { const float* g1 = a.in[I_N1G] + lnext * D + 4 * F.lane; const float* md = MOD + ((size_t)lnext * 9 + r9) * 6144 + 4 * F.lane;
#pragma unroll
            for (int j = 0; j < 4; ++j) { gA[j] = *(const f32x4*)(g1 + 256 * j); shA[j] = *(const f32x4*)(md + 256 * j); scA[j] = *(const f32x4*)(md + 1024 + 256 * j); } }
        if (combine) {
            f32x4 s[4];
#pragma unroll
            for (int j = 0; j < 4; ++j) s[j] = (f32x4){0.f, 0.f, 0.f, 0.f};
            unsigned m = (unsigned)(__ballot(myslot >= 0) & 0xFFFFull);
            while (m) {
                int sl[4]; unsigned y[4][4];
#pragma unroll
                for (int q = 0; q < 4; ++q) { sl[q] = -1; if (m) { const int e = __builtin_ctz(m); m &= m - 1; sl[q] = __builtin_amdgcn_readlane(myslot, e); } }
#pragma unroll
                for (int q = 0; q < 4; ++q) if (sl[q] >= 0) { const unsigned char* yp = YE + (size_t)sl[q] * D + 4 * F.lane;
#pragma unroll
                    for (int j = 0; j < 4; ++j) y[q][j] = *(const unsigned*)(yp + 256 * j); }
#pragma unroll
                for (int q = 0; q < 4; ++q) if (sl[q] >= 0) {
#pragma unroll
                    for (int j = 0; j < 4; ++j) { const f32x2 lo = __builtin_amdgcn_cvt_pk_f32_fp8((int)y[q][j], false), hi2 = __builtin_amdgcn_cvt_pk_f32_fp8((int)y[q][j], true);
                        s[j] += (f32x4){lo.x, lo.y, hi2.x, hi2.y}; } }
            }
#pragma unroll
            for (int j = 0; j < 4; ++j) v[j] += g2v[j] * s[j] * (1.f / 16.f);
        }
        float ss = 0.f;
#pragma unroll
        for (int j = 0; j < 4; ++j) ss += (v[j].x * v[j].x + v[j].y * v[j].y) + (v[j].z * v[j].z + v[j].w * v[j].w);
        const float rstd = 1.0f / sqrtf(wave_sum(ss, F.lane) * (1.f / D) + 1e-6f);
        if (final_out) {
            f32x4 o[4];
#pragma unroll
            for (int j = 0; j < 4; ++j) o[j] = v[j] * rstd * gA[j];
            if (row < T) {
#pragma unroll
                for (int j = 0; j < 4; ++j) __builtin_nontemporal_store(o[j], (f32x4*)(a.out + (size_t)row * D + 4 * F.lane + 256 * j)); }
        } else {
            u32x2 hw[4];
#pragma unroll
            for (int j = 0; j < 4; ++j) { const f32x4 h = (v[j] * rstd * gA[j]) * (1.f + scA[j]) + shA[j];
                hw[j].x = pk2h(h.x, h.y); hw[j].y = pk2h(h.z, h.w); }
            if (copy_in || combine) {
#pragma unroll
                for (int j = 0; j < 4; ++j) { u32x2 w; w.x = pk2h(v[j].x, v[j].y); w.y = pk2h(v[j].z, v[j].w); *(u32x2*)(XC + (size_t)row * D + 4 * F.lane + 256 * j) = w; } }
#pragma unroll
            for (int j = 0; j < 4; ++j) *(u32x2*)(H + (size_t)row * D + 4 * F.lane + 256 * j) = hw[j];
        }
    }
}


DI void cg_load_u(const h16* BCV, int row, int c0, float (&u)[8]) {
    float cg[8], v[8];
    unpack8(*(const u32x4*)(BCV + (size_t)row * 3072 + 1024 + c0), cg); unpack8(*(const u32x4*)(BCV + (size_t)row * 3072 + 2048 + c0), v);
#pragma unroll
    for (int q = 0; q < 8; ++q) u[q] = cg[q] * v[q];
}
DI void cg_raw(const h16* BU, int row, int c0, u32x4& ur) { ur = *(const u32x4*)(BU + (size_t)row * 2048 + 1024 + c0); }
DI void cg_mul(const u32x4& ur, bool valid, float (&u)[8]) {
    float t[8]; unpack8(ur, t);
#pragma unroll
    for (int q = 0; q < 8; ++q) u[q] = valid ? t[q] : 0.f;
}
DI void convgate_phase(const Ctx& F, CArgs& a, int j, int nrows) {
    const h16* BU = (const h16*)(a.ws + WS_BIG); h16* Z = (h16*)(a.ws + WS_Z);
    const float* cw = a.in[I_ACONV] + (size_t)j * 3 * D;
    const int RI = nrows == T ? 16 : 8;
    const int nitems = (nrows / RI) * 2;
    const bool spread = (F.NGW == 2048) && (nitems == 4608);
#define CG_SEQ(k) (spread ? ((k) < 2 ? F.gw + (k) * 2048 : (((k) == 2 && F.wave < 2) ? 4096 + F.vcu + 256 * F.wave : nitems)) : F.gw + (k) * F.NGW)
    for (int kk = 0, it = F.gw; it < nitems; ++kk, it = CG_SEQ(kk)) {
        const int hsel = it & 1, r0 = (it >> 1) * RI, c0 = hsel * 512 + 8 * F.lane;
        const int ls = r0 < T ? L : LC; const int t0 = r0 < T ? (r0 & (L - 1)) : ((r0 - T) & (LC - 1));
        u32x4 cm, c0r, c1r, cA, cB, bw, bw1;
        cg_raw(BU, r0 - 1, c0, cm); cg_raw(BU, r0, c0, c0r); cg_raw(BU, r0 + 1, c0, c1r);
        bw = *(const u32x4*)(BU + (size_t)r0 * 2048 + c0);
        cg_raw(BU, r0 + 2, c0, cA); cg_raw(BU, r0 + 3, c0, cB);
        bw1 = *(const u32x4*)(BU + (size_t)(r0 + 1) * 2048 + c0);
        float w0[8], w1[8], w2[8];
#pragma unroll
        for (int q = 0; q < 8; ++q) { w0[q] = cw[c0 + q]; w1[q] = cw[D + c0 + q]; w2[q] = cw[2 * D + c0 + q]; }
        __builtin_amdgcn_sched_barrier(0);
        float up[8], uc[8], un[8];
        cg_mul(cm, t0 > 0, up); cg_mul(c0r, true, uc); cg_mul(c1r, t0 + 1 < ls, un);
        for (int i = 0; i < RI; ++i) {
            const int row = r0 + i;
            u32x4 cN, bw2;
            { const int k4 = i + 4 < RI ? i + 4 : RI, k2 = i + 2 < RI ? i + 2 : RI - 1;
              cg_raw(BU, r0 + k4, c0, cN); bw2 = *(const u32x4*)(BU + (size_t)(r0 + k2) * 2048 + c0); }
            float un2[8]; cg_mul(cA, (i + 2 <= RI) && (t0 + i + 2 < ls), un2);
            float bv[8], o[8]; unpack8(bw, bv);
#pragma unroll
            for (int q = 0; q < 8; ++q) o[q] = bv[q] * (w0[q] * up[q] + w1[q] * uc[q] + w2[q] * un[q]);
            u32x4 w; w.x = pk2h(o[0], o[1]); w.y = pk2h(o[2], o[3]); w.z = pk2h(o[4], o[5]); w.w = pk2h(o[6], o[7]);
            *(u32x4*)(Z + (size_t)row * D + c0) = w;
#pragma unroll
            for (int q = 0; q < 8; ++q) { up[q] = uc[q]; uc[q] = un[q]; un[q] = un2[q]; }
            bw = bw1; bw1 = bw2; cA = cB; cB = cN;
        }
    }
}

DI void moe_rows_phase(const Ctx& F, CArgs& a, int l, int nrows) {
    unsigned char* ws = a.ws;
    const h16* XC = (const h16*)(ws + WS_XC); unsigned char* H8 = ws + WS_Z; const float* MOD = (const float*)(ws + WS_MOD); float* AFF = (float*)(ws + WS_AFF);
    LAS float* WR = (LAS float*)F.lds;
    const float* rt = a.in[I_ROUTER] + (size_t)l * 1024 * 16;
    const int ngroups = nrows >> 2;
    u32x2 raw[4][4];
    if (F.gw < ngroups) {
#pragma unroll
        for (int r = 0; r < 4; ++r)
#pragma unroll
            for (int c = 0; c < 4; ++c) raw[r][c] = *(const u32x2*)(XC + (size_t)(F.gw * 4 + r) * D + 4 * F.lane + 256 * c); }
    { float tv[32];
#pragma unroll
      for (int k = 0; k < 32; ++k) tv[k] = rt[F.tid + NTHR * k];
      __builtin_amdgcn_sched_barrier(0);
#pragma unroll
      for (int k = 0; k < 32; ++k) { const int i = F.tid + NTHR * k; WR[(i & 15) * 1028 + (i >> 4)] = tv[k]; } }
    __syncthreads();
    const int rs = F.lane >> 4, l16 = F.lane & 15;
    const float* g2 = a.in[I_N2G] + l * D + 4 * F.lane;
    const bool spread = (F.NGW == 2048) && (ngroups == 4608);
#define MR_SEQ(k) (spread ? ((k) < 2 ? F.gw + (k) * 2048 : (((k) == 2 && F.wave < 2) ? 4096 + F.vcu + 256 * F.wave : ngroups)) : F.gw + (k) * F.NGW)
    for (int kk = 0, grp = F.gw; grp < ngroups; ++kk, grp = MR_SEQ(kk)) {
        const int row0 = grp * 4;
        const int r9 = row0 < T ? (row0 >> 11) : 8;
        f32x4 gq[4], shq[4], scq[4];
        const float* md = MOD + ((size_t)l * 9 + r9) * 6144 + 3072 + 4 * F.lane;
#pragma unroll
        for (int c = 0; c < 4; ++c) { gq[c] = *(const f32x4*)(g2 + 256 * c); shq[c] = *(const f32x4*)(md + 256 * c); scq[c] = *(const f32x4*)(md + 1024 + 256 * c); }
        __builtin_amdgcn_sched_barrier(0);
        f32x2 hx[2][4][4];
#pragma unroll
        for (int r = 0; r < 4; ++r)
#pragma unroll
            for (int c = 0; c < 4; ++c) { const f32x4 t = unpack4(raw[r][c]); hx[r >> 1][c][0][r & 1] = t.x; hx[r >> 1][c][1][r & 1] = t.y; hx[r >> 1][c][2][r & 1] = t.z; hx[r >> 1][c][3][r & 1] = t.w; }
        { const int gnx = min(MR_SEQ(kk + 1), ngroups - 1);
#pragma unroll
            for (int r = 0; r < 4; ++r)
#pragma unroll
                for (int c = 0; c < 4; ++c) raw[r][c] = *(const u32x2*)(XC + (size_t)(gnx * 4 + r) * D + 4 * F.lane + 256 * c); }
        __builtin_amdgcn_sched_barrier(0);
        f32x2 ssp[2] = {{0.f, 0.f}, {0.f, 0.f}};
#pragma unroll
        for (int rp = 0; rp < 2; ++rp)
#pragma unroll
            for (int c = 0; c < 4; ++c)
#pragma unroll
                for (int i = 0; i < 4; ++i) ssp[rp] = __builtin_elementwise_fma(hx[rp][c][i], hx[rp][c][i], ssp[rp]);
        float ss[4] = {ssp[0].x, ssp[0].y, ssp[1].x, ssp[1].y};
#pragma unroll
        for (int o = 1; o < 64; o <<= 1)
#pragma unroll
            for (int r = 0; r < 4; ++r) ss[r] += sx(ss[r], o, F.lane);
        f32x2 rs2[2];
#pragma unroll
        for (int r = 0; r < 4; ++r) rs2[r >> 1][r & 1] = 1.0f / sqrtf(ss[r] * (1.f / D) + 1e-6f);
        unsigned w8[4][4];
#pragma unroll
        for (int c = 0; c < 4; ++c) { const f32x4 G8 = gq[c] * (1.f + scq[c]) * 8.f, S8 = shq[c] * 8.f;
#pragma unroll
            for (int rp = 0; rp < 2; ++rp) {
#pragma unroll
                for (int i = 0; i < 4; ++i) { const f32x2 gs = {G8[i], G8[i]}, sh2 = {S8[i], S8[i]}; hx[rp][c][i] = __builtin_elementwise_fma(hx[rp][c][i] * rs2[rp], gs, sh2); }
                w8[2 * rp][c] = pk4f8(hx[rp][c][0].x, hx[rp][c][1].x, hx[rp][c][2].x, hx[rp][c][3].x);
                w8[2 * rp + 1][c] = pk4f8(hx[rp][c][0].y, hx[rp][c][1].y, hx[rp][c][2].y, hx[rp][c][3].y); } }
        f32x2 p[2][16];
#pragma unroll
        for (int e = 0; e < 16; ++e) { f32x2 q0 = {0.f, 0.f}, q1_ = {0.f, 0.f};
#pragma unroll
            for (int c = 0; c < 4; ++c) { const f32x4 w = *(const LAS f32x4*)(WR + e * 1028 + 4 * F.lane + 256 * c);
#pragma unroll
                for (int i = 0; i < 4; ++i) { const f32x2 wv = {w[i], w[i]}; q0 = __builtin_elementwise_fma(hx[0][c][i], wv, q0); q1_ = __builtin_elementwise_fma(hx[1][c][i], wv, q1_); } }
            p[0][e] = q0; p[1][e] = q1_; if ((e & 3) == 3) __builtin_amdgcn_sched_barrier(0); }
        float p16[16];
        { float t2[2][16];
#pragma unroll
          for (int e = 0; e < 16; ++e)
#pragma unroll
              for (int k = 0; k < 2; ++k) { const float lo_ = k ? p[0][e].y : p[0][e].x, hi_ = k ? p[1][e].y : p[1][e].x; const auto sw = __builtin_amdgcn_permlane32_swap(__float_as_uint(lo_), __float_as_uint(hi_), false, false);
                  const unsigned s0 = sw[0], s1 = sw[1]; t2[k][e] = __uint_as_float(s0) + __uint_as_float(s1); }
#pragma unroll
          for (int e = 0; e < 16; ++e) { const float ev_ = t2[0][e], od_ = t2[1][e]; const auto sw = __builtin_amdgcn_permlane16_swap(__float_as_uint(ev_), __float_as_uint(od_), false, false);
              const unsigned s0 = sw[0], s1 = sw[1]; p16[e] = __uint_as_float(s0) + __uint_as_float(s1); } }
        float q8[8], q4[4], q2[2], q1;
        { const bool hb = (l16 & 8) != 0;
#pragma unroll
          for (int i = 0; i < 8; ++i) { const float send = hb ? p16[i] : p16[i + 8], keep = hb ? p16[i + 8] : p16[i]; q8[i] = keep + sx(send, 8, F.lane); } }
        { const bool hb = (l16 & 4) != 0;
#pragma unroll
          for (int i = 0; i < 4; ++i) { const float send = hb ? q8[i] : q8[i + 4], keep = hb ? q8[i + 4] : q8[i]; q4[i] = keep + sx(send, 4, F.lane); } }
        { const bool hb = (l16 & 2) != 0;
#pragma unroll
          for (int i = 0; i < 2; ++i) { const float send = hb ? q4[i] : q4[i + 2], keep = hb ? q4[i + 2] : q4[i]; q2[i] = keep + sx(send, 2, F.lane); } }
        { const bool hb = (l16 & 1) != 0; const float send = hb ? q2[0] : q2[1], keep = hb ? q2[1] : q2[0]; q1 = (keep + sx(send, 1, F.lane)) * 0.125f; }
        float mx = q1;
#pragma unroll
        for (int o = 1; o < 16; o <<= 1) mx = fmaxf(mx, sx(mx, o, F.lane));
        const float mine = expf(q1 - mx);
        float sum = mine;
#pragma unroll
        for (int o = 1; o < 16; o <<= 1) sum += sx(sum, o, F.lane);
        const float af = mine / sum;
#pragma unroll
        for (int r = 0; r < 4; ++r)
#pragma unroll
            for (int c = 0; c < 4; ++c) *(unsigned*)(H8 + (size_t)(row0 + r) * D + 4 * F.lane + 256 * c) = w8[r][c];
        const int row = row0 + rs;
        if (row < T) AFF[((size_t)(row >> 11) * 16 + l16) * L + (row & (L - 1))] = af;
        else { const int rc = row - T; AFF[(size_t)NB * 16 * L + ((size_t)(rc >> 8) * 16 + l16) * LC + (rc & (LC - 1))] = af; }
    }
}

DI int lanes_below(unsigned long long m) { return (int)__builtin_amdgcn_mbcnt_hi((unsigned)(m >> 32), __builtin_amdgcn_mbcnt_lo((unsigned)m, 0u)); }
DI void topk_phase(const Ctx& F, CArgs& a, int l) {
    unsigned char* ws = a.ws;
    const float* AFF = (const float*)(ws + WS_AFF); int* SLOT = (int*)(ws + WS_SLOT); float* GATE = (float*)(ws + WS_GATE);
    int* SEL = (int*)(ws + WS_GATE + 512 * 1024);
    volatile LAS int* CNT = (volatile LAS int*)F.lds;
    const int nitems = 128 + (l == 0 ? 128 : 0);
    for (int it = F.bx; it < nitems; it += F.G) {
        const bool ctx = it >= 128; const int id = it & 127, e = id >> 3, b = id & 7;
        const int N = ctx ? LC : L, cap = ctx ? CAPC : CAP;
        const float* src = ctx ? AFF + (size_t)NB * 16 * L + ((size_t)b * 16 + e) * LC : AFF + ((size_t)b * 16 + e) * L;
        unsigned kb[4];
        { f32x4 v = {0.f, 0.f, 0.f, 0.f}; if (4 * F.tid < N) v = *(const f32x4*)(src + 4 * F.tid);
          kb[0] = __float_as_uint(v.x); kb[1] = __float_as_uint(v.y); kb[2] = __float_as_uint(v.z); kb[3] = __float_as_uint(v.w); }
        unsigned cur = 0u; int par = 0;
        for (int bit = 30; bit >= 0; bit -= 2) {
            const int b0 = bit > 0 ? bit - 1 : 0; const bool pair = bit > 0;
            const unsigned c1 = cur | (1u << b0), c2 = cur | (1u << bit), c3 = c2 | (1u << b0);
            int n1 = 0, n2 = 0, n3 = 0;
#pragma unroll
            for (int q = 0; q < 4; ++q) { n1 += __builtin_popcountll(__ballot(kb[q] >= c1)); n2 += __builtin_popcountll(__ballot(kb[q] >= c2)); n3 += __builtin_popcountll(__ballot(kb[q] >= c3)); }
            if (F.lane == 0) { CNT[32 + par * 24 + F.wave] = n1; CNT[32 + par * 24 + 8 + F.wave] = n2; CNT[32 + par * 24 + 16 + F.wave] = n3; }
            __syncthreads();
            int t1 = 0, t2 = 0, t3 = 0;
#pragma unroll
            for (int w = 0; w < 8; ++w) { t1 += CNT[32 + par * 24 + w]; t2 += CNT[32 + par * 24 + 8 + w]; t3 += CNT[32 + par * 24 + 16 + w]; }
            if (pair) { if (t3 >= cap) cur = c3; else if (t2 >= cap) cur = c2; else if (t1 >= cap) cur = c1; }
            else { if (t2 >= cap) cur = c2; }
            par ^= 1;
        }
        unsigned long long mg[4], me[4]; int cg = 0, ce = 0;
#pragma unroll
        for (int q = 0; q < 4; ++q) { mg[q] = __ballot(kb[q] > cur); me[q] = __ballot(kb[q] == cur); cg += __builtin_popcountll(mg[q]); ce += __builtin_popcountll(me[q]); }
        __syncthreads();
        if (F.lane == 0) { CNT[16 + F.wave] = cg; CNT[24 + F.wave] = ce; }
        __syncthreads();
        int n_gt = 0, eq_before_wave = 0;
#pragma unroll
        for (int w = 0; w < 8; ++w) { const int g_ = CNT[16 + w], e_ = CNT[24 + w]; n_gt += g_; eq_before_wave += (w < F.wave) ? e_ : 0; }
        const int need_eq = cap - n_gt;
        int eqb = eq_before_wave;
#pragma unroll
        for (int q = 0; q < 4; ++q) eqb += lanes_below(me[q]);
        bool sel[4]; int eq_run = eqb;
#pragma unroll
        for (int q = 0; q < 4; ++q) { const bool isg = kb[q] > cur, ise = kb[q] == cur; sel[q] = isg || (ise && eq_run < need_eq); eq_run += ise ? 1 : 0; }
        unsigned long long ms[4]; int cs = 0;
#pragma unroll
        for (int q = 0; q < 4; ++q) { ms[q] = __ballot(sel[q]); cs += __builtin_popcountll(ms[q]); }
        __syncthreads();
        if (F.lane == 0) CNT[16 + F.wave] = cs;
        __syncthreads();
        int slot = 0;
#pragma unroll
        for (int w = 0; w < 8; ++w) slot += (w < F.wave) ? CNT[16 + w] : 0;
#pragma unroll
        for (int q = 0; q < 4; ++q) slot += lanes_below(ms[q]);
        const int gbase = ctx ? NGL + id * CAPC : id * CAP, rowbase = ctx ? T + b * LC : b * L;
        if (4 * F.tid < N) {
#pragma unroll
            for (int q = 0; q < 4; ++q) { const int row = rowbase + 4 * F.tid + q;
                if (sel[q]) { const int g = gbase + slot; SLOT[(size_t)row * 16 + e] = g; GATE[g] = __uint_as_float(kb[q]); SEL[g] = row; ++slot; }
                else SLOT[(size_t)row * 16 + e] = -1; }
        }
        __syncthreads();
    }
}

namespace attn_body {
constexpr int DM = 1024, NW = 8, QBLK = 32, QB = 256, KVBLK = 64, NT = KVR / KVBLK;
DI int crow(int r, int hi) { return (r & 3) + 8 * (r >> 2) + 4 * hi; }
#define SBAR() __builtin_amdgcn_sched_barrier(0)
constexpr int NSLOT = 3, SLOTB = 8192;
constexpr int LDS_K = 0, LDS_V = NSLOT * SLOTB, LDS_WS = 2 * NSLOT * SLOTB, LDS_OST = LDS_WS + NW * 64 * 4, LDS_BYTES_A = LDS_OST + NW * 4096;
DI void glds16(const void* gsrc, unsigned lds_dst) { unsigned keep;
    asm volatile("s_mov_b32 %0, m0\n\ts_mov_b32 m0, %2\n\ts_nop 0\n\tglobal_load_lds_dwordx4 %1, off\n\ts_mov_b32 m0, %0" : "=&s"(keep) : "v"(gsrc), "s"(lds_dst) : "memory"); }
DI float max3f(float a, float b, float c) { float r; asm("v_max3_f32 %0, %1, %2, %3" : "=v"(r) : "v"(a), "v"(b), "v"(c)); return r; }
DI float max2f(float a, float b) { float r; asm("v_max_f32_e32 %0, %1, %2" : "=v"(r) : "v"(a), "v"(b)); return r; }
DI float fadd_s(float a, float b) { float r; asm("v_add_f32_e32 %0, %1, %2" : "=v"(r) : "v"(a), "v"(b)); return r; }
DI float fsub_s(float a, float b) { float r; asm("v_sub_f32_e32 %0, %1, %2" : "=v"(r) : "v"(a), "v"(b)); return r; }
DI unsigned cvtpk_s(float lo, float hi) { return pk2h(lo, hi); }
DI f32x16 MF(s16x8 x, s16x8 y, f32x16 c) { return __builtin_amdgcn_mfma_f32_32x32x16_f16(__builtin_bit_cast(half8, x), __builtin_bit_cast(half8, y), c, 0, 0, 0); }
#define WAIT_BAR(N) asm volatile("s_waitcnt vmcnt(" #N ") lgkmcnt(0)\n\ts_barrier" ::: "memory")
DI void qkt(f32x16& p0, f32x16& p1, const char* Kslot, const s16x8* qr, const f32x16& negm, int r32, int hi) {
    const char* kb = Kslot + hi * 1024 + r32 * 16;
#pragma unroll
    for (int d0 = 0; d0 < 4; ++d0) {
        const s16x8 b0 = *reinterpret_cast<const s16x8*>(kb + d0 * 2048);
        const s16x8 b1 = *reinterpret_cast<const s16x8*>(kb + d0 * 2048 + 512);
        if (d0 == 0) { p0 = MF(b0, qr[0], negm); p1 = MF(b1, qr[0], negm); }
        else { p0 = MF(b0, qr[d0], p0); p1 = MF(b1, qr[d0], p1); } }
}
typedef __attribute__((address_space(3))) const char* lds_cptr;
typedef short v4i16_t __attribute__((ext_vector_type(4)));
DI void kload8(s16x8* kf, lds_cptr kp) {
    kf[0] = *(const LAS s16x8*)(kp);        kf[1] = *(const LAS s16x8*)(kp + 512);
    kf[2] = *(const LAS s16x8*)(kp + 2048); kf[3] = *(const LAS s16x8*)(kp + 2560);
    kf[4] = *(const LAS s16x8*)(kp + 4096); kf[5] = *(const LAS s16x8*)(kp + 4608);
    kf[6] = *(const LAS s16x8*)(kp + 6144); kf[7] = *(const LAS s16x8*)(kp + 6656);
}
DI void kload2(s16x8* kf, lds_cptr kp, int j) { kf[2 * j] = *(const LAS s16x8*)(kp + j * 2048); kf[2 * j + 1] = *(const LAS s16x8*)(kp + j * 2048 + 512); }
DI s16x4 vtr(lds_cptr p) { return __builtin_bit_cast(s16x4, __builtin_amdgcn_ds_read_tr16_b64_v4i16((LAS v4i16_t*)p)); }
DI float rowmax(const f32x16& p0, const f32x16& p1) {
    float a = max3f(p0[0], p0[1], p1[0]), b = max3f(p0[2], p0[3], p1[1]); a = max3f(a, p1[2], p1[3]);
#pragma unroll
    for (int r = 4; r < 16; r += 4) { a = max3f(a, p0[r], p0[r + 1]); b = max3f(b, p0[r + 2], p0[r + 3]); a = max3f(a, p1[r], p1[r + 1]); b = max3f(b, p1[r + 2], p1[r + 3]); }
    const float m = max2f(a, b);
    auto rr = __builtin_amdgcn_permlane32_swap(__float_as_uint(m), __float_as_uint(m), false, false);
    return max2f(__uint_as_float(rr[0]), __uint_as_float(rr[1]));
}
DI void pv(f32x16* o, int vb, s16x8 pa0, s16x8 pa1, s16x8 pa2, s16x8 pa3) {
#pragma unroll
    for (int d0 = 0; d0 < 2; ++d0) { s16x4 lo[4], hi[4];
#pragma unroll
        for (int ks = 0; ks < 4; ++ks) {
            asm volatile("ds_read_b64_tr_b16 %0,%1 offset:%c2" : "=&v"(lo[ks]) : "v"(vb), "i"(d0 * 4096 + ks * 1024) : "memory");
            asm volatile("ds_read_b64_tr_b16 %0,%1 offset:%c2" : "=&v"(hi[ks]) : "v"(vb), "i"(d0 * 4096 + ks * 1024 + 512) : "memory"); }
        asm volatile("s_waitcnt lgkmcnt(0)" ::: "memory"); SBAR();
#define PK(k) (s16x8){lo[k][0], lo[k][1], lo[k][2], lo[k][3], hi[k][0], hi[k][1], hi[k][2], hi[k][3]}
        o[d0] = MF(pa0, PK(0), o[d0]);
        o[d0] = MF(pa1, PK(1), o[d0]);
        o[d0] = MF(pa2, PK(2), o[d0]);
        o[d0] = MF(pa3, PK(3), o[d0]);
#undef PK
    }
}
template <int THRL> DI void attn_unit2(const int tid, const hf* Qw0, const hf* __restrict__ Kh, const hf* __restrict__ Vh, hf* Ow0, char* shm,
                                        const bool fuse = false, const hf* O1src = nullptr, const float lam = 0.f, const float* subg = nullptr) {
    const int lane = tid & 63, r32 = lane & 31, hi = lane >> 5; const int wid = __builtin_amdgcn_readfirstlane(tid >> 6);
    const hf* Qw = Qw0 + (long)(wid * QBLK) * DM;
    const unsigned lds0 = (unsigned)(uintptr_t)shm;
    constexpr int LDS_V2 = NSLOT * SLOTB, LDS_WS2 = LDS_V2 + NSLOT * 2 * SLOTB, LDS_OST2 = LDS_WS2 + NW * 64 * 4;
    float* wsf = (float*)(shm + LDS_WS2) + wid * 64;
    const hf* ksrc = Kh + (long)lane * DM + wid * 8;
    const hf* vsrc = Vh + (long)(16 * (wid & 3) + (lane >> 2)) * DM + (wid >> 2) * 32 + (lane & 3) * 8;
    const unsigned kdst = lds0 + LDS_K + wid * 1024, vdst = lds0 + LDS_V2 + wid * 1024;
#define DMA_K(t, slot) glds16(ksrc + (long)(t) * KVBLK * DM, (unsigned)__builtin_amdgcn_readfirstlane(kdst + (slot)))
#define DMA_V(t, slot) do { glds16(vsrc + (long)(t) * KVBLK * DM, (unsigned)__builtin_amdgcn_readfirstlane(vdst + 2 * (slot))); glds16(vsrc + (long)(t) * KVBLK * DM + 64, (unsigned)__builtin_amdgcn_readfirstlane(vdst + 2 * (slot) + 8192)); } while (0)
    const int vb0 = (int)(lds0 + LDS_V2) + ((lane >> 4) & 1) * 32 + (lane & 3) * 8 + (4 * hi + ((lane & 15) >> 2)) * 64;
    const char* Kbase = shm + LDS_K; s16x8 kf[8];
    const lds_cptr shm3 = (lds_cptr)shm; const lds_cptr kp0 = shm3 + LDS_K + hi * 1024 + r32 * 16; const lds_cptr vp0 = shm3 + LDS_V2 + ((lane >> 4) & 1) * 32 + (lane & 3) * 8 + (4 * hi + ((lane & 15) >> 2)) * 64;
    DMA_K(0, 0); DMA_V(0, 0); DMA_K(1, SLOTB);
    constexpr int LDS_Q2 = LDS_OST2 + NW * 4096;
    const lds_cptr qp0 = shm3 + LDS_Q2 + wid * 4096 + lane * 16;
    s16x8 qr[4];
#pragma unroll
    for (int d0 = 0; d0 < 4; ++d0) { qr[d0] = *reinterpret_cast<const s16x8*>(&Qw[(long)r32 * DM + d0 * 16 + hi * 8]); *(LAS s16x8*)((LAS char*)qp0 + d0 * 1024) = qr[d0]; }
#define QLD(d0) (*(const LAS s16x8*)(qp0 + (d0) * 1024))
    float mhat = 0.f, l_reg = 0.f; f32x16 o[4]; o[0] = f32x16{}; o[1] = f32x16{}; o[2] = f32x16{}; o[3] = f32x16{}; const f32x16 zero16 = f32x16{};
    bool resc = false;
#define START(P0, P1) do { const float rm = rowmax(P0, P1); resc = false; \
    { const float dl = rm; mhat = fadd_s(mhat, dl); \
      _Pragma("unroll") for (int r = 0; r < 16; ++r) { P0[r] = fsub_s(P0[r], dl); P1[r] = fsub_s(P1[r], dl); } } \
    _Pragma("unroll") for (int r = 0; r < 16; ++r) P0[r] = __builtin_amdgcn_exp2f(P0[r]); } while (0)
#define RESC() do { if (resc) { asm volatile("s_waitcnt lgkmcnt(0)" ::: "memory"); \
      _Pragma("unroll") for (int d_ = 0; d_ < 4; ++d_) _Pragma("unroll") for (int r = 0; r < 16; ++r) o[d_][r] *= wsf[crow(r, hi)]; } } while (0)
    f32x16 pA0, pA1, pB0, pB1;
    int sl_prev = 0, sl_cur = 0, sl_next = SLOTB;
#define ROT() do { sl_prev = sl_cur; sl_cur = sl_next; sl_next = (sl_next == (NSLOT - 1) * SLOTB) ? 0 : sl_next + SLOTB; } while (0)
    DMA_K(2, 2 * SLOTB);
    WAIT_BAR(3);
    qkt(pA0, pA1, Kbase, qr, zero16, r32, hi); asm volatile("s_nop 15\n\ts_nop 7" : "+v"(pA0), "+v"(pA1));
    START(pA0, pA1);
    _Pragma("unroll") for (int r = 0; r < 16; ++r) pA1[r] = __builtin_amdgcn_exp2f(pA1[r]);
    WAIT_BAR(0);
    DMA_K(3, 0); DMA_V(1, SLOTB);
    ROT();
    kload8(kf, kp0 + sl_cur);
    WAIT_BAR(3);
    s16x4 vlo[8], vhi[8]; u32x4 pw0, pw1, pw2, pw3;
    s16x8 qa_ = QLD(0), qb_ = QLD(1);
#define PKW(P, B) cvtpk_s(P[B], P[B + 1])
#define PAF(k) __builtin_bit_cast(s16x8, pw##k)
#define VFR(i) (s16x8){vlo[i][0], vlo[i][1], vlo[i][2], vlo[i][3], vhi[i][0], vhi[i][1], vhi[i][2], vhi[i][3]}
#define PIN(x) asm volatile("" : "+v"(x))
#define MX3(a, b, c) __builtin_fmaxf(__builtin_fmaxf((a), (b)), (c))
#define GAPA(MFX, A0, A1, A2, A3, W0, W1, PW) do { MFX; sacc += A0; sacc += A1; sacc += A2; sacc += A3; PIN(sacc); W0; W1; PIN(PW); SBAR(); } while (0)
#define EX(v) __builtin_amdgcn_exp2f(v)
#define GAPB(MFX, X, B) do { MFX; X[B] = EX(X[B]); X[B + 1] = EX(X[B + 1]); PIN(X); SBAR(); } while (0)
#define VRD(i) do { vlo[i] = vtr(vp_ + (((i) >> 2) * 4096 + ((i) & 3) * 1024)); vhi[i] = vtr(vp_ + (((i) >> 2) * 4096 + ((i) & 3) * 1024 + 512)); } while (0)
#define VRD2(i) do { vlo[i] = vtr(vp_ + (8192 + ((i) >> 2) * 4096 + ((i) & 3) * 1024)); vhi[i] = vtr(vp_ + (8192 + ((i) >> 2) * 4096 + ((i) & 3) * 1024 + 512)); } while (0)
#define KRD(G, j) do { if (G) { kload2(kf, kp0 + sl_next, j); SBAR(); } } while (0)
#define STEP(C0, C1, P0, P1, t, GK, GV, GL) do { SBAR(); \
    const lds_cptr vp_ = vp0 + 2 * sl_prev; \
    VRD(0); SBAR(); float sacc = (P0[0] + P0[1]); \
    GAPA(C0 = MF(kf[0], qa_, zero16), P0[2], P0[3], P0[4], P0[5],     pw0[0] = PKW(P0, 0), pw0[1] = PKW(P0, 2), pw0); \
    VRD(4); SBAR(); GAPA(C1 = MF(kf[1], qa_, zero16), P0[6], P0[7], P0[8], P0[9],     pw0[2] = PKW(P0, 4), pw0[3] = PKW(P0, 6), pw0); \
    qa_ = QLD(2); VRD(1); SBAR(); GAPA(C0 = MF(kf[2], qb_, C0),   P0[10], P0[11], P0[12], P0[13], pw1[0] = PKW(P0, 8), pw1[1] = PKW(P0, 10), pw1); \
    VRD(5); SBAR(); GAPA(C1 = MF(kf[3], qb_, C1),   P0[14], P0[15], P1[0], P1[1],   pw1[2] = PKW(P0, 12), pw1[3] = PKW(P0, 14), pw1); \
    qb_ = QLD(3); VRD(2); SBAR(); GAPA(C0 = MF(kf[4], qa_, C0),   P1[2], P1[3], P1[4], P1[5],     pw2[0] = PKW(P1, 0), pw2[1] = PKW(P1, 2), pw2); \
    VRD(6); SBAR(); GAPA(C1 = MF(kf[5], qa_, C1),   P1[6], P1[7], P1[8], P1[9],     pw2[2] = PKW(P1, 4), pw2[3] = PKW(P1, 6), pw2); \
    VRD(3); SBAR(); GAPA(C0 = MF(kf[6], qb_, C0),   P1[10], P1[11], P1[12], P1[13], pw3[0] = PKW(P1, 8), pw3[1] = PKW(P1, 10), pw3); \
    VRD(7); SBAR(); GAPA(C1 = MF(kf[7], qb_, C1),   P1[14], P1[15], 0.f, 0.f,       pw3[2] = PKW(P1, 12), pw3[3] = PKW(P1, 14), pw3); \
    l_reg += sacc; \
    if (GK) { DMA_K((t) + 3, sl_cur); } if (GV) { DMA_V((t) + 1, sl_next); } \
    { float a = MX3(C0[0], C0[1], C1[0]), b = MX3(C0[2], C0[3], C1[1]); a = MX3(a, C1[2], C1[3]); \
      _Pragma("unroll") for (int r = 4; r < 16; r += 4) { a = MX3(a, C0[r], C0[r + 1]); b = MX3(b, C0[r + 2], C0[r + 3]); a = MX3(a, C1[r], C1[r + 1]); b = MX3(b, C1[r + 2], C1[r + 3]); } \
      float rm = __builtin_fmaxf(a, b); { auto rr = __builtin_amdgcn_permlane32_swap(__float_as_uint(rm), __float_as_uint(rm), false, false); rm = __builtin_fmaxf(__uint_as_float(rr[0]), __uint_as_float(rr[1])); } \
      rm -= mhat;                                                       \
      resc = false; \
      if (__builtin_expect(__any(rm > (float)THRL), 0)) { const float dl = __builtin_fmaxf(rm, 0.f); mhat += dl; \
        const float f = __builtin_amdgcn_exp2f(-dl); l_reg *= f; if (hi == 0) wsf[r32] = f; resc = true; } \
      _Pragma("unroll") for (int r = 0; r < 16; ++r) { C0[r] -= mhat; C1[r] -= mhat; } } \
    SBAR(); \
    GAPB(o[0] = MF(PAF(0), VFR(0), o[0]), C0, 0); \
    GAPB(o[1] = MF(PAF(0), VFR(4), o[1]), C0, 2); \
    KRD(GL, 0); GAPB(o[0] = MF(PAF(1), VFR(1), o[0]), C0, 4); \
    VRD2(0); VRD2(4); SBAR(); \
    KRD(GL, 1); GAPB(o[1] = MF(PAF(1), VFR(5), o[1]), C0, 6); \
    KRD(GL, 2); GAPB(o[0] = MF(PAF(2), VFR(2), o[0]), C0, 8); \
    VRD2(1); VRD2(5); SBAR(); \
    KRD(GL, 3); GAPB(o[1] = MF(PAF(2), VFR(6), o[1]), C0, 10); \
    GAPB(o[0] = MF(PAF(3), VFR(3), o[0]), C0, 12); \
    VRD2(2); VRD2(6); SBAR(); \
    GAPB(o[1] = MF(PAF(3), VFR(7), o[1]), C0, 14); \
    VRD2(3); VRD2(7); SBAR(); \
    GAPB(o[2] = MF(PAF(0), VFR(0), o[2]), C1, 0); \
    GAPB(o[3] = MF(PAF(0), VFR(4), o[3]), C1, 2); \
    GAPB(o[2] = MF(PAF(1), VFR(1), o[2]), C1, 4); \
    GAPB(o[3] = MF(PAF(1), VFR(5), o[3]), C1, 6); \
    qa_ = QLD(0); qb_ = QLD(1); SBAR(); \
    GAPB(o[2] = MF(PAF(2), VFR(2), o[2]), C1, 8); \
    GAPB(o[3] = MF(PAF(2), VFR(6), o[3]), C1, 10); \
    GAPB(o[2] = MF(PAF(3), VFR(3), o[2]), C1, 12); \
    GAPB(o[3] = MF(PAF(3), VFR(7), o[3]), C1, 14); \
    } while (0)
    int t = 1;
    for (; t + 5 < NT; t += 2) {
        STEP(pB0, pB1, pA0, pA1, t, true, true, true);     WAIT_BAR(3); RESC(); ROT();
        STEP(pA0, pA1, pB0, pB1, t + 1, true, true, true); WAIT_BAR(3); RESC(); ROT();
    }
#define ENDW(tt) do { if ((tt) + 3 < NT) { WAIT_BAR(3); } else if ((tt) + 2 < NT) { WAIT_BAR(2); } else { WAIT_BAR(0); } } while (0)
    for (; t + 1 < NT; t += 2) {
        STEP(pB0, pB1, pA0, pA1, t, (t + 3 < NT), (t + 1 < NT), (t + 1 < NT));         ENDW(t);     RESC(); ROT();
        STEP(pA0, pA1, pB0, pB1, t + 1, (t + 4 < NT), (t + 2 < NT), (t + 2 < NT));     ENDW(t + 1); RESC(); ROT();
    }
    STEP(pB0, pB1, pA0, pA1, NT - 1, false, false, false); RESC();
    { float sacc = pB0[0] + pB0[1]; _Pragma("unroll") for (int r = 2; r < 16; ++r) sacc += pB0[r]; _Pragma("unroll") for (int r = 0; r < 16; ++r) sacc += pB1[r]; l_reg += sacc;
      pw0 = (u32x4){PKW(pB0, 0), PKW(pB0, 2), PKW(pB0, 4), PKW(pB0, 6)}; pw1 = (u32x4){PKW(pB0, 8), PKW(pB0, 10), PKW(pB0, 12), PKW(pB0, 14)}; pw2 = (u32x4){PKW(pB1, 0), PKW(pB1, 2), PKW(pB1, 4), PKW(pB1, 6)}; pw3 = (u32x4){PKW(pB1, 8), PKW(pB1, 10), PKW(pB1, 12), PKW(pB1, 14)};
      SBAR(); pv(o, vb0 + 2 * sl_cur, PAF(0), PAF(1), PAF(2), PAF(3)); pv(o + 2, vb0 + 2 * sl_cur + 8192, PAF(0), PAF(1), PAF(2), PAF(3)); }
#undef PKW
#undef PAF
#undef VFR
#undef PIN
#undef MX3
#undef GAPA
#undef GAPB
#undef EX
#undef VRD
#undef KRD
#undef STEP
#undef ENDW
    { auto rr = __builtin_amdgcn_permlane32_swap(__float_as_uint(l_reg), __float_as_uint(l_reg), false, false); l_reg = __uint_as_float(rr[0]) + __uint_as_float(rr[1]); }
    if (hi == 0) wsf[32 + r32] = l_reg; asm volatile("s_waitcnt lgkmcnt(0)" ::: "memory");
    float rli[16];
#pragma unroll
    for (int r = 0; r < 16; ++r) rli[r] = __builtin_amdgcn_rcpf(wsf[32 + crow(r, hi)]);
    hf* Ow = Ow0 + (long)(wid * QBLK) * DM;
    int lane2 = lane; asm volatile("" : "+v"(lane2));
    if (fuse) {
        asm volatile("s_waitcnt vmcnt(0)" ::: "memory");
        const hf* O1w = O1src + (long)(wid * QBLK) * DM; asm volatile("" : "+s"(O1w)); asm volatile("" : "+s"(Ow));
        u32x4 dvp[2][4]; float ssr[4] = {0.f, 0.f, 0.f, 0.f};
        hf* stg = (hf*)(shm + LDS_OST2) + wid * 2048;
#pragma unroll
        for (int hh2 = 0; hh2 < 2; ++hh2) {
            u32x4 x1r[4];
#pragma unroll
            for (int i = 0; i < 4; ++i) { const int row = i * 8 + (lane2 >> 3), ch = lane2 & 7; x1r[i] = *(const u32x4*)(O1w + (long)row * DM + 64 * hh2 + ch * 8); }
#pragma unroll
            for (int r = 0; r < 16; ++r) { const int orow = crow(r, hi);
#pragma unroll
                for (int d0 = 0; d0 < 2; ++d0) stg[orow * 64 + d0 * 32 + r32] = (hf)(o[2 * hh2 + d0][r] * rli[r]); }
            asm volatile("s_waitcnt lgkmcnt(0)" ::: "memory");
#pragma unroll
            for (int i = 0; i < 4; ++i) { const int row = i * 8 + (lane2 >> 3), ch = lane2 & 7; const u32x4 v2 = *(const u32x4*)(stg + row * 64 + ch * 8);
                float x1[8], x2[8]; unpack8(x1r[i], x1); unpack8(v2, x2);
#pragma unroll
                for (int j = 0; j < 8; ++j) { x1[j] -= lam * x2[j]; ssr[i] += x1[j] * x1[j]; }
                dvp[hh2][i].x = pk2h(x1[0], x1[1]); dvp[hh2][i].y = pk2h(x1[2], x1[3]); dvp[hh2][i].z = pk2h(x1[4], x1[5]); dvp[hh2][i].w = pk2h(x1[6], x1[7]); }
            asm volatile("s_waitcnt lgkmcnt(0)" ::: "memory");
        }
#pragma unroll
        for (int i = 0; i < 4; ++i) { float ss = ssr[i]; ss += sx(ss, 1, lane2); ss += sx(ss, 2, lane2); ss += sx(ss, 4, lane2); ssr[i] = (1.f - 0.35550907f) / sqrtf(ss * (1.f / 128.f) + 1e-5f); }
#pragma unroll
        for (int hh2 = 0; hh2 < 2; ++hh2) {
            const f32x4 g0 = *(const f32x4*)(subg + hh2 * 64 + (lane2 & 7) * 8), g1 = *(const f32x4*)(subg + hh2 * 64 + (lane2 & 7) * 8 + 4);
#pragma unroll
            for (int i = 0; i < 4; ++i) { const int row = i * 8 + (lane2 >> 3), ch = lane2 & 7; const float rs_ = ssr[i]; float dq[8]; unpack8(dvp[hh2][i], dq);
                u32x4 w; w.x = pk2h(dq[0] * rs_ * g0[0], dq[1] * rs_ * g0[1]); w.y = pk2h(dq[2] * rs_ * g0[2], dq[3] * rs_ * g0[3]);
                w.z = pk2h(dq[4] * rs_ * g1[0], dq[5] * rs_ * g1[1]); w.w = pk2h(dq[6] * rs_ * g1[2], dq[7] * rs_ * g1[3]);
                *(u32x4*)(Ow + (long)row * DM + 64 * hh2 + ch * 8) = w; } }
    } else
    { hf* stg = (hf*)(shm + LDS_OST2) + wid * 2048;
#pragma unroll
      for (int hh2 = 0; hh2 < 2; ++hh2) {
#pragma unroll
        for (int r = 0; r < 16; ++r) { const int orow = crow(r, hi);
#pragma unroll
          for (int d0 = 0; d0 < 2; ++d0) stg[orow * 64 + d0 * 32 + r32] = (hf)(o[2 * hh2 + d0][r] * rli[r]); }
        asm volatile("s_waitcnt lgkmcnt(0)" ::: "memory");
#pragma unroll
        for (int i = 0; i < 4; ++i) { const int row = i * 8 + (lane2 >> 3), ch = lane2 & 7; const u32x4 v = *(const u32x4*)(stg + row * 64 + ch * 8); *(u32x4*)(Ow + (long)row * DM + 64 * hh2 + ch * 8) = v; }
        asm volatile("s_waitcnt lgkmcnt(0)" ::: "memory");
      } }
    asm volatile("s_waitcnt lgkmcnt(0)\n\ts_barrier" ::: "memory");
#undef DMA_K
#undef QLD
#undef VRD2
#undef DMA_V
#undef START
#undef RESC
#undef ROT
}
#undef SBAR
#undef WAIT_BAR
}

DI void attn_phase(const Ctx& F, CArgs& a) {
    unsigned char* ws = a.ws;
    const hf* Q = (const hf*)(ws + WS_BIG); const hf* Kb = Q + (size_t)T * D; const hf* Vb = Kb + (size_t)NB * KVR * D;
    hf* OP = (hf*)(ws + WS_XIN); hf* ZN = (hf*)(ws + WS_Z);
    const float lam_init = 0.35550907f;
    const float l1 = wave_sum(a.in[I_LQ1][F.lane] * a.in[I_LK1][F.lane], F.lane), l2 = wave_sum(a.in[I_LQ2][F.lane] * a.in[I_LK2][F.lane], F.lane);
    const float lam_s = __int_as_float(__builtin_amdgcn_readfirstlane(__float_as_int(expf(l1) - expf(l2) + lam_init)));
    for (int i = 0;; ++i) {
        const long P = (long)(i >> 1) * F.G + F.vcu; if (P >= 512) break;
        const int r = i & 1, qb = (int)(P & 7), bh = (int)(P >> 3), b = bh >> 3, hh = bh & 7;
        const int qcol = hh * 128 + r * 64, vcol = hh * 128;
        const size_t orow0 = ((size_t)b * L + (size_t)qb * 256) * D + vcol;
        const hf* Qw0 = Q + ((size_t)b * L + (size_t)qb * 256) * D + qcol;
        const hf* Kh = Kb + (size_t)b * KVR * D + qcol; const hf* Vh = Vb + (size_t)b * KVR * D + vcol;
        attn_body::attn_unit2<8>(F.tid, Qw0, Kh, Vh, (r ? ZN : OP) + orow0, (char*)F.lds, r != 0, OP + orow0, lam_s, a.in[I_SUBG]);
    }
}

DI void attn_post_phase(const Ctx& F, CArgs& a) {
    unsigned char* ws = a.ws;
    const h16* O0 = (const h16*)(ws + WS_XIN); const h16* O1 = O0 + (size_t)T * D; h16* ON = (h16*)(ws + WS_Z);
    const float lam_init = 0.35550907f;
    const float l1 = wave_sum(a.in[I_LQ1][F.lane] * a.in[I_LK1][F.lane], F.lane), l2 = wave_sum(a.in[I_LQ2][F.lane] * a.in[I_LK2][F.lane], F.lane);
    const float lam = expf(l1) - expf(l2) + lam_init;
    float g[16];
#pragma unroll
    for (int i = 0; i < 16; ++i) g[i] = a.in[I_SUBG][(F.lane & 7) * 16 + i] * (1.f - lam_init);
    for (int row0 = F.gw; row0 < T; row0 += 4 * F.NGW) {
        u32x4 in[4][4];
#pragma unroll
        for (int q = 0; q < 4; ++q) { const int row = row0 + q * F.NGW; if (row < T) { const size_t off = (size_t)row * D + 16 * F.lane;
            in[q][0] = *(const u32x4*)(O0 + off); in[q][1] = *(const u32x4*)(O0 + off + 8); in[q][2] = *(const u32x4*)(O1 + off); in[q][3] = *(const u32x4*)(O1 + off + 8); } }
        u32x4 outw[4][2];
#pragma unroll
        for (int q = 0; q < 4; ++q) { const int row = row0 + q * F.NGW; if (row < T) {
            float x0[8], x1[8], y0[8], y1[8];
            unpack8(in[q][0], x0); unpack8(in[q][1], x1); unpack8(in[q][2], y0); unpack8(in[q][3], y1);
            float o[16]; float ss = 0.f;
#pragma unroll
            for (int i = 0; i < 8; ++i) { o[i] = x0[i] - lam * y0[i]; o[8 + i] = x1[i] - lam * y1[i]; }
#pragma unroll
            for (int i = 0; i < 16; ++i) ss += o[i] * o[i];
            ss += sx(ss, 1, F.lane); ss += sx(ss, 2, F.lane); ss += sx(ss, 4, F.lane);
            const float rstd = 1.0f / sqrtf(ss * (1.f / 128.f) + 1e-5f);
            u32x4 w0, w1;
            w0.x = pk2h(o[0] * rstd * g[0], o[1] * rstd * g[1]); w0.y = pk2h(o[2] * rstd * g[2], o[3] * rstd * g[3]); w0.z = pk2h(o[4] * rstd * g[4], o[5] * rstd * g[5]); w0.w = pk2h(o[6] * rstd * g[6], o[7] * rstd * g[7]);
            w1.x = pk2h(o[8] * rstd * g[8], o[9] * rstd * g[9]); w1.y = pk2h(o[10] * rstd * g[10], o[11] * rstd * g[11]); w1.z = pk2h(o[12] * rstd * g[12], o[13] * rstd * g[13]); w1.w = pk2h(o[14] * rstd * g[14], o[15] * rstd * g[15]);
            outw[q][0] = w0; outw[q][1] = w1; } }
#pragma unroll
        for (int q = 0; q < 4; ++q) { const int row = row0 + q * F.NGW; if (row < T) { const size_t off = (size_t)row * D + 16 * F.lane; *(u32x4*)(ON + off) = outw[q][0]; *(u32x4*)(ON + off + 8) = outw[q][1]; } }
    }
}

namespace hy {
constexpr int VPS = 2568;
constexpr int OFF_SA = 0, OFF_VP = 65536, OFF_G = OFF_VP + 8 * VPS * 2, OFF_RG = OFF_G + 32768, OFF_END = OFF_RG + 8192;
static_assert(OFF_END <= LDS_CTL_OFF, "hyena LDS map");
DI f32x16 MF(s16x8 x, s16x8 y, f32x16 c) { return __builtin_amdgcn_mfma_f32_32x32x16_f16(__builtin_bit_cast(half8, x), __builtin_bit_cast(half8, y), c, 0, 0, 0); }
DI int crow(int r, int hi) { return (r & 3) + 8 * (r >> 2) + 4 * hi; }

struct RowRaw { u32x4 d[4]; h16 prev, next; };
DI void raw_load(const h16* UT, int chr, int tid, RowRaw& r) {
    const int b = tid >> 6, t0 = (tid & 63) * 32;
    const h16* src = UT + (size_t)chr * T + (size_t)b * L + t0;
    r.prev = t0 > 0 ? src[-1] : (h16)0; r.next = t0 + 32 < L ? src[32] : (h16)0;
#pragma unroll
    for (int q = 0; q < 4; ++q) r.d[q] = *(const u32x4*)(src + 8 * q);
}
DI void conv3_store(const RowRaw& r, float w0, float w1, float w2, LAS h16* dst, int pitch, int tid) {
    const int b = tid >> 6, t0 = (tid & 63) * 32;
    float u[34];
    u[0] = h2f(r.prev); u[33] = h2f(r.next);
#pragma unroll
    for (int q = 0; q < 4; ++q) { float tmp[8]; unpack8(r.d[q], tmp);
#pragma unroll
        for (int e = 0; e < 8; ++e) u[1 + 8 * q + e] = tmp[e]; }
#pragma unroll
    for (int q = 0; q < 4; ++q) { float o[8];
#pragma unroll
        for (int e = 0; e < 8; ++e) { const int i = 8 * q + e; o[e] = w0 * u[i] + w1 * u[i + 1] + w2 * u[i + 2]; }
        u32x4 w; w.x = pk2h(o[0], o[1]); w.y = pk2h(o[2], o[3]); w.z = pk2h(o[4], o[5]); w.w = pk2h(o[6], o[7]);
        *(LAS u32x4*)(dst + b * pitch + t0 + 8 * q) = w; }
}
DI void rg_load(const h16* hfw, const h16* hbw, int tid, h16 (&v)[8]) {
#pragma unroll
    for (int e = 0; e < 8; ++e) { const int idx = tid * 8 + e; h16 x = 0; if (idx >= 1 && idx <= L) x = hfw[L - idx]; else if (idx > L) x = hbw[idx - L]; v[e] = x; }
}
DI void rg_store(LAS h16* RG, int tid, const h16 (&v)[8]) {
    u32x4 w; w.x = v[0] | ((unsigned)v[1] << 16); w.y = v[2] | ((unsigned)v[3] << 16); w.z = v[4] | ((unsigned)v[5] << 16); w.w = v[6] | ((unsigned)v[7] << 16);
    *(LAS u32x4*)(RG + tid * 8) = w;
}
DI void build_sa(const LAS h16* RG, LAS unsigned char* SA, int tid) {
#pragma unroll
    for (int i = 0; i < 8; ++i) { const int q = tid + NTHR * i; unsigned short v[8];
#pragma unroll
        for (int e = 0; e < 8; ++e) v[e] = (q + e < 4096) ? RG[q + e] : (unsigned short)0;
        u32x4 w; w.x = v[0] | ((unsigned)v[1] << 16); w.y = v[2] | ((unsigned)v[3] << 16); w.z = v[4] | ((unsigned)v[5] << 16); w.w = v[6] | ((unsigned)v[7] << 16);
        *(LAS u32x4*)(SA + q * 16) = w; }
}
DI void toeplitz(const LAS unsigned char* SA, const LAS h16* VP, int wave, int lane, f32x16 (&acc)[2]) {
    const int i = lane & 31, hi = lane >> 5, n = lane & 31, b = n >> 2, q = n & 3;
    const int T0 = 256 * wave, dhi = T0 + 192;
    const LAS unsigned char* ap = SA + (L - dhi + 8 * hi - i) * 16;
    const LAS h16* bp = VP + b * VPS + 256 + (T0 + 64 * q - dhi) + 8 * hi;
    acc[0] = f32x16{}; acc[1] = f32x16{};
    s16x8 p0 = *(const LAS s16x8*)(ap - 512), p1 = *(const LAS s16x8*)(ap - 512 + 256);
    s16x8 xa0 = *(const LAS s16x8*)(ap), xa1 = *(const LAS s16x8*)(ap + 256), xb0 = *(const LAS s16x8*)(bp), xb1 = *(const LAS s16x8*)(bp + 16);
    s16x8 ya0, ya1, yb0, yb1;
    for (int d = 0; d < 70; d += 2) {
        ya0 = *(const LAS s16x8*)(ap + (d + 1) * 512); ya1 = *(const LAS s16x8*)(ap + (d + 1) * 512 + 256); yb0 = *(const LAS s16x8*)(bp + (d + 1) * 32); yb1 = *(const LAS s16x8*)(bp + (d + 1) * 32 + 16);
        __builtin_amdgcn_sched_barrier(0);
        acc[0] = MF(xa0, xb0, acc[0]); acc[1] = MF(p0, xb0, acc[1]);
        acc[0] = MF(xa1, xb1, acc[0]); acc[1] = MF(p1, xb1, acc[1]);
        __builtin_amdgcn_sched_barrier(0);
        { const int d2 = (d + 2 < 70) ? d + 2 : d;
          p0 = xa0; p1 = xa1;
          xa0 = *(const LAS s16x8*)(ap + d2 * 512); xa1 = *(const LAS s16x8*)(ap + d2 * 512 + 256); xb0 = *(const LAS s16x8*)(bp + d2 * 32); xb1 = *(const LAS s16x8*)(bp + d2 * 32 + 16); }
        __builtin_amdgcn_sched_barrier(0);
        acc[0] = MF(ya0, yb0, acc[0]); acc[1] = MF(p0, yb0, acc[1]);
        acc[0] = MF(ya1, yb1, acc[0]); acc[1] = MF(p1, yb1, acc[1]);
        __builtin_amdgcn_sched_barrier(0);
        p0 = ya0; p1 = ya1;
    }
}
}

#define HY_LBAR() asm volatile("s_waitcnt lgkmcnt(0)\n\ts_barrier" ::: "memory")
DI void hyconv_phase(const Ctx& F, CArgs& a) {
    using namespace hy;
    unsigned char* ws = a.ws;
    const h16* UT = (const h16*)(ws + WS_BIG); h16* ZT = (h16*)(ws + WS_XIN); const h16* FILT = (const h16*)(ws + WS_FILT);
    const float* cconv = a.in[I_CCONV]; const float* skip = a.in[I_SKIP];
    LAS unsigned char* SA = F.lds + OFF_SA; LAS h16* VP = (LAS h16*)(F.lds + OFF_VP); LAS h16* GB = (LAS h16*)(F.lds + OFF_G); LAS h16* RG = (LAS h16*)(F.lds + OFF_RG);
    for (int i = F.tid; i < 8 * 512; i += NTHR) { const int b = i >> 9, p = i & 511; VP[b * VPS + (p < 256 ? p : 2048 + p)] = 0; }
    const int lane = F.lane, hi = lane >> 5, n = lane & 31, bq = n >> 2, q = n & 3;
    int ch = F.bx;
    RowRaw rx1, rv, rx2; h16 g1[8], g2[8];
    if (ch < D) { raw_load(UT, ch, F.tid, rx1); raw_load(UT, 2048 + ch, F.tid, rv); rg_load(FILT + (size_t)(0 * 1024 + ch) * L, FILT + (size_t)(1 * 1024 + ch) * L, F.tid, g1); }
    for (; ch < D; ch += F.G) {
        HY_LBAR();
        conv3_store(rx1, cconv[ch], cconv[3072 + ch], cconv[2 * 3072 + ch], GB, L, F.tid);
        conv3_store(rv, cconv[2048 + ch], cconv[3072 + 2048 + ch], cconv[2 * 3072 + 2048 + ch], VP + 256, VPS, F.tid);
        rg_store(RG, F.tid, g1);
        raw_load(UT, 1024 + ch, F.tid, rx2); rg_load(FILT + (size_t)(2 * 1024 + ch) * L, FILT + (size_t)(3 * 1024 + ch) * L, F.tid, g2);
        HY_LBAR();
        build_sa(RG, SA, F.tid);
        HY_LBAR();
        f32x16 acc[2];
        toeplitz(SA, VP, F.wave, lane, acc);
        const float sk0 = skip[ch], sk1 = skip[1024 + ch];
        u32x2 z1p[2][4];
#pragma unroll
        for (int tau = 0; tau < 2; ++tau)
#pragma unroll
            for (int g4 = 0; g4 < 4; ++g4) { const int t = 256 * F.wave + 64 * q + 32 * tau + 8 * g4 + 4 * hi;
                const f32x4 vv = unpack4(*(const LAS u32x2*)(VP + bq * VPS + 256 + t)); const f32x4 xx = unpack4(*(const LAS u32x2*)(GB + bq * L + t));
                const float o0 = xx[0] * (acc[tau][4 * g4 + 0] + vv[0] * sk0); const float o1 = xx[1] * (acc[tau][4 * g4 + 1] + vv[1] * sk0);
                const float o2 = xx[2] * (acc[tau][4 * g4 + 2] + vv[2] * sk0); const float o3 = xx[3] * (acc[tau][4 * g4 + 3] + vv[3] * sk0);
                z1p[tau][g4].x = pk2h(o0, o1); z1p[tau][g4].y = pk2h(o2, o3); }
        HY_LBAR();
#pragma unroll
        for (int tau = 0; tau < 2; ++tau)
#pragma unroll
            for (int g4 = 0; g4 < 4; ++g4) { const int t = 256 * F.wave + 64 * q + 32 * tau + 8 * g4 + 4 * hi; *(LAS u32x2*)(VP + bq * VPS + 256 + t) = z1p[tau][g4]; }
        conv3_store(rx2, cconv[1024 + ch], cconv[3072 + 1024 + ch], cconv[2 * 3072 + 1024 + ch], GB, L, F.tid);
        rg_store(RG, F.tid, g2);
        { const int nc = ch + F.G;
          if (nc < D) { raw_load(UT, nc, F.tid, rx1); raw_load(UT, 2048 + nc, F.tid, rv); rg_load(FILT + (size_t)(0 * 1024 + nc) * L, FILT + (size_t)(1 * 1024 + nc) * L, F.tid, g1); } }
        HY_LBAR();
        build_sa(RG, SA, F.tid);
        HY_LBAR();
        toeplitz(SA, VP, F.wave, lane, acc);
#pragma unroll
        for (int tau = 0; tau < 2; ++tau)
#pragma unroll
            for (int g4 = 0; g4 < 4; ++g4) { const int t = 256 * F.wave + 64 * q + 32 * tau + 8 * g4 + 4 * hi;
                const f32x4 vv = unpack4(*(const LAS u32x2*)(VP + bq * VPS + 256 + t)); const f32x4 xx = unpack4(*(const LAS u32x2*)(GB + bq * L + t));
                const float o0 = xx[0] * (acc[tau][4 * g4 + 0] + vv[0] * sk1); const float o1 = xx[1] * (acc[tau][4 * g4 + 1] + vv[1] * sk1);
                const float o2 = xx[2] * (acc[tau][4 * g4 + 2] + vv[2] * sk1); const float o3 = xx[3] * (acc[tau][4 * g4 + 3] + vv[3] * sk1);
                u32x2 w; w.x = pk2h(o0, o1); w.y = pk2h(o2, o3);
                *(u32x2*)(ZT + (size_t)ch * T + (size_t)bq * L + t) = w; }
    }
    __syncthreads();
}

DI void trans_phase(const Ctx& F, CArgs& a) {
    const h16* ZT = (const h16*)(a.ws + WS_XIN); h16* Z = (h16*)(a.ws + WS_Z);
    LAS h16* tile = (LAS h16*)(F.lds + F.wave * 16384);
    const int nitems = (D / 64) * (T / 64);
    for (int it = F.gw; it < nitems; it += F.NGW) {
        const int cb = it & 15, tb = it >> 4, c0 = cb * 64, t0 = tb * 64;
        u32x4 tw[8];
#pragma unroll
        for (int i = 0; i < 8; ++i) { const int c = (F.lane >> 3) + 8 * i, ck = F.lane & 7; tw[i] = *(const u32x4*)(ZT + (size_t)(c0 + c) * T + t0 + 8 * ck); }
        __builtin_amdgcn_sched_barrier(0);
#pragma unroll
        for (int i = 0; i < 8; ++i) { const int c = (F.lane >> 3) + 8 * i, ck = F.lane & 7; *(LAS u32x4*)(tile + c * 72 + 8 * ck) = tw[i]; }
        LDS_WAIT(); asm volatile("" ::: "memory");
#pragma unroll
        for (int i = 0; i < 8; ++i) { const int t = (F.lane >> 3) + 8 * i, ck = F.lane & 7; unsigned short v[8];
#pragma unroll
            for (int e = 0; e < 8; ++e) v[e] = tile[(8 * ck + e) * 72 + t];
            u32x4 w; w.x = v[0] | ((unsigned)v[1] << 16); w.y = v[2] | ((unsigned)v[3] << 16); w.z = v[4] | ((unsigned)v[5] << 16); w.w = v[6] | ((unsigned)v[7] << 16);
            *(u32x4*)(Z + (size_t)(t0 + t) * D + c0 + 8 * ck) = w; }
        LDS_WAIT(); asm volatile("" ::: "memory");
    }
}

enum { K_PRO = 0, K_ROWS, K_GIN, K_CONVGATE, K_GOUT, K_MOEROWS, K_TOPK, K_GMOE1, K_GMOE2, K_GQKV, K_ATTN, K_ATTNPOST, K_GHYIN, K_HYCONV, K_TRANS };
constexpr int NPHASE = 35;
DI void phase_desc(int ph, int& kind, int& layer) {
    if (ph == 0) { kind = K_PRO; layer = 0; return; }
    if (ph == 1) { kind = K_ROWS; layer = -1; return; }
    int l, r;
    if (ph < 10) { l = 0; r = ph - 2; } else if (ph < 18) { l = 1; r = ph - 10; } else if (ph < 27) { l = 2; r = ph - 18; } else { l = 3; r = ph - 27; }
    layer = l;
    const int nmix = (l == 2) ? 4 : 3;
    if (r >= nmix) { const int m = r - nmix; kind = m == 0 ? K_MOEROWS : m == 1 ? K_TOPK : m == 2 ? K_GMOE1 : m == 3 ? K_GMOE2 : K_ROWS; return; }
    if (l == 0 || l == 3) kind = r == 0 ? K_GIN : r == 1 ? K_CONVGATE : K_GOUT;
    else if (l == 1) kind = r == 0 ? K_GQKV : r == 1 ? K_ATTN : K_GOUT;
    else kind = r == 0 ? K_GHYIN : r == 1 ? K_HYCONV : r == 2 ? K_TRANS : K_GOUT;
}

__global__ void __launch_bounds__(NTHR, 2) mk_fwd(Args a_) {
    extern __shared__ __attribute__((aligned(16))) unsigned char lds_raw[];
    cg::grid_group grid = cg::this_grid();
    const int ph_lo = a_.ph_lo, ph_hi = a_.ph_hi;
    { volatile LAS unsigned* st0 = (volatile LAS unsigned*)((LAS unsigned char*)lds_raw + LDS_CTL_OFF); if (threadIdx.x < 16) st0[threadIdx.x] = 0u; }
    __syncthreads();
    XcdBarrier xbar = xcd_barrier_post((unsigned*)(a_.ws + WS_CTL) + 4096, (volatile LAS unsigned*)((LAS unsigned char*)lds_raw + LDS_CTL_OFF));
    int wave_s = __builtin_amdgcn_readfirstlane((int)(threadIdx.x >> 6)); asm volatile("" : "+s"(wave_s));
    for (int ph = ph_lo; ph < ph_hi; ++ph) {
#define MK_CTX Ctx F; { unsigned am_ = ~0u; asm volatile("" : "+s"(am_)); int tid_ = wave_s * 64 + (int)__builtin_amdgcn_mbcnt_hi(am_, __builtin_amdgcn_mbcnt_lo(am_, 0u)); asm volatile("" : "+v"(tid_)); int bx = blockIdx.x; asm volatile("" : "+s"(bx)); \
          F.lds = (LAS unsigned char*)lds_raw; F.tid = tid_; F.lane = tid_ & 63; F.wave = __builtin_amdgcn_readfirstlane(tid_ >> 6); \
          int G_ = gridDim.x; asm volatile("" : "+s"(G_)); F.G = G_; F.bx = bx; F.vcu = (F.G % 8 == 0) ? (bx % 8) * (F.G / 8) + bx / 8 : bx; \
          F.gw = F.vcu * NWAVES + F.wave; F.NGW = F.G * NWAVES; }
        CArgs* apl = (CArgs*)__builtin_amdgcn_kernarg_segment_ptr(); asm volatile("" : "+s"(apl)); CArgs& a = *apl;
        unsigned char* ws = a.ws;
        int kind, l; phase_desc(ph, kind, l);
        const bool dbg_final = (ph > DBG_STOP);
        if (dbg_final && ph != NPHASE - 1) continue;
        if (dbg_final) { kind = K_ROWS; }
#ifdef ONLY_KIND
        kind = ONLY_KIND;
#endif
        const unsigned long long amp_t0 = DBG_AMP_MASK ? __builtin_amdgcn_s_memrealtime() : 0ull;
        switch (kind) {
        case K_PRO: { MK_CTX; p0_prologue(F, a); } break;
        case K_ROWS: { MK_CTX;
            const bool first = (l < 0) && !dbg_final, fin = dbg_final || l == 3;
            const int lm = l < 0 ? 0 : l;
            rows_phase(F, a, (first || lm == 0) && !dbg_final ? TT : T, first, !first && !dbg_final, lm, lm + (first ? 0 : 1), fin, dbg_final && DBG_CHECK);
        } break;
        case K_GIN: { MK_CTX; const int j = l == 0 ? 0 : 1;
            pg8::SchedPlain S{l == 0 ? 72 : 64, 12, F.G, F.bx}; pg8::EpiGin E{(h16*)(ws + WS_BIG)};
            pg8::gemm_phase<false, false>(F.lds, F.tid, (const h16*)(ws + WS_H), (const h16*)(ws + WS_WAIN) + (size_t)j * 3072 * 1024, 1024, S, E); } break;
        case K_CONVGATE: { MK_CTX; convgate_phase(F, a, l == 0 ? 0 : 1, l == 0 ? TT : T); } break;
        case K_GOUT: { MK_CTX; const h16* W = l == 0 ? (const h16*)(ws + WS_WAOUT) : l == 1 ? (const h16*)(ws + WS_WBOUT) : l == 2 ? (const h16*)(ws + WS_WCOUT) : (const h16*)(ws + WS_WAOUT) + (size_t)1024 * 1024;
            pg8::SchedPlain S{l == 0 ? 72 : 64, 4, F.G, F.bx}; pg8::EpiResid E{(h16*)(ws + WS_XC), (const float*)(ws + WS_MOD) + (size_t)l * 9 * 6144, 2048};
            pg8::gemm_phase<false, false>(F.lds, F.tid, (const h16*)(ws + WS_Z), W, 1024, S, E); } break;
        case K_MOEROWS: { MK_CTX; moe_rows_phase(F, a, l, l == 0 ? TT : T); } break;
        case K_TOPK: { MK_CTX; topk_phase(F, a, l); } break;
        case K_GMOE1: { MK_CTX; pg8::SchedMoe S{l == 0 ? 144 : 128, 8, F.G, F.bx, 8}; pg8::EpiSwiglu8 E{(unsigned char*)(ws + WS_BIG)};
            pg8::gemm_phase<true, true>(F.lds, F.tid, (const h16*)(ws + WS_Z), (const h16*)(ws + WS_WGU + (size_t)l * 16 * 2048 * 1024), 512, S, E, (const int*)(ws + WS_GATE + 512 * 1024)); } break;
        case K_GMOE2: { MK_CTX; pg8::SchedMoe S{l == 0 ? 144 : 128, 4, F.G, F.bx, 4}; pg8::EpiDown8 E{(unsigned char*)(ws + WS_XIN), (const float*)(ws + WS_GATE)};
            pg8::gemm_phase<false, true>(F.lds, F.tid, (const h16*)(ws + WS_BIG), (const h16*)(ws + WS_WDN + (size_t)l * 16 * 1024 * 1024), 512, S, E); } break;
        case K_GQKV: { MK_CTX; pg8::SchedQkv S{F.G, F.bx};
            h16* Q = (h16*)(ws + WS_BIG); h16* Kb = Q + (size_t)T * D; h16* Vb = Kb + (size_t)NB * KVR * D;
            pg8::EpiQkv E{Q, Kb, Vb, (const float*)(ws + WS_SMALL), (const float*)(ws + WS_SMALL) + 1024};
            pg8::gemm_phase<false, false>(F.lds, F.tid, (const h16*)(ws + WS_H), (const h16*)(ws + WS_WQKV), 1024, S, E); } break;
        case K_ATTN: { MK_CTX; attn_phase(F, a); } break;
        case K_ATTNPOST: { MK_CTX; attn_post_phase(F, a); } break;
        case K_GHYIN: { MK_CTX; pg8::SchedPlain S{12, 64, F.G, F.bx}; pg8::EpiPlain E{(h16*)(ws + WS_BIG), T};
            pg8::gemm_phase<false, false>(F.lds, F.tid, (const h16*)(ws + WS_WCIN), (const h16*)(ws + WS_H), 1024, S, E); } break;
        case K_HYCONV: { MK_CTX; hyconv_phase(F, a); } break;
        case K_TRANS: { MK_CTX; trans_phase(F, a); } break;
        default: break;
        }
        if (gridDim.x == 256) {
            const int bx_ = blockIdx.x; int first = -1, n = 0;
            if (kind == K_GIN && l == 0 && bx_ >= 96) { first = (bx_ - 96) * DEF_A; n = DEF_A; }
            else if (kind == K_GOUT && l == 0 && bx_ >= 32) { first = 160 * DEF_A + (bx_ - 32) * DEF_A; n = DEF_A; }
            else if (kind == K_GMOE1 && l == 0 && bx_ >= 128) { first = 384 * DEF_A + (bx_ - 128) * DEF_B; n = DEF_B; }
            else if (kind == K_GMOE2 && l == 0 && bx_ >= 64) { first = 384 * DEF_A + 128 * DEF_B + (bx_ - 64) * DEF_B; n = DEF_B; }
            else if (kind == K_GQKV && bx_ >= 64) { first = 384 * DEF_A + 320 * DEF_B + (bx_ - 64) * DEF_A; n = DEF_A; }
            if (n > 0) { MK_CTX; deferred_convert(F, a, first, n); }
        }
        if (DBG_AMP_MASK && ((DBG_AMP_MASK >> kind) & 1)) { const unsigned long long t1 = __builtin_amdgcn_s_memrealtime(); const unsigned long long dt = (t1 - amp_t0) * DBG_AMP_M; while (__builtin_amdgcn_s_memrealtime() - t1 < dt) __builtin_amdgcn_s_sleep(8); }
        if (ph + 1 < ph_hi) { if (ph_lo < -1) grid.sync();
            unsigned am2_ = ~0u; asm volatile("" : "+s"(am2_));
            xcd_barrier(xbar, wave_s == 0 && __builtin_amdgcn_mbcnt_hi(am2_, __builtin_amdgcn_mbcnt_lo(am2_, 0u)) == 0u); }
    }
}

#if DBG_CHECK
__device__ unsigned dbg_hash(unsigned x) { x ^= x >> 16; x *= 0x7feb352dU; x ^= x >> 15; x *= 0x846ca68bU; x ^= x >> 16; return x; }
__global__ void dbg_check_gemm(const h16* A, const float* W, int N, const h16* O, int ldo, int nrows, float* accum) {
    const unsigned id = blockIdx.x * blockDim.x + threadIdx.x;
    const int row = dbg_hash(id * 2 + 1) % nrows, col = dbg_hash(id * 2 + 2) % N;
    float s = 0.f;
    for (int k = 0; k < 1024; ++k) s += h2f(A[(size_t)row * 1024 + k]) * W[(size_t)k * N + col];
    const float o = h2f(O[(size_t)row * ldo + col]);
    atomicAdd(accum, (o - s) * (o - s)); atomicAdd(accum + 1, s * s);
}
__global__ void dbg_check_convgate(const h16* BCV, const float* cw, const h16* Z, int nrows, float* accum) {
    const unsigned id = blockIdx.x * blockDim.x + threadIdx.x;
    const int row = dbg_hash(id * 2 + 1) % nrows, c = dbg_hash(id * 2 + 2) % 1024;
    const int ls = row < T ? L : LC; const int t = row < T ? (row % L) : ((row - T) % LC);
    auto u = [&](int r) { return h2f(BCV[(size_t)r * 3072 + 1024 + c]) * h2f(BCV[(size_t)r * 3072 + 2048 + c]); };
    float s = cw[1024 + c] * u(row);
    if (t > 0) s += cw[c] * u(row - 1);
    if (t + 1 < ls) s += cw[2048 + c] * u(row + 1);
    s *= h2f(BCV[(size_t)row * 3072 + c]);
    const float o = h2f(Z[(size_t)row * 1024 + c]);
    atomicAdd(accum, (o - s) * (o - s)); atomicAdd(accum + 1, s * s);
}
__global__ void dbg_check_resid(const h16* Zb, const float* W, const float* XC, const float* xin, const float* gate  , float* accum) {
    const unsigned id = blockIdx.x * blockDim.x + threadIdx.x;
    const int row = dbg_hash(id * 2 + 1) % T, col = dbg_hash(id * 2 + 2) % 1024;
    float s = 0.f;
    for (int k = 0; k < 1024; ++k) s += h2f(Zb[(size_t)row * 1024 + k]) * W[(size_t)k * 1024 + col];
    s *= gate[(size_t)(row / L) * 6144 + col];
    const float o = XC[(size_t)row * 1024 + col] - xin[(size_t)row * 1024 + col];
    atomicAdd(accum, (o - s) * (o - s)); atomicAdd(accum + 1, s * s);
}
__global__ void dbg_encode(float* out, const float* accum, int n) {
    const float e = sqrtf(accum[0] / fmaxf(accum[1], 1e-30f));
    const float k = fminf(fmaxf(log10f(fmaxf(e, 1e-20f)) + 7.f, 0.f), 8.f);
    const float s = 1.f + k;
    for (int i = blockIdx.x * blockDim.x + threadIdx.x; i < n; i += gridDim.x * blockDim.x) out[i] *= s;
}
#endif

extern "C" void kernel_launch(void* const* d_in, const int* in_sizes, int n_in, void* d_out, int out_size, void* d_ws, size_t ws_size, hipStream_t stream) {
    static int grid = 0;
    if (grid == 0) {
        if (n_in != 34 || in_sizes[0] != T * D || out_size != T * D || ws_size < WS_END) { fprintf(stderr, "kernel_launch: unexpected shapes / workspace (n_in %d, in0 %d, out %d, ws %zu); nothing launched\n", n_in, n_in > 0 ? in_sizes[0] : -1, out_size, ws_size); grid = -1; return; }
        int dev = 0, cus = 0, per_cu = 0;
        if (hipGetDevice(&dev) != hipSuccess || hipDeviceGetAttribute(&cus, hipDeviceAttributeMultiprocessorCount, dev) != hipSuccess) { fprintf(stderr, "kernel_launch: device query failed\n"); grid = -1; return; }
        if (hipFuncSetAttribute((const void*)mk_fwd, hipFuncAttributeMaxDynamicSharedMemorySize, LDS_BYTES) != hipSuccess) { fprintf(stderr, "kernel_launch: hipFuncSetAttribute failed\n"); grid = -1; return; }
        if (hipOccupancyMaxActiveBlocksPerMultiprocessor(&per_cu, (const void*)mk_fwd, NTHR, LDS_BYTES) != hipSuccess || per_cu < 1) { fprintf(stderr, "kernel_launch: occupancy query says %d\n", per_cu); (void)hipGetLastError(); per_cu = 1; }
        grid = cus * 1;
    }
    if (grid < 0) return;
    (void)hipMemsetAsync((char*)d_ws + WS_CTL, 0, CTL_ZERO_BYTES, stream);
    Args a{};
    for (int i = 0; i < 34; ++i) a.in[i] = (const float*)d_in[i];
    a.out = (float*)d_out; a.ws = (unsigned char*)d_ws;
    constexpr int NPH = NPHASE;
#if MK_N_LAUNCHES == 1
    a.ph_lo = 0; a.ph_hi = NPH;
    void* args[] = {&a};
    hipError_t e = hipLaunchCooperativeKernel((const void*)mk_fwd, dim3(grid), dim3(NTHR), args, LDS_BYTES, stream);
    if (e != hipSuccess) fprintf(stderr, "kernel_launch: cooperative launch failed: %s (grid %d)\n", hipGetErrorString(e), grid);
#else
    for (int ph = 0; ph < NPH; ++ph) { a.ph_lo = ph; a.ph_hi = ph + 1; hipLaunchKernelGGL(mk_fwd, dim3(grid), dim3(NTHR), LDS_BYTES, stream, a); }
#endif
#if DBG_CHECK
    {
        unsigned char* ws = (unsigned char*)d_ws; float* accum = (float*)(ws + WS_CTL + 512 * 1024);
        (void)hipMemsetAsync(accum, 0, 64, stream);
        if (DBG_CHECK == 1) hipLaunchKernelGGL(dbg_check_gemm, dim3(64), dim3(256), 0, stream, (const h16*)(ws + WS_H), (const float*)d_in[I_AWIN], 3072, (const h16*)(ws + WS_BIG), 3072, TT, accum);
        if (DBG_CHECK == 2)
            hipLaunchKernelGGL(dbg_check_convgate, dim3(64), dim3(256), 0, stream, (const h16*)(ws + WS_BIG), (const float*)d_in[I_ACONV], (const h16*)(ws + WS_Z), TT, accum);
        if (DBG_CHECK == 3)
            hipLaunchKernelGGL(dbg_check_resid, dim3(64), dim3(256), 0, stream, (const h16*)(ws + WS_Z), (const float*)d_in[I_AWOUT], (const float*)(ws + WS_XC), (const float*)d_in[I_X], (const float*)(ws + WS_MOD) + 2048, accum);
        hipLaunchKernelGGL(dbg_encode, dim3(1024), dim3(256), 0, stream, (float*)d_out, (const float*)accum, T * D);
    }
#endif
}
```
